# Optimizing an MI355X kernel written in HIP

```python
import jax, jax.numpy as jnp
from jax import lax
import numpy as np

D_MODEL = 4096
BATCH = 4
SEQ = 2048
DEPTH = 1

N_META = 16
CHUNK = 64
RET_HEADS = 8
RET_DK = D_MODEL // 16
RET_DV = D_MODEL // RET_HEADS
GLA_HEADS = 4
GLA_DK = D_MODEL // 8
GLA_DV = D_MODEL // GLA_HEADS
GLA_RANK = 16
GLA_GATE_TAU = 16.0
D_FF = 11008
CONV_W = 3
ROPE_BASE = 10000.0
EPS = 1e-6

RET_QK = RET_HEADS * RET_DK
RET_V = RET_HEADS * RET_DV
GLA_QK = GLA_HEADS * GLA_DK
GLA_V = GLA_HEADS * GLA_DV
IN_WIDTHS = (RET_QK, RET_QK, RET_V, RET_V,
             GLA_QK, GLA_QK, GLA_V, GLA_V,
             GLA_RANK,
             D_MODEL, D_MODEL)
W_IN_COLS = 4 * RET_QK // 2 + 2 * RET_V + 2 * GLA_QK + 2 * GLA_V + GLA_RANK + 2 * D_MODEL

kernel_name = "hybrid_retnet_gla_convffn_meta"


def _rmsnorm(x, g):
    xf = x.astype(jnp.float32)
    y = xf * lax.rsqrt(jnp.mean(xf * xf, axis=-1, keepdims=True) + EPS)
    return (y * g.astype(jnp.float32)).astype(x.dtype)


def _rope(x, pos):
    half = x.shape[-1] // 2
    inv_freq = ROPE_BASE ** (-jnp.arange(half, dtype=jnp.float32) / half)
    ang = pos.astype(jnp.float32)[..., None] * inv_freq
    cos = jnp.cos(ang)[:, :, None, :]
    sin = jnp.sin(ang)[:, :, None, :]
    x1 = x[..., :half].astype(jnp.float32)
    x2 = x[..., half:].astype(jnp.float32)
    return jnp.concatenate([x1 * cos - x2 * sin, x2 * cos + x1 * sin], axis=-1).astype(x.dtype)


def _to_chunks(t):
    B, L, H, d = t.shape
    t = jnp.pad(t, ((0, 0), (CHUNK - N_META, 0), (0, 0), (0, 0)))
    n = t.shape[1] // CHUNK
    return t.reshape(B, n, CHUNK, H, d).transpose(1, 0, 3, 2, 4)


def _from_chunks(o):
    n, B, H, C, d = o.shape
    return o.transpose(1, 0, 3, 2, 4).reshape(B, n * C, H, d)[:, CHUNK - N_META:]


def _retention_chunked(q, k, v):
    H, dk, dv = q.shape[2], q.shape[3], v.shape[3]
    B = q.shape[0]
    qc, kc, vc = _to_chunks(q), _to_chunks(k), _to_chunks(v)
    log_gamma = jnp.log1p(-jnp.exp2(-5.0 - jnp.arange(H, dtype=jnp.float32)))
    idx = jnp.arange(CHUNK)
    rel = idx[:, None] - idx[None, :]
    causal = rel >= 0
    decay_intra = jnp.where(causal, jnp.exp(log_gamma[:, None, None] * jnp.where(causal, rel, 0)), 0.0)
    decay_q = jnp.exp(log_gamma[:, None] * (idx + 1))[None, :, :, None]
    decay_k = jnp.exp(log_gamma[:, None] * (CHUNK - 1 - idx))[None, :, :, None]
    decay_chunk = jnp.exp(log_gamma * CHUNK)[None, :, None, None]

    def step(state, inp):
        qi, ki, vi = inp
        scores = jnp.einsum('bhqd,bhkd->bhqk', qi, ki) * decay_intra
        inner = jnp.einsum('bhqk,bhkv->bhqv', scores, vi)
        cross = jnp.einsum('bhqd,bhdv->bhqv', qi, state) * decay_q
        new_state = state * decay_chunk + jnp.einsum('bhkd,bhkv->bhdv', ki * decay_k, vi)
        return new_state, (inner + cross).astype(jnp.float32)

    state0 = jnp.zeros((B, H, dk, dv), jnp.float32)
    _, out = lax.scan(step, state0, (qc, kc, vc))
    return _from_chunks(out)


def _gla_chunked(q, k, v, log_a):
    B, H, dk, dv = q.shape[0], q.shape[2], q.shape[3], v.shape[3]
    qc, kc, vc, gc = _to_chunks(q), _to_chunks(k), _to_chunks(v), _to_chunks(log_a)
    idx = jnp.arange(CHUNK)
    causal = (idx[:, None] >= idx[None, :])[None, None, :, :, None]

    def step(state, inp):
        qi, ki, vi, gi = inp
        b = jnp.cumsum(gi.astype(jnp.float32), axis=2)
        cross = jnp.einsum('bhqd,bhdv->bhqv', qi * jnp.exp(b), state)
        diff = b[:, :, :, None, :] - b[:, :, None, :, :]
        w = jnp.where(causal, jnp.exp(jnp.where(causal, diff, 0.0)), 0.0)
        scores = jnp.einsum('bhqd,bhkd,bhqkd->bhqk', qi, ki, w)
        inner = jnp.einsum('bhqk,bhkv->bhqv', scores, vi)
        b_last = b[:, :, -1:, :]
        new_state = state * jnp.exp(b_last)[:, :, 0, :, None] + jnp.einsum(
            'bhkd,bhkv->bhdv', ki * jnp.exp(b_last - b), vi)
        return new_state, (inner + cross).astype(jnp.float32)

    state0 = jnp.zeros((B, H, dk, dv), jnp.float32)
    _, out = lax.scan(step, state0, (qc, kc, vc, gc))
    return _from_chunks(out)


def _hybrid_mixer(h, pos, w_in, w_gate_up, b_gate, g_ret, g_gla, w_out):
    B, L, _ = h.shape
    proj = h @ w_in
    splits = np.cumsum(IN_WIDTHS)[:-1].tolist()
    q_r, k_r, v_r, o_r, q_g, k_g, v_g, o_g, z_g, m_r, m_g = jnp.split(proj, splits, axis=-1)

    q = _rope(q_r.reshape(B, L, RET_HEADS, RET_DK), pos)
    k = _rope(k_r.reshape(B, L, RET_HEADS, RET_DK), pos) * (RET_DK ** -0.5)
    v = v_r.reshape(B, L, RET_HEADS, RET_DV)
    y = _retention_chunked(q, k, v)
    mu = jnp.mean(y, axis=-1, keepdims=True)
    var = jnp.mean(jnp.square(y - mu), axis=-1, keepdims=True)
    y = ((y - mu) * lax.rsqrt(var + EPS)).reshape(B, L, RET_V) * g_ret.astype(jnp.float32)
    y_ret = y.astype(h.dtype) * jax.nn.silu(o_r)

    log_a = jax.nn.log_sigmoid((z_g @ w_gate_up + b_gate).astype(jnp.float32)) / GLA_GATE_TAU
    q = q_g.reshape(B, L, GLA_HEADS, GLA_DK) * (GLA_DK ** -0.5)
    k = k_g.reshape(B, L, GLA_HEADS, GLA_DK)
    v = v_g.reshape(B, L, GLA_HEADS, GLA_DV)
    y = _gla_chunked(q, k, v, log_a.reshape(B, L, GLA_HEADS, GLA_DK))
    y = (y * lax.rsqrt(jnp.mean(y * y, axis=-1, keepdims=True) + EPS)).reshape(B, L, GLA_V)
    y_gla = (y * g_gla.astype(jnp.float32)).astype(h.dtype) * jax.nn.silu(o_g)

    merged = jax.nn.sigmoid(m_r) * y_ret + jax.nn.sigmoid(m_g) * y_gla
    return (merged @ w_out).astype(h.dtype)


def _conv_ffn(h, w_ffn_in, conv_w, conv_b, w_ffn_out):
    L = h.shape[1]
    up, gate = jnp.split(h @ w_ffn_in, 2, axis=-1)
    up_p = jnp.pad(up, ((0, 0), (CONV_W - 1, 0), (0, 0)))
    c = conv_b
    for j in range(CONV_W):
        c = c + conv_w[j] * up_p[:, j:j + L]
    return ((jax.nn.silu(c) * gate) @ w_ffn_out).astype(h.dtype)


def setup_inputs(seed: int = 0) -> dict:
    key = jax.random.key(seed)
    ks = jax.random.split(key, 16)
    f32 = jnp.float32
    nrm = lambda k, s, sc: jax.random.normal(k, s, f32) * sc
    return {
        "x": nrm(ks[0], (BATCH, SEQ, D_MODEL), 1.0),
        "positions": jnp.broadcast_to(jnp.arange(SEQ, dtype=jnp.int32), (BATCH, SEQ)),
        "meta_tokens": nrm(ks[1], (N_META, D_MODEL), 1.0),
        "attn_norm": 1.0 + nrm(ks[2], (DEPTH, D_MODEL), 0.02),
        "w_in": nrm(ks[3], (DEPTH, D_MODEL, W_IN_COLS), D_MODEL ** -0.5),
        "w_gate_up": nrm(ks[4], (DEPTH, GLA_RANK, GLA_QK), GLA_RANK ** -0.5),
        "b_gate": nrm(ks[5], (DEPTH, GLA_QK), 0.01),
        "ret_norm": 1.0 + nrm(ks[6], (DEPTH, RET_V), 0.02),
        "gla_norm": 1.0 + nrm(ks[7], (DEPTH, GLA_V), 0.02),
        "w_out": nrm(ks[8], (DEPTH, D_MODEL, D_MODEL), D_MODEL ** -0.5),
        "ffn_norm": 1.0 + nrm(ks[9], (DEPTH, D_MODEL), 0.02),
        "w_ffn_in": nrm(ks[10], (DEPTH, D_MODEL, 2 * D_FF), D_MODEL ** -0.5),
        "conv_w": nrm(ks[11], (DEPTH, CONV_W, D_FF), CONV_W ** -0.5),
        "conv_b": nrm(ks[12], (DEPTH, D_FF), 0.01),
        "w_ffn_out": nrm(ks[13], (DEPTH, D_FF, D_MODEL), D_FF ** -0.5),
        "final_norm": 1.0 + nrm(ks[14], (D_MODEL,), 0.02),
    }


def reference(x, positions, meta_tokens, attn_norm, w_in, w_gate_up, b_gate, ret_norm, gla_norm,
              w_out, ffn_norm, w_ffn_in, conv_w, conv_b, w_ffn_out, final_norm):
    B = x.shape[0]
    meta = jnp.broadcast_to(meta_tokens[None].astype(x.dtype), (B, N_META, D_MODEL))
    h = jnp.concatenate([meta, x], axis=1)
    pos = jnp.concatenate([jnp.broadcast_to(jnp.arange(N_META, dtype=jnp.int32), (B, N_META)),
                           positions.astype(jnp.int32) + N_META], axis=1)
    for i in range(DEPTH):
        h = h + _hybrid_mixer(_rmsnorm(h, attn_norm[i]), pos, w_in[i], w_gate_up[i], b_gate[i],
                              ret_norm[i], gla_norm[i], w_out[i])
        h = h + _conv_ffn(_rmsnorm(h, ffn_norm[i]), w_ffn_in[i], conv_w[i], conv_b[i], w_ffn_out[i])
    h = _rmsnorm(h, final_norm)
    return h[:, N_META:]
```

```cpp
#include <hip/hip_runtime.h>
#include <cstdio>
#include <cstdint>
namespace pg8 {
#define PG8_LAS __attribute__((address_space(3)))
typedef unsigned short bf16_t;
typedef short bf16x8 __attribute__((ext_vector_type(8)));
typedef float f32x4 __attribute__((ext_vector_type(4)));
typedef unsigned u32x4 __attribute__((ext_vector_type(4)));
constexpr int BM = 256, BK = 64, HALF = 128, HTB = HALF * BK * 2  , STAGE_BYTES = 8 * HTB, NXCD = 8, WGM = 8;

__host__ __device__ __forceinline__ int lds_byte(int r, int c) { const int st = (r >> 4) * 2 + (c >> 5), rr = r & 15, cc = c & 31, ob = rr * 64 + cc * 2; return st * 1024 + (ob ^ (((ob >> 9) & 1) << 5)); }
__host__ __device__ __forceinline__ void stage_rc(int b, int& R, int& C) { const int st = b / 1024, sb = b % 1024, swz = sb ^ (((sb >> 9) & 1) << 5); R = (st >> 1) * 16 + swz / 64; C = (st & 1) * 32 + (swz % 64) / 2; }
__host__ __device__ __forceinline__ int perm32(int rho) { const int n = rho >> 4, i = rho & 15; return 8 * (i >> 2) + 4 * n + (i & 3); }

struct Unit { int pm, pn; };
struct Gemm { const bf16_t* A; const bf16_t* Bt; int M, N, K; };

struct StaticOrder {
    int nM, nN, nwg, G, c;
    __host__ __device__ void init(int M, int N, int G_, int c_) { nM = M / BM; nN = N / BM; nwg = nM * nN; G = G_; c = c_; }
    __host__ __device__ bool next(int i, Unit& u) const {
        const long L = (long)i * G + c; if (L >= nwg) return false;
        int wgid = (int)L; { const int q = nwg / NXCD, r = nwg % NXCD, xcd = wgid % NXCD, off = wgid / NXCD; wgid = (xcd < r ? xcd * (q + 1) : r * (q + 1) + (xcd - r) * q) + off; }
        const int nig = WGM * nN, gid = wgid / nig, fm = gid * WGM, gsz = (nM - fm) < WGM ? (nM - fm) : WGM;
        u.pm = fm + ((wgid % nig) % gsz); u.pn = (wgid % nig) / gsz; return true;
    }
    __device__ __forceinline__ void a_ready(const Unit&) const {}
    __device__ __forceinline__ void done(const Unit&) const {}
};
__device__ __forceinline__ unsigned cvt_pk_bf16(float lo, float hi) { unsigned r; asm volatile("v_cvt_pk_bf16_f32 %0, %1, %2" : "=v"(r) : "v"(lo), "v"(hi)); return r; }
template <class Epi, class Sched, bool ALIGN_EPI = false, bool SP2 = false>
__device__ __forceinline__ void gemm_phase(PG8_LAS unsigned char* lds, const Gemm g, const Sched& S, const Epi& E) {
    const int tid = threadIdx.x, wid = __builtin_amdgcn_readfirstlane(tid >> 6), lane = tid & 63, wr = wid >> 2, wc = wid & 3, fr = lane & 15, fq = lane >> 4;
    const int K = g.K, nt = K / BK;
    unsigned voffA[2], voffB[2];
#pragma unroll
    for (int i = 0; i < 2; ++i) { int R, C; stage_rc(tid * 16 + i * 8192, R, C); const int Rb = Epi::PERM ? ((R & ~31) + perm32(R & 31)) : R;
        voffA[i] = (unsigned)(R * K + C) * 2u; voffB[i] = (unsigned)(Rb * K + C) * 2u; }
    const size_t kstep = (size_t)(BK * 2);
    const size_t hstep = (size_t)HALF * K * 2;
    const size_t tstep = 2 * hstep;
    const unsigned ldsw = (unsigned)wid * 1024u;
    const int aoff = lds_byte(wr * 64 + fr, fq * 8), boff = lds_byte(wc * 32 + fr, fq * 8);
#define PG8_SA(b, h) (((b) * 2 + (h)) * HTB)
#define PG8_SB(b, h) ((4 + (b) * 2 + (h)) * HTB)
#define PG8_STAGE(bufoff, gbase, voff) do { _Pragma("unroll") for (int _i = 0; _i < 2; ++_i) \
        __builtin_amdgcn_global_load_lds((const unsigned*)((const char*)(gbase) + (voff)[_i]), (PG8_LAS unsigned*)(lds + (bufoff) + ldsw + _i * 8192), 16, 0, 0); } while (0)
#define PG8_LDA(dst, b, h) do { _Pragma("unroll") for (int m = 0; m < 4; ++m) _Pragma("unroll") for (int k = 0; k < 2; ++k) dst[m][k] = *(const PG8_LAS bf16x8*)(lds + PG8_SA(b, h) + aoff + m * 2048 + k * 1024); } while (0)
#define PG8_LDB(dst, b, h) do { _Pragma("unroll") for (int n = 0; n < 2; ++n) _Pragma("unroll") for (int k = 0; k < 2; ++k) dst[n][k] = *(const PG8_LAS bf16x8*)(lds + PG8_SB(b, h) + boff + n * 2048 + k * 1024); } while (0)
#define PG8_MMA(ai, bj, At, Bt) do { __builtin_amdgcn_s_setprio(1); _Pragma("unroll") for (int m = 0; m < 4; ++m) _Pragma("unroll") for (int n = 0; n < 2; ++n) _Pragma("unroll") for (int k = 0; k < 2; ++k) \
        acc[ai][bj][m][n] = __builtin_amdgcn_mfma_f32_16x16x32_bf16(Bt[n][k], At[m][k], acc[ai][bj][m][n], 0, 0, 0); __builtin_amdgcn_s_setprio(0); } while (0)
#define PG8_WAIT_V(n) asm volatile("s_waitcnt vmcnt(" #n ")" ::: "memory")
#define PG8_WAIT_L(n) asm volatile("s_waitcnt lgkmcnt(" #n ")" ::: "memory")
#define PG8_BAR __builtin_amdgcn_s_barrier()
#define PG8_SCHED __builtin_amdgcn_sched_barrier(0)
    Unit cur, nxt; int ui = 0;
    if (!S.next(0, cur)) return;
    f32x4 acc[2][2][4][2];
#pragma unroll
    for (int a = 0; a < 2; ++a)
#pragma unroll
        for (int b = 0; b < 2; ++b)
#pragma unroll
            for (int m = 0; m < 4; ++m)
#pragma unroll
                for (int n = 0; n < 2; ++n) acc[a][b][m][n] = (f32x4){0.f, 0.f, 0.f, 0.f};
    bf16x8 At[4][2], B0[2][2], B1[2][2];
    const char* cA = (const char*)g.A + (size_t)cur.pm * tstep; const char* cB = (const char*)g.Bt + (size_t)cur.pn * tstep;
    S.a_ready(cur);
    if constexpr (SP2) {
        PG8_STAGE(PG8_SB(0, 0), cB, voffB); PG8_STAGE(PG8_SB(0, 1), cB + hstep, voffB); PG8_STAGE(PG8_SA(0, 0), cA, voffA); PG8_STAGE(PG8_SA(0, 1), cA + hstep, voffA);
        if (wr == 1) PG8_BAR;
        PG8_WAIT_V(2); PG8_BAR;
        PG8_STAGE(PG8_SB(1, 0), cB + kstep, voffB); PG8_STAGE(PG8_SA(1, 0), cA + kstep, voffA); PG8_STAGE(PG8_SB(1, 1), cB + hstep + kstep, voffB);
        PG8_WAIT_V(6); PG8_BAR;
    } else {
        PG8_STAGE(PG8_SB(0, 0), cB, voffB); PG8_STAGE(PG8_SA(0, 0), cA, voffA); PG8_STAGE(PG8_SB(0, 1), cB + hstep, voffB); PG8_STAGE(PG8_SA(0, 1), cA + hstep, voffA);
        if (wr == 1) PG8_BAR;
        PG8_WAIT_V(4); PG8_BAR;
        PG8_STAGE(PG8_SB(1, 0), cB + kstep, voffB); PG8_STAGE(PG8_SA(1, 0), cA + kstep, voffA); PG8_STAGE(PG8_SB(1, 1), cB + hstep + kstep, voffB);
        PG8_WAIT_V(6); PG8_BAR;
    }
    for (;;) {
        const bool has_next = S.next(ui + 1, nxt);
        const char* nA = has_next ? (const char*)g.A + (size_t)nxt.pm * tstep : cA; const char* nB = has_next ? (const char*)g.Bt + (size_t)nxt.pn * tstep : cB;
        for (int t = 0; t < nt; t += 2) {
            const bool last = (t == nt - 2);
            const char* a1 = cA + (size_t)(t + 1) * kstep;
            const char* a2 = last ? nA : cA + (size_t)(t + 2) * kstep; const char* b2 = last ? nB : cB + (size_t)(t + 2) * kstep;
            const char* a3 = a2 + kstep; const char* b3 = b2 + kstep;
            if (last && has_next) S.a_ready(nxt);
            if constexpr (SP2) {
            PG8_LDB(B0, 0, 0); PG8_LDB(B1, 0, 1); PG8_SCHED; PG8_LDA(At, 0, 0); PG8_STAGE(PG8_SA(1, 1), a1 + hstep, voffA);
            PG8_WAIT_V(8); PG8_WAIT_L(0); PG8_BAR; PG8_MMA(0, 0, At, B0); PG8_MMA(0, 1, At, B1); PG8_BAR; PG8_SCHED;
            PG8_LDA(At, 0, 1); PG8_STAGE(PG8_SB(0, 0), b2, voffB); PG8_STAGE(PG8_SB(0, 1), b2 + hstep, voffB); PG8_STAGE(PG8_SA(0, 0), a2, voffA);
            PG8_WAIT_V(8); PG8_WAIT_L(0); PG8_BAR; PG8_MMA(1, 0, At, B0); PG8_MMA(1, 1, At, B1); PG8_BAR; PG8_SCHED;
            PG8_LDB(B0, 1, 0); PG8_LDB(B1, 1, 1); PG8_SCHED; PG8_LDA(At, 1, 0); PG8_STAGE(PG8_SA(0, 1), a2 + hstep, voffA);
            PG8_WAIT_V(8); PG8_WAIT_L(0); PG8_BAR; PG8_MMA(0, 0, At, B0); PG8_MMA(0, 1, At, B1); PG8_BAR; PG8_SCHED;
            PG8_LDA(At, 1, 1); PG8_STAGE(PG8_SB(1, 0), b3, voffB); PG8_STAGE(PG8_SB(1, 1), b3 + hstep, voffB); PG8_STAGE(PG8_SA(1, 0), a3, voffA);
            PG8_WAIT_V(8); PG8_WAIT_L(0); PG8_BAR; PG8_MMA(1, 0, At, B0); PG8_MMA(1, 1, At, B1); PG8_BAR; PG8_SCHED;
            } else {
            PG8_LDB(B0, 0, 0); PG8_SCHED; PG8_LDA(At, 0, 0); PG8_STAGE(PG8_SA(1, 1), a1 + hstep, voffA);
            PG8_WAIT_L(8); PG8_BAR; PG8_WAIT_L(0); PG8_MMA(0, 0, At, B0); PG8_BAR; PG8_SCHED;
            PG8_LDB(B1, 0, 1); PG8_STAGE(PG8_SB(0, 0), b2, voffB);
            PG8_BAR; PG8_WAIT_L(0); PG8_MMA(0, 1, At, B1); PG8_BAR;
            PG8_LDA(At, 0, 1); PG8_STAGE(PG8_SA(0, 0), a2, voffA);
            PG8_BAR; PG8_WAIT_L(0); PG8_MMA(1, 0, At, B0); PG8_BAR; PG8_SCHED;
            PG8_STAGE(PG8_SB(0, 1), b2 + hstep, voffB);
            PG8_WAIT_V(6); PG8_BAR; PG8_MMA(1, 1, At, B1); PG8_BAR;
            PG8_LDB(B0, 1, 0); PG8_SCHED; PG8_LDA(At, 1, 0); PG8_STAGE(PG8_SA(0, 1), a2 + hstep, voffA);
            PG8_WAIT_L(8); PG8_BAR; PG8_WAIT_L(0); PG8_MMA(0, 0, At, B0); PG8_BAR; PG8_SCHED;
            PG8_LDB(B1, 1, 1); PG8_STAGE(PG8_SB(1, 0), b3, voffB);
            PG8_BAR; PG8_WAIT_L(0); PG8_MMA(0, 1, At, B1); PG8_BAR;
            PG8_LDA(At, 1, 1); PG8_STAGE(PG8_SA(1, 0), a3, voffA);
            PG8_BAR; PG8_WAIT_L(0); PG8_MMA(1, 0, At, B0); PG8_BAR; PG8_SCHED;
            PG8_STAGE(PG8_SB(1, 1), b3 + hstep, voffB);
            PG8_WAIT_V(6); PG8_BAR; PG8_MMA(1, 1, At, B1); PG8_BAR;
            }
        }
        if constexpr (ALIGN_EPI) { if (wr == 0) PG8_BAR; }
        if constexpr (!Epi::AFTER_DRAIN) { E(acc, cur, wr, wc, fr, fq); S.done(cur); }
        if (!has_next) break;
#pragma unroll
        for (int a = 0; a < 2; ++a)
#pragma unroll
            for (int b = 0; b < 2; ++b)
#pragma unroll
                for (int m = 0; m < 4; ++m)
#pragma unroll
                    for (int n = 0; n < 2; ++n) acc[a][b][m][n] = (f32x4){0.f, 0.f, 0.f, 0.f};
        cur = nxt; cA = nA; cB = nB; ++ui;
        if constexpr (ALIGN_EPI) { if (wr == 1) PG8_BAR; }
    }
    PG8_WAIT_V(0);
    if constexpr (!ALIGN_EPI) { if (wr == 0) PG8_BAR; }
    PG8_BAR;
    if constexpr (Epi::AFTER_DRAIN) { E.fused(acc, cur, wr, wc, fr, fq, lds, wid, lane); S.done(cur); }
#undef PG8_SA
#undef PG8_SB
#undef PG8_STAGE
#undef PG8_LDA
#undef PG8_LDB
#undef PG8_MMA
#undef PG8_WAIT_V
#undef PG8_WAIT_L
#undef PG8_BAR
#undef PG8_SCHED
}
}
#define GAS __attribute__((address_space(1)))
#define LAS __attribute__((address_space(3)))
typedef unsigned short bf16;
typedef unsigned v4u __attribute__((ext_vector_type(4)));
typedef float f32x4 __attribute__((ext_vector_type(4)));
typedef short bf16x8 __attribute__((ext_vector_type(8)));
typedef GAS unsigned gu32;
typedef GAS unsigned long long gu64;
#define RLX_AGENT __ATOMIC_RELAXED, __HIP_MEMORY_SCOPE_AGENT
#define LDS_WAIT() asm volatile("s_waitcnt lgkmcnt(0)" ::: "memory")
#define VM_WAIT() asm volatile("s_waitcnt vmcnt(0)" ::: "memory")
__device__ __forceinline__ unsigned long long rt() { return __builtin_amdgcn_s_memrealtime(); }
__device__ __forceinline__ unsigned f2bf(float f) { unsigned u = __builtin_bit_cast(unsigned, f); return (u + 0x7fffu + ((u >> 16) & 1u)) >> 16; }
__device__ __forceinline__ unsigned pk2(float lo, float hi) { return f2bf(lo) | (f2bf(hi) << 16); }
#define XB_TMO      128
#define XB_XCNT(j)  (256  + 64 * (j))
#define XB_XSUB(j)  (1280 + 64 * (j))
#define XB_XGEN(j)  (2304 + 64 * (j))
#define XB_TOP      3328
#define XB_TOPGEN   3392
#define XCD_BAR_WORDS 3456
#define XB_SPIN_CAP (1u << 18)

__device__ __forceinline__ unsigned xb_ld(unsigned* p)              { return __hip_atomic_load(p, __ATOMIC_RELAXED, __HIP_MEMORY_SCOPE_AGENT); }
__device__ __forceinline__ unsigned xb_add(unsigned* p, unsigned v) { return __hip_atomic_fetch_add(p, v, __ATOMIC_RELAXED, __HIP_MEMORY_SCOPE_AGENT); }
__device__ __forceinline__ unsigned xb_xcc_id() { return (unsigned)__builtin_amdgcn_s_getreg((3 << 11) | 20) & 0xFu; }
#define XB_SPIN(cond, bar) do { unsigned _sp = 0; while (cond) { __builtin_amdgcn_s_sleep(1); \
    if ((++_sp & 255u) == 0u) { if (xb_ld(&(bar)[XB_TMO])) break; if (_sp > XB_SPIN_CAP) { atomicAdd(&(bar)[XB_TMO], 1u); break; } } } } while (0)

struct XcdBarrier {
    unsigned* bar; unsigned x;
    volatile LAS unsigned* st;
};

__device__ __forceinline__ XcdBarrier xcd_barrier_post(unsigned* bar, volatile LAS unsigned* st) {
    XcdBarrier b; b.bar = bar; b.x = xb_xcc_id(); b.st = st;
    if (threadIdx.x == 0) (void)xb_add(&bar[XB_XCNT(b.x)], 1u);
    return b;
}
__device__ __forceinline__ void xcd_barrier_complete(unsigned* bar, unsigned x, unsigned& nloc, unsigned& nx) {
    const unsigned G = gridDim.x * gridDim.y * gridDim.z;
    unsigned sum, cnt, mine, sp = 0u;
    for (;;) {
        sum = 0u; cnt = 0u; mine = 0u;
#pragma unroll
        for (unsigned j = 0; j < 16; ++j) { const unsigned c = xb_ld(&bar[XB_XCNT(j)]); sum += c; cnt += (c > 0u) ? 1u : 0u; mine = (j == x) ? c : mine; }
        if (sum == G) break;
        __builtin_amdgcn_s_sleep(1);
        if ((++sp & 255u) == 0u) { if (xb_ld(&bar[XB_TMO])) break; if (sp > XB_SPIN_CAP) { atomicAdd(&bar[XB_TMO], 1u); break; } }
    }
    nloc = mine > 0u ? mine : 1u; nx = cnt > 0u ? cnt : 1u;
}

__device__ __forceinline__ void xcd_barrier(const XcdBarrier& b) {
    asm volatile("s_waitcnt vmcnt(0)" ::: "memory");
    __syncthreads();
    if (threadIdx.x == 0) {
        unsigned* bar = b.bar;
        __builtin_amdgcn_s_waitcnt(0);
        unsigned nloc = b.st[0], nx = b.st[1];
        if (nloc == 0u) { xcd_barrier_complete(bar, b.x, nloc, nx); b.st[0] = nloc; b.st[1] = nx; }
        const unsigned old = xb_add(&bar[XB_XSUB(b.x)], 1u);
        const unsigned gen = old / nloc;
        if (old + 1u == (gen + 1u) * nloc) {
            __builtin_amdgcn_fence(__ATOMIC_RELEASE, "agent");
            asm volatile("s_waitcnt vmcnt(0)" ::: "memory");
            const unsigned og = xb_add(&bar[XB_TOP], 1u);
            const unsigned tg = og / nx;
            if (og + 1u == (tg + 1u) * nx) xb_add(&bar[XB_TOPGEN], 1u);
            else XB_SPIN(xb_ld(&bar[XB_TOPGEN]) == tg, bar);
            __builtin_amdgcn_fence(__ATOMIC_ACQUIRE, "agent");
            xb_add(&bar[XB_XGEN(b.x)], 1u);
            asm volatile("s_waitcnt vmcnt(0)" ::: "memory");
        } else {
            XB_SPIN(xb_ld(&bar[XB_XGEN(b.x)]) == gen, bar);
            __builtin_amdgcn_fence(__ATOMIC_ACQUIRE, "agent");
            asm volatile("s_waitcnt vmcnt(0)" ::: "memory");
        }
    }
    __syncthreads();
}
#ifndef PG8_SP2
#define PG8_SP2 true
#endif
#ifndef PG8_ALIGN
#define PG8_ALIGN true
#endif
constexpr int NWAVES = 8, NTHR = NWAVES * 64;
constexpr int BATCH = 4, SEQ = 2048, DM = 4096, NMETA = 16;
constexpr int MR = BATCH * SEQ;
constexpr int MROWS = MR + NMETA;
constexpr int MT = 8448;
constexpr int NIN = 32784;
constexpr int N1 = 33024;
constexpr int DFF = 11008, NF = 2 * DFF;
constexpr int RET_H = 8, RET_DK = 256, RET_DV = 512, GLA_H = 4, GLA_DK = 512, GLA_DV = 1024, GLA_RANK = 16;
constexpr float EPS = 1e-6f;
constexpr int C_QR = 0, C_KR = 2048, C_VR = 4096, C_OR = 8192, C_QG = 12288, C_KG = 14336, C_VG = 16384, C_OG = 20480, C_MR = 24576, C_MG = 28672, C_Z = 32768;
constexpr int NPH = 10;
#ifndef MK_N_LAUNCHES
#define MK_N_LAUNCHES 1
#endif
constexpr int N_LAUNCHES = MK_N_LAUNCHES;

constexpr size_t al256(size_t x) { return (x + 255) & ~(size_t)255; }
constexpr size_t WS_CTL = 0, CTL_ZERO_BYTES = 1u << 20;
constexpr size_t WS_W1T = WS_CTL + CTL_ZERO_BYTES;
constexpr size_t WS_WOT = WS_W1T + al256((size_t)N1 * DM * 2);
constexpr size_t WS_WFT = WS_WOT + al256((size_t)DM * DM * 2);
constexpr size_t WS_W2T = WS_WFT + al256((size_t)NF * DM * 2);
constexpr size_t WS_XB  = WS_W2T + al256((size_t)DM * DFF * 2);
constexpr size_t WS_RS1 = WS_XB + al256((size_t)MT * DM * 2);
constexpr size_t WS_RS2 = WS_RS1 + al256((size_t)MT * 4);
constexpr size_t WS_ZB  = WS_RS2 + al256((size_t)MT * 4);
constexpr size_t WS_COS = WS_ZB + al256((size_t)MT * 16 * 4);
constexpr size_t WS_SIN = WS_COS + al256((size_t)MROWS * 128 * 4);
constexpr size_t WS_PROJ = WS_SIN + al256((size_t)MROWS * 128 * 4);
constexpr size_t WS_UG  = WS_PROJ;
constexpr size_t WS_ACT = WS_UG + al256((size_t)MT * NF * 2);
constexpr size_t WS_YR  = WS_PROJ + al256((size_t)MT * N1 * 2);
constexpr size_t WS_YG  = WS_YR + al256((size_t)MROWS * DM * 4);
constexpr size_t WS_MRG = WS_YG + al256((size_t)MROWS * DM * 4);
constexpr size_t WS_H1  = WS_MRG + al256((size_t)MT * DM * 2);
constexpr size_t WS_H1B = WS_H1 + al256((size_t)MT * DM * 4);
constexpr size_t WS_END = WS_H1B + al256((size_t)MT * DM * 2);
static_assert(WS_ACT + (size_t)MR * DFF * 2 <= WS_YR, "UG | ACT overlay fits inside PROJ");
static_assert(WS_END <= (size_t)4 * 4096 * NIN * 4, "workspace map fits 4 x the largest tensor");
constexpr int CW_TMO = 0, CW_CODE = 1, CW_BAR = 4096;

constexpr int RING_OFF = 0, RING_BYTES = 131072;
constexpr int LDSCTL_OFF = RING_BYTES, MISC_OFF = LDSCTL_OFF + 320;
constexpr int LDS_BYTES = 147456;
static_assert(MISC_OFF + 128 <= LDS_BYTES, "LDS map");

__device__ __forceinline__ float bf2f(bf16 v) { return __builtin_bit_cast(float, (unsigned)v << 16); }
__device__ __forceinline__ float wave_sum(float v) {
#pragma unroll
    for (int o = 1; o < 64; o <<= 1) v += __shfl_xor(v, o);
    return v;
}
__device__ __forceinline__ float sigm(float x) { return 1.f / (1.f + __expf(-x)); }
__device__ __forceinline__ float silu(float x) { return x / (1.f + __expf(-x)); }
__device__ __forceinline__ float logsig(float x) { return fminf(x, 0.f) - log1pf(__expf(-fabsf(x))); }

struct Frame {
    LAS unsigned char* lds;
    volatile LAS unsigned* MISC;
    gu32* ctl;
    int tid, lane, wave, G;
    const float *x, *meta, *attn_norm, *w_in, *w_gate_up, *b_gate, *ret_norm, *gla_norm, *w_out, *ffn_norm, *w_ffn_in, *conv_w, *conv_b, *w_ffn_out, *final_norm;
    const int* positions;
    float* out;
    bf16 *W1t, *Wot, *Wft, *W2t, *XB, *PROJ, *UG, *ACT, *MRG, *H1B;
    float *RS1, *RS2, *ZB, *COS, *SIN, *YR, *YG, *H1;
};

namespace pg8 {
struct EpiG1 {
    static constexpr bool PERM = true, AFTER_DRAIN = false;
    bf16_t* O; int ldc; const float* rs; float* zb;
    __device__ __forceinline__ void operator()(const f32x4 (&acc)[2][2][4][2], const Unit& u, int wr, int wc, int fr, int fq) const {
        const int row0 = u.pm * BM + wr * 64 + fr, col0 = u.pn * BM + wc * 32 + 8 * fq;
#pragma unroll
        for (int ai = 0; ai < 2; ++ai)
#pragma unroll
            for (int m = 0; m < 4; ++m) { const int row = row0 + ai * HALF + m * 16; const float s = rs[row]; bf16_t* rowp = O + (size_t)row * ldc + col0;
#pragma unroll
                for (int bj = 0; bj < 2; ++bj) { const f32x4 v0 = acc[ai][bj][m][0] * s, v1 = acc[ai][bj][m][1] * s;
                    u32x4 w; w.x = cvt_pk_bf16(v0[0], v0[1]); w.y = cvt_pk_bf16(v0[2], v0[3]); w.z = cvt_pk_bf16(v1[0], v1[1]); w.w = cvt_pk_bf16(v1[2], v1[3]);
                    *(u32x4*)(rowp + bj * HALF) = w;
                    if (bj == 0 && u.pn == 128 && wc == 0 && fq < 2) { float* zp = zb + (size_t)row * 16 + 8 * fq; *(f32x4*)zp = v0; *(f32x4*)(zp + 4) = v1; } } }
    }
};
struct EpiScaleBf16 {
    static constexpr bool PERM = true, AFTER_DRAIN = false;
    bf16_t* O; int ldc; const float* rs;
    __device__ __forceinline__ void operator()(const f32x4 (&acc)[2][2][4][2], const Unit& u, int wr, int wc, int fr, int fq) const {
        const int row0 = u.pm * BM + wr * 64 + fr, col0 = u.pn * BM + wc * 32 + 8 * fq;
#pragma unroll
        for (int ai = 0; ai < 2; ++ai)
#pragma unroll
            for (int m = 0; m < 4; ++m) { const int row = row0 + ai * HALF + m * 16; const float s = rs[row]; bf16_t* rowp = O + (size_t)row * ldc + col0;
#pragma unroll
                for (int bj = 0; bj < 2; ++bj) { const f32x4 v0 = acc[ai][bj][m][0] * s, v1 = acc[ai][bj][m][1] * s;
                    u32x4 w; w.x = cvt_pk_bf16(v0[0], v0[1]); w.y = cvt_pk_bf16(v0[2], v0[3]); w.z = cvt_pk_bf16(v1[0], v1[1]); w.w = cvt_pk_bf16(v1[2], v1[3]);
                    *(u32x4*)(rowp + bj * HALF) = w; } }
    }
};
struct EpiResX {
    static constexpr bool PERM = false, AFTER_DRAIN = false;
    const float* x; const float* meta; float* out; int ldc; int nreal, nmeta;
    __device__ __forceinline__ void operator()(const f32x4 (&acc)[2][2][4][2], const Unit& u, int wr, int wc, int fr, int fq) const {
        const int row0 = u.pm * BM + wr * 64 + fr, col0 = u.pn * BM + wc * 32 + 4 * fq;
#pragma unroll
        for (int ai = 0; ai < 2; ++ai)
#pragma unroll
            for (int m = 0; m < 4; ++m) { const int row = row0 + ai * HALF + m * 16;
                const float* bp = row < nreal ? x + (size_t)row * ldc : (row < nreal + nmeta ? meta + (size_t)(row - nreal) * ldc : nullptr);
                float* rowp = out + (size_t)row * ldc + col0;
#pragma unroll
                for (int bj = 0; bj < 2; ++bj)
#pragma unroll
                    for (int n = 0; n < 2; ++n) { f32x4 o = (f32x4){0.f, 0.f, 0.f, 0.f};
                        if (bp) o = *(const f32x4*)(bp + col0 + bj * HALF + n * 16) + acc[ai][bj][m][n];
                        *(f32x4*)(rowp + bj * HALF + n * 16) = o; } }
    }
};
struct EpiResF32 {
    static constexpr bool PERM = false, AFTER_DRAIN = false;
    const float* base; float* out; int ldc;
    __device__ __forceinline__ void operator()(const f32x4 (&acc)[2][2][4][2], const Unit& u, int wr, int wc, int fr, int fq) const {
        const int row0 = u.pm * BM + wr * 64 + fr, col0 = u.pn * BM + wc * 32 + 4 * fq;
#pragma unroll
        for (int ai = 0; ai < 2; ++ai)
#pragma unroll
            for (int m = 0; m < 4; ++m) { const size_t off = (size_t)(row0 + ai * HALF + m * 16) * ldc + col0;
#pragma unroll
                for (int bj = 0; bj < 2; ++bj)
#pragma unroll
                    for (int n = 0; n < 2; ++n) *(f32x4*)(out + off + bj * HALF + n * 16) = *(const f32x4*)(base + off + bj * HALF + n * 16) + acc[ai][bj][m][n]; }
    }
};
}

__device__ __forceinline__ void p0_transpose_item(const float* W, int K, int ldw, int c0, int nc, bf16* WT, int row_off, const float* kscale, LAS float* scr, int item, int lane) {
    const int nblk = (nc + 31) / 32, kb = item / nblk, nb = item % nblk, k0 = 64 * kb, n0 = 32 * nb;
    const int n = n0 + (lane & 31); const bool ok = n < nc;
#pragma unroll 8
    for (int i = 0; i < 32; ++i) { const int kk = 2 * i + (lane >> 5);
        float v = ok ? W[(size_t)(k0 + kk) * ldw + c0 + n] : 0.f;
        if (kscale) v *= kscale[k0 + kk];
        scr[kk * 33 + (lane & 31)] = v; }
    LDS_WAIT(); asm volatile("" ::: "memory");
    const int c = lane & 7;
#pragma unroll
    for (int j = 0; j < 4; ++j) { const int nn = (lane >> 3) + 8 * j; const LAS float* s = scr + (8 * c) * 33 + nn;
        v4u o; o.x = pk2(s[0 * 33], s[1 * 33]); o.y = pk2(s[2 * 33], s[3 * 33]); o.z = pk2(s[4 * 33], s[5 * 33]); o.w = pk2(s[6 * 33], s[7 * 33]);
        *(GAS v4u*)(WT + (size_t)(row_off + n0 + nn) * K + k0 + 8 * c) = o; }
    LDS_WAIT(); asm volatile("" ::: "memory");
}
__device__ __forceinline__ void p0_prologue(Frame& F) {
    LAS float* scr = (LAS float*)(F.lds + RING_OFF + F.wave * 16384);
    const int gw = blockIdx.x * NWAVES + F.wave, NGW = F.G * NWAVES;
    constexpr int I_A = 64 * (24576 / 32), I_Z = 64, I_M = 64 * (8192 / 32), I_O = 64 * (DM / 32), I_F = 64 * (NF / 32), I_2 = (DFF / 64) * (DM / 32);
    constexpr int NITEMS = I_A + I_Z + I_M + I_O + I_F + I_2;
    for (int it = gw; it < NITEMS; it += NGW) {
        int r = it;
        if (r < I_A) { p0_transpose_item(F.w_in, DM, NIN, 0, 24576, F.W1t, 0, F.attn_norm, scr, r, F.lane); continue; } r -= I_A;
        if (r < I_Z) { p0_transpose_item(F.w_in, DM, NIN, 24576, 16, F.W1t, C_Z, F.attn_norm, scr, r, F.lane); continue; } r -= I_Z;
        if (r < I_M) { p0_transpose_item(F.w_in, DM, NIN, 24592, 8192, F.W1t, C_MR, F.attn_norm, scr, r, F.lane); continue; } r -= I_M;
        if (r < I_O) { p0_transpose_item(F.w_out, DM, DM, 0, DM, F.Wot, 0, nullptr, scr, r, F.lane); continue; } r -= I_O;
        if (r < I_F) { p0_transpose_item(F.w_ffn_in, DM, NF, 0, NF, F.Wft, 0, F.ffn_norm, scr, r, F.lane); continue; } r -= I_F;
        p0_transpose_item(F.w_ffn_out, DFF, DM, 0, DM, F.W2t, 0, nullptr, scr, r, F.lane);
    }
    { const size_t n16 = (size_t)(N1 - C_Z - 32) * DM * 2 / 16; GAS v4u* p = (GAS v4u*)(F.W1t + (size_t)(C_Z + 32) * DM);
      for (size_t i = (size_t)blockIdx.x * NTHR + F.tid; i < n16; i += (size_t)F.G * NTHR) p[i] = (v4u){0u, 0u, 0u, 0u}; }
    for (int m = gw; m < MT; m += NGW) {
        GAS unsigned long long* o8 = (GAS unsigned long long*)(F.XB + (size_t)m * DM) + F.lane;
        if (m < MROWS) {
            const float* xrow = m < MR ? F.x + (size_t)m * DM : F.meta + (size_t)(m - MR) * DM;
            const GAS f32x4* xr = (const GAS f32x4*)xrow + F.lane; float ss = 0.f;
#pragma unroll
            for (int j = 0; j < 16; ++j) { const f32x4 v = xr[64 * j]; ss += (v.x * v.x + v.y * v.y) + (v.z * v.z + v.w * v.w);
                o8[64 * j] = (unsigned long long)pk2(v.x, v.y) | ((unsigned long long)pk2(v.z, v.w) << 32); }
            ss = wave_sum(ss);
            if (F.lane == 0) F.RS1[m] = 1.0f / sqrtf(ss * (1.0f / DM) + EPS);
        } else {
            GAS unsigned long long* o2 = (GAS unsigned long long*)(F.MRG + (size_t)m * DM) + F.lane;
            GAS unsigned long long* o3 = (GAS unsigned long long*)(F.H1B + (size_t)m * DM) + F.lane;
#pragma unroll
            for (int j = 0; j < 16; ++j) { o8[64 * j] = 0ull; o2[64 * j] = 0ull; o3[64 * j] = 0ull; }
            if (F.lane == 0) { F.RS1[m] = 0.f; F.RS2[m] = 0.f; }
        }
    }
    for (int i = blockIdx.x * NTHR + F.tid; i < MROWS * 128; i += F.G * NTHR) {
        const int m = i >> 7, j = i & 127;
        const int pos = m < MR ? F.positions[m] + NMETA : m - MR;
        const float inv_freq = powf(10000.0f, -(float)j * (1.0f / 128.0f));
        const float ang = (float)pos * inv_freq; float s, c; sincosf(ang, &s, &c);
        F.COS[i] = c; F.SIN[i] = s;
    }
}

template <bool GLA> __device__ __forceinline__ void scan_unit(Frame& F, int u) {
    constexpr int DK = GLA ? GLA_DK : RET_DK, DV = GLA ? GLA_DV : RET_DV, DKG = DK / 8, NSL = DV / 64, NH = GLA ? GLA_H : RET_H;
    const int b = u / (NH * NSL), h = (u / NSL) % NH, sl = u % NSL;
    LAS float* qs = (LAS float*)F.lds; LAS float* ks = qs + 512; LAS float* as_ = ks + 512; LAS float* red = as_ + 512;
    const int tid = F.tid, v = tid & 63, g = tid >> 6;
    float S[DKG];
#pragma unroll
    for (int i = 0; i < DKG; ++i) S[i] = 0.f;
    const float gamma = 1.0f - exp2f(-5.0f - (float)h);
    float* Y = GLA ? F.YG : F.YR;
    for (int tt = 0; tt < NMETA + SEQ; ++tt) {
        const int row = tt < NMETA ? MR + tt : b * SEQ + tt - NMETA;
        const bf16* pr = F.PROJ + (size_t)row * N1;
        if (!GLA) {
            if (tid < 128) {
                const float c = F.COS[row * 128 + tid], s = F.SIN[row * 128 + tid];
                const float q1 = bf2f(pr[C_QR + h * 256 + tid]), q2 = bf2f(pr[C_QR + h * 256 + 128 + tid]);
                const float k1 = bf2f(pr[C_KR + h * 256 + tid]), k2 = bf2f(pr[C_KR + h * 256 + 128 + tid]);
                qs[tid] = q1 * c - q2 * s; qs[tid + 128] = q2 * c + q1 * s;
                ks[tid] = (k1 * c - k2 * s) * 0.0625f; ks[tid + 128] = (k2 * c + k1 * s) * 0.0625f;
            }
        } else {
            const int d = tid, ch = h * GLA_DK + d;
            float lg = F.b_gate[ch];
            const float* zr = F.ZB + (size_t)row * 16;
#pragma unroll
            for (int r = 0; r < GLA_RANK; ++r) lg += zr[r] * F.w_gate_up[r * 2048 + ch];
            as_[d] = __expf(logsig(lg) * (1.0f / 16.0f));
            qs[d] = bf2f(pr[C_QG + ch]) * 0.04419417382415922f;
            ks[d] = bf2f(pr[C_KG + ch]);
        }
        __syncthreads();
        const float vv = bf2f(pr[(GLA ? C_VG : C_VR) + h * DV + sl * 64 + v]);
        float o = 0.f;
#pragma unroll
        for (int i = 0; i < DKG; ++i) { const int d = g * DKG + i; const float a = GLA ? as_[d] : gamma;
            S[i] = a * S[i] + ks[d] * vv; o += qs[d] * S[i]; }
        red[g * 64 + v] = o;
        __syncthreads();
        if (g == 0 && (tt >= NMETA || b == 0)) {
            float t = 0.f;
#pragma unroll
            for (int gg = 0; gg < 8; ++gg) t += red[gg * 64 + v];
            Y[(size_t)row * DM + h * DV + sl * 64 + v] = t;
        }
    }
    __syncthreads();
}
__device__ __forceinline__ void p2_scan(Frame& F) {
    for (int unit = blockIdx.x; unit < 512; unit += F.G) {
        if (unit < 256) scan_unit<false>(F, unit); else scan_unit<true>(F, unit - 256);
    }
}

__device__ __forceinline__ void p3_merge(Frame& F) {
    const int gw = blockIdx.x * NWAVES + F.wave, NGW = F.G * NWAVES, lane = F.lane;
    for (int m = gw; m < MROWS; m += NGW) {
        const bf16* pr = F.PROJ + (size_t)m * N1;
#pragma unroll 1
        for (int hg = 0; hg < 4; ++hg) {
            f32x4 yr[4], yg[4];
#pragma unroll
            for (int j = 0; j < 4; ++j) { const int c = hg * 1024 + j * 256 + lane * 4; yr[j] = *(const f32x4*)(F.YR + (size_t)m * DM + c); yg[j] = *(const f32x4*)(F.YG + (size_t)m * DM + c); }
            float sg = 0.f, sa = 0.f, sb = 0.f;
#pragma unroll
            for (int j = 0; j < 4; ++j) { sg += (yg[j].x * yg[j].x + yg[j].y * yg[j].y) + (yg[j].z * yg[j].z + yg[j].w * yg[j].w);
                const float t = (yr[j].x + yr[j].y) + (yr[j].z + yr[j].w); if (j < 2) sa += t; else sb += t; }
            sg = wave_sum(sg); sa = wave_sum(sa); sb = wave_sum(sb);
            const float rg = 1.0f / sqrtf(sg * (1.0f / 1024.0f) + EPS), ma = sa * (1.0f / 512.0f), mb = sb * (1.0f / 512.0f);
            float qa = 0.f, qb = 0.f;
#pragma unroll
            for (int j = 0; j < 4; ++j) { const float mu = j < 2 ? ma : mb; yr[j] = yr[j] - mu;
                const float t = (yr[j].x * yr[j].x + yr[j].y * yr[j].y) + (yr[j].z * yr[j].z + yr[j].w * yr[j].w); if (j < 2) qa += t; else qb += t; }
            qa = wave_sum(qa); qb = wave_sum(qb);
            const float ra = 1.0f / sqrtf(qa * (1.0f / 512.0f) + EPS), rb = 1.0f / sqrtf(qb * (1.0f / 512.0f) + EPS);
#pragma unroll
            for (int j = 0; j < 4; ++j) { const int c = hg * 1024 + j * 256 + lane * 4; const float rr = j < 2 ? ra : rb;
                const f32x4 gr = *(const f32x4*)(F.ret_norm + c), gg = *(const f32x4*)(F.gla_norm + c);
                const unsigned long long wor = *(const unsigned long long*)(pr + C_OR + c), wmr = *(const unsigned long long*)(pr + C_MR + c);
                const unsigned long long wog = *(const unsigned long long*)(pr + C_OG + c), wmg = *(const unsigned long long*)(pr + C_MG + c);
                float res[4];
#pragma unroll
                for (int e = 0; e < 4; ++e) {
                    const float o_r = bf2f((bf16)(wor >> (16 * e))), m_r = bf2f((bf16)(wmr >> (16 * e))), o_g = bf2f((bf16)(wog >> (16 * e))), m_g = bf2f((bf16)(wmg >> (16 * e)));
                    const float yrn = yr[j][e] * rr * gr[e], ygn = yg[j][e] * rg * gg[e];
                    res[e] = sigm(m_r) * (yrn * silu(o_r)) + sigm(m_g) * (ygn * silu(o_g)); }
                *(unsigned long long*)(F.MRG + (size_t)m * DM + c) = (unsigned long long)pk2(res[0], res[1]) | ((unsigned long long)pk2(res[2], res[3]) << 32); }
        }
    }
}

__device__ __forceinline__ void p5_rows(Frame& F) {
    const int gw = blockIdx.x * NWAVES + F.wave, NGW = F.G * NWAVES;
    for (int m = gw; m < MROWS; m += NGW) {
        const GAS f32x4* xr = (const GAS f32x4*)(F.H1 + (size_t)m * DM) + F.lane; float ss = 0.f;
        GAS unsigned long long* o8 = (GAS unsigned long long*)(F.H1B + (size_t)m * DM) + F.lane;
#pragma unroll
        for (int j = 0; j < 16; ++j) { const f32x4 v = xr[64 * j]; ss += (v.x * v.x + v.y * v.y) + (v.z * v.z + v.w * v.w);
            o8[64 * j] = (unsigned long long)pk2(v.x, v.y) | ((unsigned long long)pk2(v.z, v.w) << 32); }
        ss = wave_sum(ss);
        if (F.lane == 0) F.RS2[m] = 1.0f / sqrtf(ss * (1.0f / DM) + EPS);
    }
}

__device__ __forceinline__ void p7_act(Frame& F) {
    constexpr int FB = DFF / 8;
    for (size_t i = (size_t)blockIdx.x * NTHR + F.tid; i < (size_t)MR * FB; i += (size_t)F.G * NTHR) {
        const int m = (int)(i / FB), f = (int)(i % FB) * 8, t = m & (SEQ - 1);
        const int r1 = t >= 1 ? m - 1 : MR + 15, r2 = t >= 2 ? m - 2 : MR + 14 + t;
        const v4u u0 = *(const v4u*)(F.UG + (size_t)m * NF + f), u1 = *(const v4u*)(F.UG + (size_t)r1 * NF + f), u2 = *(const v4u*)(F.UG + (size_t)r2 * NF + f), gt = *(const v4u*)(F.UG + (size_t)m * NF + DFF + f);
        float res[8];
#pragma unroll
        for (int e = 0; e < 8; ++e) { const unsigned sh = 16 * (e & 1);
            const float a0 = bf2f((bf16)(u0[e >> 1] >> sh)), a1 = bf2f((bf16)(u1[e >> 1] >> sh)), a2 = bf2f((bf16)(u2[e >> 1] >> sh)), gv = bf2f((bf16)(gt[e >> 1] >> sh));
            const float c = F.conv_b[f + e] + F.conv_w[f + e] * a2 + F.conv_w[DFF + f + e] * a1 + F.conv_w[2 * DFF + f + e] * a0;
            res[e] = silu(c) * gv; }
        v4u o; o.x = pk2(res[0], res[1]); o.y = pk2(res[2], res[3]); o.z = pk2(res[4], res[5]); o.w = pk2(res[6], res[7]);
        *(v4u*)(F.ACT + (size_t)m * DFF + f) = o;
    }
}

__device__ __forceinline__ void p9_final(Frame& F) {
    const int gw = blockIdx.x * NWAVES + F.wave, NGW = F.G * NWAVES;
    for (int m = gw; m < MR; m += NGW) {
        GAS f32x4* xr = (GAS f32x4*)(F.out + (size_t)m * DM) + F.lane; f32x4 v[16]; float ss = 0.f;
#pragma unroll
        for (int j = 0; j < 16; ++j) { v[j] = xr[64 * j]; ss += (v[j].x * v[j].x + v[j].y * v[j].y) + (v[j].z * v[j].z + v[j].w * v[j].w); }
        ss = wave_sum(ss); const float r = 1.0f / sqrtf(ss * (1.0f / DM) + EPS);
#pragma unroll
        for (int j = 0; j < 16; ++j) { const f32x4 g = *((const GAS f32x4*)F.final_norm + F.lane + 64 * j); xr[64 * j] = v[j] * r * g; }
    }
}

struct Args { const void* in[16]; float* out; unsigned char* ws; int ph_lo, ph_hi, li, pad; };
__global__ void __launch_bounds__(NTHR, 2) fwd(Args args) {
    extern __shared__ __attribute__((aligned(16))) unsigned char lds[];
    Frame F;
    F.lds = (LAS unsigned char*)lds;
    F.MISC = (volatile LAS unsigned*)(F.lds + MISC_OFF);
    F.tid = threadIdx.x; F.lane = F.tid & 63; F.wave = __builtin_amdgcn_readfirstlane(F.tid >> 6); F.G = gridDim.x;
    unsigned char* ws = args.ws;
    F.ctl = (gu32*)(ws + WS_CTL);
    F.x = (const float*)args.in[0]; F.positions = (const int*)args.in[1]; F.meta = (const float*)args.in[2]; F.attn_norm = (const float*)args.in[3]; F.w_in = (const float*)args.in[4];
    F.w_gate_up = (const float*)args.in[5]; F.b_gate = (const float*)args.in[6]; F.ret_norm = (const float*)args.in[7]; F.gla_norm = (const float*)args.in[8]; F.w_out = (const float*)args.in[9];
    F.ffn_norm = (const float*)args.in[10]; F.w_ffn_in = (const float*)args.in[11]; F.conv_w = (const float*)args.in[12]; F.conv_b = (const float*)args.in[13]; F.w_ffn_out = (const float*)args.in[14];
    F.final_norm = (const float*)args.in[15]; F.out = args.out;
    F.W1t = (bf16*)(ws + WS_W1T); F.Wot = (bf16*)(ws + WS_WOT); F.Wft = (bf16*)(ws + WS_WFT); F.W2t = (bf16*)(ws + WS_W2T); F.XB = (bf16*)(ws + WS_XB);
    F.PROJ = (bf16*)(ws + WS_PROJ); F.UG = (bf16*)(ws + WS_UG); F.ACT = (bf16*)(ws + WS_ACT); F.MRG = (bf16*)(ws + WS_MRG); F.H1B = (bf16*)(ws + WS_H1B);
    F.RS1 = (float*)(ws + WS_RS1); F.RS2 = (float*)(ws + WS_RS2); F.ZB = (float*)(ws + WS_ZB); F.COS = (float*)(ws + WS_COS); F.SIN = (float*)(ws + WS_SIN);
    F.YR = (float*)(ws + WS_YR); F.YG = (float*)(ws + WS_YG); F.H1 = (float*)(ws + WS_H1);
    for (int u = F.tid; u < (LDS_BYTES - LDSCTL_OFF) / 4; u += NTHR) ((LAS unsigned*)(F.lds + LDSCTL_OFF))[u] = 0u;
    __syncthreads();
    XcdBarrier bar; bar.bar = (unsigned*)(F.ctl + CW_BAR); bar.x = 0; bar.st = nullptr;
    if (N_LAUNCHES != NPH) bar = xcd_barrier_post((unsigned*)(F.ctl + CW_BAR) + args.li * XCD_BAR_WORDS, F.MISC + 8);
#define GRID_BAR(seam) do { if (N_LAUNCHES == NPH) { if (F.tid == 0) __hip_atomic_store(F.ctl + CW_TMO, 0xBADBA0u | (unsigned)(seam), RLX_AGENT); } else { xcd_barrier(bar); } } while (0)
    const int lo = args.ph_lo, hi = args.ph_hi;
#define IN(k) (lo <= (k) && (k) < hi)
#define BOTH(k) (IN(k) && IN((k) + 1))
    if (IN(0)) { p0_prologue(F); if (BOTH(0)) GRID_BAR(0); }
    if (IN(1)) {
        pg8::Gemm g{F.XB, F.W1t, MT, N1, DM}; pg8::StaticOrder S; S.init(MT, N1, F.G, (int)blockIdx.x);
        pg8::EpiG1 E{F.PROJ, N1, F.RS1, F.ZB};
        pg8::gemm_phase<pg8::EpiG1, pg8::StaticOrder, PG8_ALIGN, PG8_SP2>(F.lds + RING_OFF, g, S, E);
        if (BOTH(1)) GRID_BAR(1);
    }
    if (IN(2)) { p2_scan(F); if (BOTH(2)) GRID_BAR(2); }
    if (IN(3)) { p3_merge(F); if (BOTH(3)) GRID_BAR(3); }
    if (IN(4)) {
        pg8::Gemm g{F.MRG, F.Wot, MT, DM, DM}; pg8::StaticOrder S; S.init(MT, DM, F.G, (int)blockIdx.x);
        pg8::EpiResX E{F.x, F.meta, F.H1, DM, MR, NMETA};
        pg8::gemm_phase<pg8::EpiResX, pg8::StaticOrder, PG8_ALIGN, PG8_SP2>(F.lds + RING_OFF, g, S, E);
        if (BOTH(4)) GRID_BAR(4);
    }
    if (IN(5)) { p5_rows(F); if (BOTH(5)) GRID_BAR(5); }
    if (IN(6)) {
        pg8::Gemm g{F.H1B, F.Wft, MT, NF, DM}; pg8::StaticOrder S; S.init(MT, NF, F.G, (int)blockIdx.x);
        pg8::EpiScaleBf16 E{F.UG, NF, F.RS2};
        pg8::gemm_phase<pg8::EpiScaleBf16, pg8::StaticOrder, PG8_ALIGN, PG8_SP2>(F.lds + RING_OFF, g, S, E);
        if (BOTH(6)) GRID_BAR(6);
    }
    if (IN(7)) { p7_act(F); if (BOTH(7)) GRID_BAR(7); }
    if (IN(8)) {
        pg8::Gemm g{F.ACT, F.W2t, MR, DM, DFF}; pg8::StaticOrder S; S.init(MR, DM, F.G, (int)blockIdx.x);
        pg8::EpiResF32 E{F.H1, F.out, DM};
        pg8::gemm_phase<pg8::EpiResF32, pg8::StaticOrder, PG8_ALIGN, PG8_SP2>(F.lds + RING_OFF, g, S, E);
        if (BOTH(8)) GRID_BAR(8);
    }
    if (IN(9)) { p9_final(F); }
#undef IN
#undef BOTH
}

extern "C" void kernel_launch(void* const* d_in, const int* in_sizes, int n_in, void* d_out, int out_size, void* d_ws, size_t ws_size, hipStream_t stream) {
    static int grid = 0;
    if (grid == 0) {
        if (n_in != 16 || in_sizes[0] != MR * DM || out_size != MR * DM || ws_size < WS_END) {
            fprintf(stderr, "kernel_launch: shape/workspace mismatch: n_in %d in0 %d out %d ws %zu (need %zu); nothing launched\n", n_in, n_in > 0 ? in_sizes[0] : -1, out_size, ws_size, (size_t)WS_END); grid = -1; return; }
        int dev = 0, cus = 0, per_cu = 0;
        if (hipGetDevice(&dev) != hipSuccess || hipDeviceGetAttribute(&cus, hipDeviceAttributeMultiprocessorCount, dev) != hipSuccess) { fprintf(stderr, "kernel_launch: device query failed\n"); grid = -1; return; }
        if (hipFuncSetAttribute((const void*)fwd, hipFuncAttributeMaxDynamicSharedMemorySize, LDS_BYTES) != hipSuccess) { fprintf(stderr, "kernel_launch: hipFuncSetAttribute failed\n"); grid = -1; return; }
        if (hipOccupancyMaxActiveBlocksPerMultiprocessor(&per_cu, (const void*)fwd, NTHR, LDS_BYTES) != hipSuccess || per_cu < 1)
            fprintf(stderr, "kernel_launch: note: occupancy query reports %d workgroups per CU\n", per_cu);
        (void)hipGetLastError();
        grid = cus;
    }
    if (grid < 0) return;
    if (hipMemsetAsync((char*)d_ws + WS_CTL, 0, CTL_ZERO_BYTES, stream) != hipSuccess) { fprintf(stderr, "kernel_launch: memset failed\n"); return; }
    Args a{};
    for (int i = 0; i < 16; ++i) a.in[i] = d_in[i];
    a.out = (float*)d_out; a.ws = (unsigned char*)d_ws;
    for (int li = 0; li < N_LAUNCHES; ++li) {
        a.ph_lo = (N_LAUNCHES == NPH) ? li : 0; a.ph_hi = (N_LAUNCHES == NPH) ? li + 1 : NPH; a.li = (N_LAUNCHES == NPH) ? 0 : li;
        hipLaunchKernelGGL(fwd, dim3(grid), dim3(NTHR), LDS_BYTES, stream, a);
        const hipError_t le = hipPeekAtLastError();
        if (le != hipSuccess) { fprintf(stderr, "kernel_launch: launch %d failed: %s\n", li, hipGetErrorName(le)); break; }
    }
}
```

```cpp
#include <hip/hip_runtime.h>
#include <cstdio>
#include <cstdint>
namespace pg8 {
#define PG8_LAS __attribute__((address_space(3)))
typedef unsigned short bf16_t;
typedef short bf16x8 __attribute__((ext_vector_type(8)));
typedef float f32x4 __attribute__((ext_vector_type(4)));
typedef unsigned u32x4 __attribute__((ext_vector_type(4)));
constexpr int BM = 256, BK = 64, HALF = 128, HTB = HALF * BK * 2  , STAGE_BYTES = 8 * HTB, NXCD = 8, WGM = 8;

__host__ __device__ __forceinline__ int lds_byte(int r, int c) { const int st = (r >> 4) * 2 + (c >> 5), rr = r & 15, cc = c & 31, ob = rr * 64 + cc * 2; return st * 1024 + (ob ^ (((ob >> 9) & 1) << 5)); }
__host__ __device__ __forceinline__ void stage_rc(int b, int& R, int& C) { const int st = b / 1024, sb = b % 1024, swz = sb ^ (((sb >> 9) & 1) << 5); R = (st >> 1) * 16 + swz / 64; C = (st & 1) * 32 + (swz % 64) / 2; }
__host__ __device__ __forceinline__ int perm32(int rho) { const int n = rho >> 4, i = rho & 15; return 8 * (i >> 2) + 4 * n + (i & 3); }

struct Unit { int pm, pn; };
struct Gemm { const bf16_t* A; const bf16_t* Bt; int M, N, K; };

struct StaticOrder {
    int nM, nN, nwg, G, c;
    __host__ __device__ void init(int M, int N, int G_, int c_) { nM = M / BM; nN = N / BM; nwg = nM * nN; G = G_; c = c_; }
    __host__ __device__ bool next(int i, Unit& u) const {
        const long L = (long)i * G + c; if (L >= nwg) return false;
        int wgid = (int)L; { const int q = nwg / NXCD, r = nwg % NXCD, xcd = wgid % NXCD, off = wgid / NXCD; wgid = (xcd < r ? xcd * (q + 1) : r * (q + 1) + (xcd - r) * q) + off; }
        const int nig = WGM * nN, gid = wgid / nig, fm = gid * WGM, gsz = (nM - fm) < WGM ? (nM - fm) : WGM;
        u.pm = fm + ((wgid % nig) % gsz); u.pn = (wgid % nig) / gsz; return true;
    }
    __device__ __forceinline__ void a_ready(const Unit&) const {}
    __device__ __forceinline__ void done(const Unit&) const {}
};
__device__ __forceinline__ unsigned cvt_pk_bf16(float lo, float hi) { unsigned r; asm volatile("v_cvt_pk_bf16_f32 %0, %1, %2" : "=v"(r) : "v"(lo), "v"(hi)); return r; }
template <class Epi, class Sched, bool ALIGN_EPI = false, bool SP2 = false>
__device__ __forceinline__ void gemm_phase(PG8_LAS unsigned char* lds, const Gemm g, const Sched& S, const Epi& E) {
    const int tid = threadIdx.x, wid = __builtin_amdgcn_readfirstlane(tid >> 6), lane = tid & 63, wr = wid >> 2, wc = wid & 3, fr = lane & 15, fq = lane >> 4;
    const int K = g.K, nt = K / BK;
    unsigned voffA[2], voffB[2];
#pragma unroll
    for (int i = 0; i < 2; ++i) { int R, C; stage_rc(tid * 16 + i * 8192, R, C); const int Rb = Epi::PERM ? ((R & ~31) + perm32(R & 31)) : R;
        voffA[i] = (unsigned)(R * K + C) * 2u; voffB[i] = (unsigned)(Rb * K + C) * 2u; }
    const size_t kstep = (size_t)(BK * 2);
    const size_t hstep = (size_t)HALF * K * 2;
    const size_t tstep = 2 * hstep;
    const unsigned ldsw = (unsigned)wid * 1024u;
    const int aoff = lds_byte(wr * 64 + fr, fq * 8), boff = lds_byte(wc * 32 + fr, fq * 8);
#define PG8_SA(b, h) (((b) * 2 + (h)) * HTB)
#define PG8_SB(b, h) ((4 + (b) * 2 + (h)) * HTB)
#define PG8_STAGE(bufoff, gbase, voff) do { _Pragma("unroll") for (int _i = 0; _i < 2; ++_i) \
        __builtin_amdgcn_global_load_lds((const unsigned*)((const char*)(gbase) + (voff)[_i]), (PG8_LAS unsigned*)(lds + (bufoff) + ldsw + _i * 8192), 16, 0, 0); } while (0)
#define PG8_LDA(dst, b, h) do { _Pragma("unroll") for (int m = 0; m < 4; ++m) _Pragma("unroll") for (int k = 0; k < 2; ++k) dst[m][k] = *(const PG8_LAS bf16x8*)(lds + PG8_SA(b, h) + aoff + m * 2048 + k * 1024); } while (0)
#define PG8_LDB(dst, b, h) do { _Pragma("unroll") for (int n = 0; n < 2; ++n) _Pragma("unroll") for (int k = 0; k < 2; ++k) dst[n][k] = *(const PG8_LAS bf16x8*)(lds + PG8_SB(b, h) + boff + n * 2048 + k * 1024); } while (0)
#define PG8_MMA(ai, bj, At, Bt) do { __builtin_amdgcn_s_setprio(1); _Pragma("unroll") for (int m = 0; m < 4; ++m) _Pragma("unroll") for (int n = 0; n < 2; ++n) _Pragma("unroll") for (int k = 0; k < 2; ++k) \
        acc[ai][bj][m][n] = __builtin_amdgcn_mfma_f32_16x16x32_bf16(Bt[n][k], At[m][k], acc[ai][bj][m][n], 0, 0, 0); __builtin_amdgcn_s_setprio(0); } while (0)
#define PG8_WAIT_V(n) asm volatile("s_waitcnt vmcnt(" #n ")" ::: "memory")
#define PG8_WAIT_L(n) asm volatile("s_waitcnt lgkmcnt(" #n ")" ::: "memory")
#define PG8_BAR __builtin_amdgcn_s_barrier()
#define PG8_SCHED __builtin_amdgcn_sched_barrier(0)
    Unit cur, nxt; int ui = 0;
    if (!S.next(0, cur)) return;
    f32x4 acc[2][2][4][2];
#pragma unroll
    for (int a = 0; a < 2; ++a)
#pragma unroll
        for (int b = 0; b < 2; ++b)
#pragma unroll
            for (int m = 0; m < 4; ++m)
#pragma unroll
                for (int n = 0; n < 2; ++n) acc[a][b][m][n] = (f32x4){0.f, 0.f, 0.f, 0.f};
    bf16x8 At[4][2], B0[2][2], B1[2][2];
    const char* cA = (const char*)g.A + (size_t)cur.pm * tstep; const char* cB = (const char*)g.Bt + (size_t)cur.pn * tstep;
    S.a_ready(cur);
    if constexpr (SP2) {
        PG8_STAGE(PG8_SB(0, 0), cB, voffB); PG8_STAGE(PG8_SB(0, 1), cB + hstep, voffB); PG8_STAGE(PG8_SA(0, 0), cA, voffA); PG8_STAGE(PG8_SA(0, 1), cA + hstep, voffA);
        if (wr == 1) PG8_BAR;
        PG8_WAIT_V(2); PG8_BAR;
        PG8_STAGE(PG8_SB(1, 0), cB + kstep, voffB); PG8_STAGE(PG8_SA(1, 0), cA + kstep, voffA); PG8_STAGE(PG8_SB(1, 1), cB + hstep + kstep, voffB);
        PG8_WAIT_V(6); PG8_BAR;
    } else {
        PG8_STAGE(PG8_SB(0, 0), cB, voffB); PG8_STAGE(PG8_SA(0, 0), cA, voffA); PG8_STAGE(PG8_SB(0, 1), cB + hstep, voffB); PG8_STAGE(PG8_SA(0, 1), cA + hstep, voffA);
        if (wr == 1) PG8_BAR;
        PG8_WAIT_V(4); PG8_BAR;
        PG8_STAGE(PG8_SB(1, 0), cB + kstep, voffB); PG8_STAGE(PG8_SA(1, 0), cA + kstep, voffA); PG8_STAGE(PG8_SB(1, 1), cB + hstep + kstep, voffB);
        PG8_WAIT_V(6); PG8_BAR;
    }
    for (;;) {
        const bool has_next = S.next(ui + 1, nxt);
        const char* nA = has_next ? (const char*)g.A + (size_t)nxt.pm * tstep : cA; const char* nB = has_next ? (const char*)g.Bt + (size_t)nxt.pn * tstep : cB;
        for (int t = 0; t < nt; t += 2) {
            const bool last = (t == nt - 2);
            const char* a1 = cA + (size_t)(t + 1) * kstep;
            const char* a2 = last ? nA : cA + (size_t)(t + 2) * kstep; const char* b2 = last ? nB : cB + (size_t)(t + 2) * kstep;
            const char* a3 = a2 + kstep; const char* b3 = b2 + kstep;
            if (last && has_next) S.a_ready(nxt);
            if constexpr (SP2) {
            PG8_LDB(B0, 0, 0); PG8_LDB(B1, 0, 1); PG8_SCHED; PG8_LDA(At, 0, 0); PG8_STAGE(PG8_SA(1, 1), a1 + hstep, voffA);
            PG8_WAIT_V(8); PG8_WAIT_L(0); PG8_BAR; PG8_MMA(0, 0, At, B0); PG8_MMA(0, 1, At, B1); PG8_BAR; PG8_SCHED;
            PG8_LDA(At, 0, 1); PG8_STAGE(PG8_SB(0, 0), b2, voffB); PG8_STAGE(PG8_SB(0, 1), b2 + hstep, voffB); PG8_STAGE(PG8_SA(0, 0), a2, voffA);
            PG8_WAIT_V(8); PG8_WAIT_L(0); PG8_BAR; PG8_MMA(1, 0, At, B0); PG8_MMA(1, 1, At, B1); PG8_BAR; PG8_SCHED;
            PG8_LDB(B0, 1, 0); PG8_LDB(B1, 1, 1); PG8_SCHED; PG8_LDA(At, 1, 0); PG8_STAGE(PG8_SA(0, 1), a2 + hstep, voffA);
            PG8_WAIT_V(8); PG8_WAIT_L(0); PG8_BAR; PG8_MMA(0, 0, At, B0); PG8_MMA(0, 1, At, B1); PG8_BAR; PG8_SCHED;
            PG8_LDA(At, 1, 1); PG8_STAGE(PG8_SB(1, 0), b3, voffB); PG8_STAGE(PG8_SB(1, 1), b3 + hstep, voffB); PG8_STAGE(PG8_SA(1, 0), a3, voffA);
            PG8_WAIT_V(8); PG8_WAIT_L(0); PG8_BAR; PG8_MMA(1, 0, At, B0); PG8_MMA(1, 1, At, B1); PG8_BAR; PG8_SCHED;
            } else {
            PG8_LDB(B0, 0, 0); PG8_SCHED; PG8_LDA(At, 0, 0); PG8_STAGE(PG8_SA(1, 1), a1 + hstep, voffA);
            PG8_WAIT_L(8); PG8_BAR; PG8_WAIT_L(0); PG8_MMA(0, 0, At, B0); PG8_BAR; PG8_SCHED;
            PG8_LDB(B1, 0, 1); PG8_STAGE(PG8_SB(0, 0), b2, voffB);
            PG8_BAR; PG8_WAIT_L(0); PG8_MMA(0, 1, At, B1); PG8_BAR;
            PG8_LDA(At, 0, 1); PG8_STAGE(PG8_SA(0, 0), a2, voffA);
            PG8_BAR; PG8_WAIT_L(0); PG8_MMA(1, 0, At, B0); PG8_BAR; PG8_SCHED;
            PG8_STAGE(PG8_SB(0, 1), b2 + hstep, voffB);
            PG8_WAIT_V(6); PG8_BAR; PG8_MMA(1, 1, At, B1); PG8_BAR;
            PG8_LDB(B0, 1, 0); PG8_SCHED; PG8_LDA(At, 1, 0); PG8_STAGE(PG8_SA(0, 1), a2 + hstep, voffA);
            PG8_WAIT_L(8); PG8_BAR; PG8_WAIT_L(0); PG8_MMA(0, 0, At, B0); PG8_BAR; PG8_SCHED;
            PG8_LDB(B1, 1, 1); PG8_STAGE(PG8_SB(1, 0), b3, voffB);
            PG8_BAR; PG8_WAIT_L(0); PG8_MMA(0, 1, At, B1); PG8_BAR;
            PG8_LDA(At, 1, 1); PG8_STAGE(PG8_SA(1, 0), a3, voffA);
            PG8_BAR; PG8_WAIT_L(0); PG8_MMA(1, 0, At, B0); PG8_BAR; PG8_SCHED;
            PG8_STAGE(PG8_SB(1, 1), b3 + hstep, voffB);
            PG8_WAIT_V(6); PG8_BAR; PG8_MMA(1, 1, At, B1); PG8_BAR;
            }
        }
        if constexpr (ALIGN_EPI) { if (wr == 0) PG8_BAR; }
        if constexpr (!Epi::AFTER_DRAIN) { E(acc, cur, wr, wc, fr, fq); S.done(cur); }
        if (!has_next) break;
#pragma unroll
        for (int a = 0; a < 2; ++a)
#pragma unroll
            for (int b = 0; b < 2; ++b)
#pragma unroll
                for (int m = 0; m < 4; ++m)
#pragma unroll
                    for (int n = 0; n < 2; ++n) acc[a][b][m][n] = (f32x4){0.f, 0.f, 0.f, 0.f};
        cur = nxt; cA = nA; cB = nB; ++ui;
        if constexpr (ALIGN_EPI) { if (wr == 1) PG8_BAR; }
    }
    PG8_WAIT_V(0);
    if constexpr (!ALIGN_EPI) { if (wr == 0) PG8_BAR; }
    PG8_BAR;
    if constexpr (Epi::AFTER_DRAIN) { E.fused(acc, cur, wr, wc, fr, fq, lds, wid, lane); S.done(cur); }
#undef PG8_SA
#undef PG8_SB
#undef PG8_STAGE
#undef PG8_LDA
#undef PG8_LDB
#undef PG8_MMA
#undef PG8_WAIT_V
#undef PG8_WAIT_L
#undef PG8_BAR
#undef PG8_SCHED
}
}
#define GAS __attribute__((address_space(1)))
#define LAS __attribute__((address_space(3)))
typedef unsigned short bf16;
typedef unsigned v4u __attribute__((ext_vector_type(4)));
typedef float f32x4 __attribute__((ext_vector_type(4)));
typedef short bf16x8 __attribute__((ext_vector_type(8)));
typedef GAS unsigned gu32;
typedef GAS unsigned long long gu64;
#define RLX_AGENT __ATOMIC_RELAXED, __HIP_MEMORY_SCOPE_AGENT
#define LDS_WAIT() asm volatile("s_waitcnt lgkmcnt(0)" ::: "memory")
#define VM_WAIT() asm volatile("s_waitcnt vmcnt(0)" ::: "memory")
__device__ __forceinline__ unsigned long long rt() { return __builtin_amdgcn_s_memrealtime(); }
__device__ __forceinline__ unsigned f2bf(float f) { unsigned u = __builtin_bit_cast(unsigned, f); return (u + 0x7fffu + ((u >> 16) & 1u)) >> 16; }
__device__ __forceinline__ unsigned pk2(float lo, float hi) { return f2bf(lo) | (f2bf(hi) << 16); }
#define XB_TMO      128
#define XB_XCNT(j)  (256  + 64 * (j))
#define XB_XSUB(j)  (1280 + 64 * (j))
#define XB_XGEN(j)  (2304 + 64 * (j))
#define XB_TOP      3328
#define XB_TOPGEN   3392
#define XCD_BAR_WORDS 3456
#define XB_SPIN_CAP (1u << 18)

__device__ __forceinline__ unsigned xb_ld(unsigned* p)              { return __hip_atomic_load(p, __ATOMIC_RELAXED, __HIP_MEMORY_SCOPE_AGENT); }
__device__ __forceinline__ unsigned xb_add(unsigned* p, unsigned v) { return __hip_atomic_fetch_add(p, v, __ATOMIC_RELAXED, __HIP_MEMORY_SCOPE_AGENT); }
__device__ __forceinline__ unsigned xb_xcc_id() { return (unsigned)__builtin_amdgcn_s_getreg((3 << 11) | 20) & 0xFu; }
#define XB_SPIN(cond, bar) do { unsigned _sp = 0; while (cond) { __builtin_amdgcn_s_sleep(1); \
    if ((++_sp & 255u) == 0u) { if (xb_ld(&(bar)[XB_TMO])) break; if (_sp > XB_SPIN_CAP) { atomicAdd(&(bar)[XB_TMO], 1u); break; } } } } while (0)

struct XcdBarrier {
    unsigned* bar; unsigned x;
    volatile LAS unsigned* st;
};

__device__ __forceinline__ XcdBarrier xcd_barrier_post(unsigned* bar, volatile LAS unsigned* st) {
    XcdBarrier b; b.bar = bar; b.x = xb_xcc_id(); b.st = st;
    if (threadIdx.x == 0) (void)xb_add(&bar[XB_XCNT(b.x)], 1u);
    return b;
}
__device__ __forceinline__ void xcd_barrier_complete(unsigned* bar, unsigned x, unsigned& nloc, unsigned& nx) {
    const unsigned G = gridDim.x * gridDim.y * gridDim.z;
    unsigned sum, cnt, mine, sp = 0u;
    for (;;) {
        sum = 0u; cnt = 0u; mine = 0u;
#pragma unroll
        for (unsigned j = 0; j < 16; ++j) { const unsigned c = xb_ld(&bar[XB_XCNT(j)]); sum += c; cnt += (c > 0u) ? 1u : 0u; mine = (j == x) ? c : mine; }
        if (sum == G) break;
        __builtin_amdgcn_s_sleep(1);
        if ((++sp & 255u) == 0u) { if (xb_ld(&bar[XB_TMO])) break; if (sp > XB_SPIN_CAP) { atomicAdd(&bar[XB_TMO], 1u); break; } }
    }
    nloc = mine > 0u ? mine : 1u; nx = cnt > 0u ? cnt : 1u;
}

__device__ __forceinline__ void xcd_barrier(const XcdBarrier& b) {
    asm volatile("s_waitcnt vmcnt(0)" ::: "memory");
    __syncthreads();
    if (threadIdx.x == 0) {
        unsigned* bar = b.bar;
        __builtin_amdgcn_s_waitcnt(0);
        unsigned nloc = b.st[0], nx = b.st[1];
        if (nloc == 0u) { xcd_barrier_complete(bar, b.x, nloc, nx); b.st[0] = nloc; b.st[1] = nx; }
        const unsigned old = xb_add(&bar[XB_XSUB(b.x)], 1u);
        const unsigned gen = old / nloc;
        if (old + 1u == (gen + 1u) * nloc) {
            __builtin_amdgcn_fence(__ATOMIC_RELEASE, "agent");
            asm volatile("s_waitcnt vmcnt(0)" ::: "memory");
            const unsigned og = xb_add(&bar[XB_TOP], 1u);
            const unsigned tg = og / nx;
            if (og + 1u == (tg + 1u) * nx) xb_add(&bar[XB_TOPGEN], 1u);
            else XB_SPIN(xb_ld(&bar[XB_TOPGEN]) == tg, bar);
            __builtin_amdgcn_fence(__ATOMIC_ACQUIRE, "agent");
            xb_add(&bar[XB_XGEN(b.x)], 1u);
            asm volatile("s_waitcnt vmcnt(0)" ::: "memory");
        } else {
            XB_SPIN(xb_ld(&bar[XB_XGEN(b.x)]) == gen, bar);
            __builtin_amdgcn_fence(__ATOMIC_ACQUIRE, "agent");
            asm volatile("s_waitcnt vmcnt(0)" ::: "memory");
        }
    }
    __syncthreads();
}
#ifndef PG8_SP2
#define PG8_SP2 true
#endif
#ifndef PG8_ALIGN
#define PG8_ALIGN true
#endif
constexpr int NWAVES = 8, NTHR = NWAVES * 64;
constexpr int BATCH = 4, SEQ = 2048, DM = 4096, NMETA = 16;
constexpr int MR = BATCH * SEQ;
constexpr int MROWS = MR + NMETA;
constexpr int MT = 8448;
constexpr int NIN = 32784;
constexpr int N1 = 33024;
constexpr int DFF = 11008, NF = 2 * DFF;
constexpr int RET_H = 8, RET_DK = 256, RET_DV = 512, GLA_H = 4, GLA_DK = 512, GLA_DV = 1024, GLA_RANK = 16;
constexpr float EPS = 1e-6f;
constexpr int C_QR = 0, C_KR = 2048, C_VR = 4096, C_OR = 8192, C_QG = 12288, C_KG = 14336, C_VG = 16384, C_OG = 20480, C_MR = 24576, C_MG = 28672, C_Z = 32768;
constexpr int NPH = 11;
#ifndef MK_N_LAUNCHES
#define MK_N_LAUNCHES 1
#endif
constexpr int N_LAUNCHES = MK_N_LAUNCHES;

constexpr size_t al256(size_t x) { return (x + 255) & ~(size_t)255; }
constexpr size_t WS_CTL = 0, CTL_ZERO_BYTES = 1u << 20;
constexpr size_t WS_W1T = WS_CTL + CTL_ZERO_BYTES;
constexpr size_t WS_WOT = WS_W1T + al256((size_t)N1 * DM * 2);
constexpr size_t WS_WFT = WS_WOT + al256((size_t)DM * DM * 2);
constexpr size_t WS_W2T = WS_WFT + al256((size_t)NF * DM * 2);
constexpr size_t WS_XB  = WS_W2T + al256((size_t)DM * DFF * 2);
constexpr size_t WS_RS1 = WS_XB + al256((size_t)MT * DM * 2);
constexpr size_t WS_RS2 = WS_RS1 + al256((size_t)MT * 4);
constexpr size_t WS_ZB  = WS_RS2 + al256((size_t)MT * 4);
constexpr size_t WS_COS = WS_ZB + al256((size_t)MT * 16 * 4);
constexpr size_t WS_SIN = WS_COS + al256((size_t)MROWS * 128 * 4);
constexpr size_t WS_PROJ = WS_SIN + al256((size_t)MROWS * 128 * 4);
constexpr size_t WS_UG  = WS_PROJ;
constexpr size_t WS_ACT = WS_UG + al256((size_t)MT * NF * 2);
constexpr size_t WS_YR  = WS_PROJ + al256((size_t)MT * N1 * 2);
constexpr size_t WS_YG  = WS_YR + al256((size_t)MROWS * DM * 4);
constexpr size_t WS_MRG = WS_YG + al256((size_t)MROWS * DM * 4);
constexpr size_t WS_H1  = WS_MRG + al256((size_t)MT * DM * 2);
constexpr size_t WS_H1B = WS_H1 + al256((size_t)MT * DM * 4);
constexpr size_t WS_QFG = WS_H1B + al256((size_t)MT * DM * 2);
constexpr size_t WS_KFG = WS_QFG + (size_t)4 * 4 * 33 * 65536;
constexpr size_t WS_QFR = WS_KFG + (size_t)4 * 4 * 33 * 65536;
constexpr size_t WS_KFR = WS_QFR + (size_t)4 * 8 * 33 * 32768;
constexpr size_t WS_VFG = WS_KFR + (size_t)4 * 8 * 33 * 32768;
constexpr size_t WS_VFR = WS_VFG + (size_t)4 * 33 * 64 * 8192;
constexpr size_t WS_PFG = WS_VFR + (size_t)4 * 33 * 64 * 8192;
constexpr size_t WS_PFR = WS_PFG + (size_t)4 * 4 * 33 * 8192;
constexpr size_t WS_DECG = WS_PFR + (size_t)4 * 8 * 33 * 8192;
constexpr size_t WS_END = WS_DECG + (size_t)4 * 4 * 33 * 512 * 4;
static_assert(WS_ACT + (size_t)MR * DFF * 2 <= WS_YR, "UG | ACT overlay fits inside PROJ");
static_assert(WS_END <= (size_t)4 * 4096 * NIN * 4, "workspace map fits 4 x the largest tensor");
constexpr int CW_TMO = 0, CW_CODE = 1, CW_BAR = 4096;

constexpr int RING_OFF = 0, RING_BYTES = 131072;
constexpr int LDS_BYTES = 163840;
constexpr int LDSCTL_OFF = LDS_BYTES - 1024, MISC_OFF = LDSCTL_OFF + 320;
static_assert(MISC_OFF + 128 <= LDS_BYTES, "LDS map");

__device__ __forceinline__ float bf2f(bf16 v) { return __builtin_bit_cast(float, (unsigned)v << 16); }
__device__ __forceinline__ float wave_sum(float v) {
#pragma unroll
    for (int o = 1; o < 64; o <<= 1) v += __shfl_xor(v, o);
    return v;
}
__device__ __forceinline__ float sigm(float x) { return 1.f / (1.f + __expf(-x)); }
__device__ __forceinline__ float silu(float x) { return x / (1.f + __expf(-x)); }
__device__ __forceinline__ float logsig(float x) { return fminf(x, 0.f) - log1pf(__expf(-fabsf(x))); }

typedef float f32x16 __attribute__((ext_vector_type(16)));
#define MFMA32(a, b, c) __builtin_amdgcn_mfma_f32_32x32x16_bf16((a), (b), (c), 0, 0, 0)
__device__ __forceinline__ unsigned pkbf(float lo, float hi) { typedef __bf16 b2 __attribute__((ext_vector_type(2))); typedef float f2 __attribute__((ext_vector_type(2))); return __builtin_bit_cast(unsigned, __builtin_convertvector((f2){lo, hi}, b2)); }
__device__ __forceinline__ bf16 f2b(float x) { return (bf16)(pkbf(x, 0.f) & 0xffffu); }
__device__ __forceinline__ int chunk_row(int b, int n, int i) { return n == 0 ? (i < 48 ? -1 : MR + i - 48) : b * SEQ + 64 * (n - 1) + i; }

struct Frame {
    LAS unsigned char* lds;
    volatile LAS unsigned* MISC;
    gu32* ctl;
    int tid, lane, wave, G;
    const float *x, *meta, *attn_norm, *w_in, *w_gate_up, *b_gate, *ret_norm, *gla_norm, *w_out, *ffn_norm, *w_ffn_in, *conv_w, *conv_b, *w_ffn_out, *final_norm;
    const int* positions;
    float* out;
    bf16 *W1t, *Wot, *Wft, *W2t, *XB, *PROJ, *UG, *ACT, *MRG, *H1B;
    float *RS1, *RS2, *ZB, *COS, *SIN, *YR, *YG, *H1, *DECG;
    bf16 *QFG, *KFG, *QFR, *KFR, *VFG, *VFR, *PFG, *PFR;
};

namespace pg8 {
struct EpiG1 {
    static constexpr bool PERM = true, AFTER_DRAIN = false;
    bf16_t* O; int ldc; const float* rs; float* zb;
    __device__ __forceinline__ void operator()(const f32x4 (&acc)[2][2][4][2], const Unit& u, int wr, int wc, int fr, int fq) const {
        const int row0 = u.pm * BM + wr * 64 + fr, col0 = u.pn * BM + wc * 32 + 8 * fq;
#pragma unroll
        for (int ai = 0; ai < 2; ++ai)
#pragma unroll
            for (int m = 0; m < 4; ++m) { const int row = row0 + ai * HALF + m * 16; const float s = rs[row]; bf16_t* rowp = O + (size_t)row * ldc + col0;
#pragma unroll
                for (int bj = 0; bj < 2; ++bj) { const f32x4 v0 = acc[ai][bj][m][0] * s, v1 = acc[ai][bj][m][1] * s;
                    u32x4 w; w.x = cvt_pk_bf16(v0[0], v0[1]); w.y = cvt_pk_bf16(v0[2], v0[3]); w.z = cvt_pk_bf16(v1[0], v1[1]); w.w = cvt_pk_bf16(v1[2], v1[3]);
                    *(u32x4*)(rowp + bj * HALF) = w;
                    if (bj == 0 && u.pn == 128 && wc == 0 && fq < 2) { float* zp = zb + (size_t)row * 16 + 8 * fq; *(f32x4*)zp = v0; *(f32x4*)(zp + 4) = v1; } } }
    }
};
struct EpiScaleBf16 {
    static constexpr bool PERM = true, AFTER_DRAIN = false;
    bf16_t* O; int ldc; const float* rs;
    __device__ __forceinline__ void operator()(const f32x4 (&acc)[2][2][4][2], const Unit& u, int wr, int wc, int fr, int fq) const {
        const int row0 = u.pm * BM + wr * 64 + fr, col0 = u.pn * BM + wc * 32 + 8 * fq;
#pragma unroll
        for (int ai = 0; ai < 2; ++ai)
#pragma unroll
            for (int m = 0; m < 4; ++m) { const int row = row0 + ai * HALF + m * 16; const float s = rs[row]; bf16_t* rowp = O + (size_t)row * ldc + col0;
#pragma unroll
                for (int bj = 0; bj < 2; ++bj) { const f32x4 v0 = acc[ai][bj][m][0] * s, v1 = acc[ai][bj][m][1] * s;
                    u32x4 w; w.x = cvt_pk_bf16(v0[0], v0[1]); w.y = cvt_pk_bf16(v0[2], v0[3]); w.z = cvt_pk_bf16(v1[0], v1[1]); w.w = cvt_pk_bf16(v1[2], v1[3]);
                    *(u32x4*)(rowp + bj * HALF) = w; } }
    }
};
struct EpiResX {
    static constexpr bool PERM = false, AFTER_DRAIN = false;
    const float* x; const float* meta; float* out; int ldc; int nreal, nmeta;
    __device__ __forceinline__ void operator()(const f32x4 (&acc)[2][2][4][2], const Unit& u, int wr, int wc, int fr, int fq) const {
        const int row0 = u.pm * BM + wr * 64 + fr, col0 = u.pn * BM + wc * 32 + 4 * fq;
#pragma unroll
        for (int ai = 0; ai < 2; ++ai)
#pragma unroll
            for (int m = 0; m < 4; ++m) { const int row = row0 + ai * HALF + m * 16;
                const float* bp = row < nreal ? x + (size_t)row * ldc : (row < nreal + nmeta ? meta + (size_t)(row - nreal) * ldc : nullptr);
                float* rowp = out + (size_t)row * ldc + col0;
#pragma unroll
                for (int bj = 0; bj < 2; ++bj)
#pragma unroll
                    for (int n = 0; n < 2; ++n) { f32x4 o = (f32x4){0.f, 0.f, 0.f, 0.f};
                        if (bp) o = *(const f32x4*)(bp + col0 + bj * HALF + n * 16) + acc[ai][bj][m][n];
                        *(f32x4*)(rowp + bj * HALF + n * 16) = o; } }
    }
};
struct EpiResF32 {
    static constexpr bool PERM = false, AFTER_DRAIN = false;
    const float* base; float* out; int ldc;
    __device__ __forceinline__ void operator()(const f32x4 (&acc)[2][2][4][2], const Unit& u, int wr, int wc, int fr, int fq) const {
        const int row0 = u.pm * BM + wr * 64 + fr, col0 = u.pn * BM + wc * 32 + 4 * fq;
#pragma unroll
        for (int ai = 0; ai < 2; ++ai)
#pragma unroll
            for (int m = 0; m < 4; ++m) { const size_t off = (size_t)(row0 + ai * HALF + m * 16) * ldc + col0;
#pragma unroll
                for (int bj = 0; bj < 2; ++bj)
#pragma unroll
                    for (int n = 0; n < 2; ++n) *(f32x4*)(out + off + bj * HALF + n * 16) = *(const f32x4*)(base + off + bj * HALF + n * 16) + acc[ai][bj][m][n]; }
    }
};
}

__device__ __forceinline__ void p0_transpose_item(const float* W, int K, int ldw, int c0, int nc, bf16* WT, int row_off, const float* kscale, LAS float* scr, int item, int lane) {
    const int nblk = (nc + 31) / 32, kb = item / nblk, nb = item % nblk, k0 = 64 * kb, n0 = 32 * nb;
    const int n = n0 + (lane & 31); const bool ok = n < nc;
#pragma unroll 8
    for (int i = 0; i < 32; ++i) { const int kk = 2 * i + (lane >> 5);
        float v = ok ? W[(size_t)(k0 + kk) * ldw + c0 + n] : 0.f;
        if (kscale) v *= kscale[k0 + kk];
        scr[kk * 33 + (lane & 31)] = v; }
    LDS_WAIT(); asm volatile("" ::: "memory");
    const int c = lane & 7;
#pragma unroll
    for (int j = 0; j < 4; ++j) { const int nn = (lane >> 3) + 8 * j; const LAS float* s = scr + (8 * c) * 33 + nn;
        v4u o; o.x = pk2(s[0 * 33], s[1 * 33]); o.y = pk2(s[2 * 33], s[3 * 33]); o.z = pk2(s[4 * 33], s[5 * 33]); o.w = pk2(s[6 * 33], s[7 * 33]);
        *(GAS v4u*)(WT + (size_t)(row_off + n0 + nn) * K + k0 + 8 * c) = o; }
    LDS_WAIT(); asm volatile("" ::: "memory");
}
__device__ __forceinline__ void p0_prologue(Frame& F) {
    LAS float* scr = (LAS float*)(F.lds + RING_OFF + F.wave * 16384);
    const int gw = blockIdx.x * NWAVES + F.wave, NGW = F.G * NWAVES;
    constexpr int I_A = 64 * (24576 / 32), I_Z = 64, I_M = 64 * (8192 / 32), I_O = 64 * (DM / 32), I_F = 64 * (NF / 32), I_2 = (DFF / 64) * (DM / 32);
    constexpr int NITEMS = I_A + I_Z + I_M + I_O + I_F + I_2;
    for (int it = gw; it < NITEMS; it += NGW) {
        int r = it;
        if (r < I_A) { p0_transpose_item(F.w_in, DM, NIN, 0, 24576, F.W1t, 0, F.attn_norm, scr, r, F.lane); continue; } r -= I_A;
        if (r < I_Z) { p0_transpose_item(F.w_in, DM, NIN, 24576, 16, F.W1t, C_Z, F.attn_norm, scr, r, F.lane); continue; } r -= I_Z;
        if (r < I_M) { p0_transpose_item(F.w_in, DM, NIN, 24592, 8192, F.W1t, C_MR, F.attn_norm, scr, r, F.lane); continue; } r -= I_M;
        if (r < I_O) { p0_transpose_item(F.w_out, DM, DM, 0, DM, F.Wot, 0, nullptr, scr, r, F.lane); continue; } r -= I_O;
        if (r < I_F) { p0_transpose_item(F.w_ffn_in, DM, NF, 0, NF, F.Wft, 0, F.ffn_norm, scr, r, F.lane); continue; } r -= I_F;
        p0_transpose_item(F.w_ffn_out, DFF, DM, 0, DM, F.W2t, 0, nullptr, scr, r, F.lane);
    }
    { const size_t n16 = (size_t)(N1 - C_Z - 32) * DM * 2 / 16; GAS v4u* p = (GAS v4u*)(F.W1t + (size_t)(C_Z + 32) * DM);
      for (size_t i = (size_t)blockIdx.x * NTHR + F.tid; i < n16; i += (size_t)F.G * NTHR) p[i] = (v4u){0u, 0u, 0u, 0u}; }
    for (int m = gw; m < MT; m += NGW) {
        GAS unsigned long long* o8 = (GAS unsigned long long*)(F.XB + (size_t)m * DM) + F.lane;
        if (m < MROWS) {
            const float* xrow = m < MR ? F.x + (size_t)m * DM : F.meta + (size_t)(m - MR) * DM;
            const GAS f32x4* xr = (const GAS f32x4*)xrow + F.lane; float ss = 0.f;
#pragma unroll
            for (int j = 0; j < 16; ++j) { const f32x4 v = xr[64 * j]; ss += (v.x * v.x + v.y * v.y) + (v.z * v.z + v.w * v.w);
                o8[64 * j] = (unsigned long long)pk2(v.x, v.y) | ((unsigned long long)pk2(v.z, v.w) << 32); }
            ss = wave_sum(ss);
            if (F.lane == 0) F.RS1[m] = 1.0f / sqrtf(ss * (1.0f / DM) + EPS);
        } else {
            GAS unsigned long long* o2 = (GAS unsigned long long*)(F.MRG + (size_t)m * DM) + F.lane;
            GAS unsigned long long* o3 = (GAS unsigned long long*)(F.H1B + (size_t)m * DM) + F.lane;
#pragma unroll
            for (int j = 0; j < 16; ++j) { o8[64 * j] = 0ull; o2[64 * j] = 0ull; o3[64 * j] = 0ull; }
            if (F.lane == 0) { F.RS1[m] = 0.f; F.RS2[m] = 0.f; }
        }
    }
    for (int i = blockIdx.x * NTHR + F.tid; i < MROWS * 128; i += F.G * NTHR) {
        const int m = i >> 7, j = i & 127;
        const int pos = m < MR ? F.positions[m] + NMETA : m - MR;
        const float inv_freq = powf(10000.0f, -(float)j * (1.0f / 128.0f));
        const float ang = (float)pos * inv_freq; float s, c; sincosf(ang, &s, &c);
        F.COS[i] = c; F.SIN[i] = s;
    }
}

template <bool GLA> __device__ __forceinline__ void prep_qkp(Frame& F, int u) {
    constexpr int DK = GLA ? GLA_DK : RET_DK, NH = GLA ? GLA_H : RET_H, LDQ = DK + 8, DKW = DK / 8, NKS = DKW / 16, NDT = DKW / 32;
    const int n = u % 33, h = (u / 33) % NH, b = u / (33 * NH);
    LAS bf16* Qs = (LAS bf16*)F.lds; LAS bf16* Ks = Qs + 64 * LDQ; LAS float* zs = (LAS float*)(Ks + 64 * LDQ);
    const int tid = F.tid, lane = F.lane, w8 = F.wave, r = lane & 31, hh = lane >> 5;
    if (GLA) {
        for (int e = tid; e < 64 * 16; e += NTHR) { const int row = chunk_row(b, n, e >> 4); zs[e] = row >= 0 ? F.ZB[(size_t)row * 16 + (e & 15)] : 0.f; }
        __syncthreads();
        const int d = tid, ch = h * GLA_DK + d; float wg[GLA_RANK];
#pragma unroll
        for (int q = 0; q < GLA_RANK; ++q) wg[q] = F.w_gate_up[q * 2048 + ch];
        const float bg = F.b_gate[ch]; float bc = 0.f;
        for (int i = 0; i < 64; ++i) { const int row = chunk_row(b, n, i); float qv = 0.f, kv = 0.f;
            if (row >= 0) { float lg = bg;
#pragma unroll
                for (int q = 0; q < GLA_RANK; ++q) lg += zs[i * 16 + q] * wg[q];
                bc += logsig(lg) * (1.0f / 16.0f);
                const bf16* pr = F.PROJ + (size_t)row * N1;
                qv = bf2f(pr[C_QG + ch]) * 0.04419417382415922f * __expf(bc); kv = bf2f(pr[C_KG + ch]) * __expf(-bc); }
            Qs[i * LDQ + d] = f2b(qv); Ks[i * LDQ + d] = f2b(kv); }
        F.DECG[((size_t)(b * GLA_H + h) * 33 + n) * GLA_DK + d] = __expf(bc);
    } else {
        const int p = tid & 127, tg = tid >> 7; const float l2g = log2f(1.0f - exp2f(-5.0f - (float)h));
        for (int ii = 0; ii < 16; ++ii) { const int i = tg * 16 + ii, row = chunk_row(b, n, i); float qa = 0.f, qb = 0.f, ka = 0.f, kb = 0.f;
            if (row >= 0) { const float c = F.COS[row * 128 + p], sn = F.SIN[row * 128 + p]; const bf16* pr = F.PROJ + (size_t)row * N1;
                const float q1 = bf2f(pr[C_QR + h * 256 + p]), q2 = bf2f(pr[C_QR + h * 256 + 128 + p]), k1 = bf2f(pr[C_KR + h * 256 + p]), k2 = bf2f(pr[C_KR + h * 256 + 128 + p]);
                const float dq = exp2f((float)(i + 1) * l2g), dkk = 0.0625f / dq;
                qa = (q1 * c - q2 * sn) * dq; qb = (q2 * c + q1 * sn) * dq; ka = (k1 * c - k2 * sn) * dkk; kb = (k2 * c + k1 * sn) * dkk; }
            Qs[i * LDQ + p] = f2b(qa); Qs[i * LDQ + p + 128] = f2b(qb); Ks[i * LDQ + p] = f2b(ka); Ks[i * LDQ + p + 128] = f2b(kb); }
    }
    __syncthreads();
    const size_t cb = (size_t)(b * NH + h) * 33 + n;
    {
        char* qdst = (char*)(GLA ? F.QFG : F.QFR) + ((cb * 8 + w8) * (NKS * 2)) * 1024 + lane * 16;
#pragma unroll
        for (int ks = 0; ks < NKS; ++ks)
#pragma unroll
            for (int qt = 0; qt < 2; ++qt) { const LAS bf16* src = Qs + (32 * qt + r) * LDQ + DKW * w8 + 16 * ks + 4 * hh;
                const unsigned long long lo = *(const LAS unsigned long long*)src, hi = *(const LAS unsigned long long*)(src + 8);
                *(v4u*)(qdst + (ks * 2 + qt) * 1024) = (v4u){(unsigned)lo, (unsigned)(lo >> 32), (unsigned)hi, (unsigned)(hi >> 32)}; }
        char* kdst = (char*)(GLA ? F.KFG : F.KFR) + ((cb * 8 + w8) * (NDT * 4)) * 1024 + lane * 16;
#pragma unroll
        for (int dkt = 0; dkt < NDT; ++dkt)
#pragma unroll
            for (int ks = 0; ks < 4; ++ks) { unsigned w[4];
#pragma unroll
                for (int jj = 0; jj < 4; ++jj) { const int j0 = 2 * jj, t0 = 16 * ks + 8 * (j0 >> 2) + 4 * hh + (j0 & 3);
                    const unsigned e0 = Ks[t0 * LDQ + DKW * w8 + 32 * dkt + r], e1 = Ks[(t0 + 1) * LDQ + DKW * w8 + 32 * dkt + r]; w[jj] = e0 | (e1 << 16); }
                *(v4u*)(kdst + (dkt * 4 + ks) * 1024) = (v4u){w[0], w[1], w[2], w[3]}; }
    }
    if (w8 < 4) {
        const int kt = w8 >> 1, qt = w8 & 1; f32x16 acc;
#pragma unroll
        for (int i = 0; i < 16; ++i) acc[i] = 0.f;
        if (!(kt == 1 && qt == 0)) {
            const LAS bf16* ap = Ks + (32 * kt + r) * LDQ + 8 * hh; const LAS bf16* bp = Qs + (32 * qt + r) * LDQ + 8 * hh;
#pragma unroll 8
            for (int s = 0; s < DK / 16; ++s) acc = MFMA32(*(const LAS bf16x8*)(ap + 16 * s), *(const LAS bf16x8*)(bp + 16 * s), acc);
        }
        char* pdst = (char*)(GLA ? F.PFG : F.PFR) + (cb * 8) * 1024 + lane * 16;
#pragma unroll
        for (int s2 = 0; s2 < 2; ++s2) { unsigned w[4];
#pragma unroll
            for (int jj = 0; jj < 4; ++jj) { const int i0 = 8 * s2 + 2 * jj, i1 = i0 + 1;
                const int k0 = 32 * kt + (i0 & 3) + 8 * (i0 >> 2) + 4 * hh, k1 = 32 * kt + (i1 & 3) + 8 * (i1 >> 2) + 4 * hh, qc = 32 * qt + r;
                w[jj] = pkbf(k0 <= qc ? acc[i0] : 0.f, k1 <= qc ? acc[i1] : 0.f); }
            *(v4u*)(pdst + ((2 * kt + s2) * 2 + qt) * 1024) = (v4u){w[0], w[1], w[2], w[3]}; }
    }
    __syncthreads();
}
__device__ __forceinline__ void prep_vf(Frame& F, int u) {
    const int n = u % 33, b = (u / 33) % 4, br = u / 132; const int cv = br ? C_VG : C_VR; char* VF = (char*)(br ? F.VFG : F.VFR);
    const int lane = F.lane, r = lane & 31, hh = lane >> 5;
    for (int f = F.wave; f < 512; f += 8) { const int slg = f >> 3, wt = (f >> 2) & 1, ks = f & 3; unsigned w[4];
#pragma unroll
        for (int jj = 0; jj < 4; ++jj) { const int j0 = 2 * jj, t0 = 16 * ks + 8 * (j0 >> 2) + 4 * hh + (j0 & 3);
            const int r0 = chunk_row(b, n, t0), r1 = chunk_row(b, n, t0 + 1); const int col = cv + 64 * slg + 32 * wt + r;
            const unsigned e0 = r0 >= 0 ? (unsigned)F.PROJ[(size_t)r0 * N1 + col] : 0u, e1 = r1 >= 0 ? (unsigned)F.PROJ[(size_t)r1 * N1 + col] : 0u; w[jj] = e0 | (e1 << 16); }
        *(v4u*)(VF + ((((size_t)b * 33 + n) * 64 + slg) * 8 + wt * 4 + ks) * 1024 + lane * 16) = (v4u){w[0], w[1], w[2], w[3]}; }
}
__device__ __forceinline__ void p2_prep(Frame& F) {
    constexpr int U_R = 4 * 8 * 33, U_G = 4 * 4 * 33, U_V = 2 * 4 * 33;
    for (int u = blockIdx.x; u < U_G + U_R + U_V; u += F.G) {
        if (u < U_G) prep_qkp<true>(F, u); else if (u < U_G + U_R) prep_qkp<false>(F, u - U_G); else prep_vf(F, u - U_G - U_R);
    }
}

__device__ __forceinline__ bf16x8 pack8(const f32x16& x, int s) { v4u w;
    if (s == 0) { w.x = pkbf(x[0], x[1]); w.y = pkbf(x[2], x[3]); w.z = pkbf(x[4], x[5]); w.w = pkbf(x[6], x[7]); }
    else { w.x = pkbf(x[8], x[9]); w.y = pkbf(x[10], x[11]); w.z = pkbf(x[12], x[13]); w.w = pkbf(x[14], x[15]); }
    return __builtin_bit_cast(bf16x8, w); }
template <bool GLA> __device__ __forceinline__ void scan_unit(Frame& F, int u) {
    constexpr int DK = GLA ? GLA_DK : RET_DK, DV = GLA ? GLA_DV : RET_DV, NH = GLA ? GLA_H : RET_H, NSL = DV / 64, DKW = DK / 8, NKS = DKW / 16, NDT = DKW / 32;
    const int b = u / (NH * NSL), h = (u / NSL) % NH, sl = u % NSL, slg = h * NSL + sl;
    const int lane = F.lane, r = lane & 31, hh = lane >> 5, w8 = F.wave;
    LAS float* RED = (LAS float*)F.lds;
    f32x16 S[NDT][2];
#pragma unroll
    for (int a = 0; a < NDT; ++a)
#pragma unroll
        for (int c = 0; c < 2; ++c)
#pragma unroll
            for (int i = 0; i < 16; ++i) S[a][c][i] = 0.f;
    const char* QFb = (const char*)(GLA ? F.QFG : F.QFR); const char* KFb = (const char*)(GLA ? F.KFG : F.KFR);
    const char* VFb = (const char*)(GLA ? F.VFG : F.VFR); const char* PFb = (const char*)(GLA ? F.PFG : F.PFR);
    float* Y = GLA ? F.YG : F.YR;
    const float gam64 = exp2f(64.0f * log2f(1.0f - exp2f(-5.0f - (float)h)));
#pragma unroll 1
    for (int n = 0; n < 33; ++n) {
        const size_t cb = (size_t)(b * NH + h) * 33 + n;
        const char* qp = QFb + ((cb * 8 + w8) * (NKS * 2)) * 1024 + lane * 16;
        const char* kp = KFb + ((cb * 8 + w8) * (NDT * 4)) * 1024 + lane * 16;
        const char* vp = VFb + ((((size_t)b * 33 + n) * 64 + slg) * 8) * 1024 + lane * 16;
        const char* pp = PFb + (cb * 8) * 1024 + lane * 16;
        f32x16 o[2][2];
#pragma unroll
        for (int a = 0; a < 2; ++a)
#pragma unroll
            for (int c = 0; c < 2; ++c)
#pragma unroll
                for (int i = 0; i < 16; ++i) o[a][c][i] = 0.f;
#pragma unroll
        for (int ks = 0; ks < NKS; ++ks) { const int dkt = ks >> 1, s = ks & 1; bf16x8 a[2];
#pragma unroll
            for (int wt = 0; wt < 2; ++wt) a[wt] = pack8(S[dkt][wt], s);
#pragma unroll
            for (int qt = 0; qt < 2; ++qt) { const bf16x8 bq = *(const bf16x8*)(qp + (ks * 2 + qt) * 1024);
#pragma unroll
                for (int wt = 0; wt < 2; ++wt) o[wt][qt] = MFMA32(a[wt], bq, o[wt][qt]); } }
        { const int ks2 = w8 >> 1, qt2 = w8 & 1; const bf16x8 bp = *(const bf16x8*)(pp + (ks2 * 2 + qt2) * 1024);
#pragma unroll
          for (int wt = 0; wt < 2; ++wt) { const bf16x8 av = *(const bf16x8*)(vp + (wt * 4 + ks2) * 1024);
              if (qt2 == 0) o[wt][0] = MFMA32(av, bp, o[wt][0]); else o[wt][1] = MFMA32(av, bp, o[wt][1]); } }
#pragma unroll
        for (int wt = 0; wt < 2; ++wt)
#pragma unroll
            for (int qt = 0; qt < 2; ++qt)
#pragma unroll
                for (int i = 0; i < 16; ++i) RED[((w8 * 4 + wt * 2 + qt) * 16 + i) * 64 + lane] = o[wt][qt][i];
#pragma unroll
        for (int dkt = 0; dkt < NDT; ++dkt)
#pragma unroll
            for (int ks = 0; ks < 4; ++ks) { const bf16x8 ak = *(const bf16x8*)(kp + (dkt * 4 + ks) * 1024);
#pragma unroll
                for (int wt = 0; wt < 2; ++wt) { const bf16x8 bv = *(const bf16x8*)(vp + (wt * 4 + ks) * 1024); S[dkt][wt] = MFMA32(ak, bv, S[dkt][wt]); } }
        if (GLA) {
#pragma unroll
            for (int dkt = 0; dkt < NDT; ++dkt) { const float* dp = F.DECG + cb * GLA_DK + DKW * w8 + 32 * dkt + 4 * hh;
#pragma unroll
                for (int g4 = 0; g4 < 4; ++g4) { const f32x4 dv = *(const f32x4*)(dp + 8 * g4);
#pragma unroll
                    for (int e = 0; e < 4; ++e) { S[dkt][0][4 * g4 + e] *= dv[e]; S[dkt][1][4 * g4 + e] *= dv[e]; } } }
        } else {
#pragma unroll
            for (int wt = 0; wt < 2; ++wt)
#pragma unroll
                for (int i = 0; i < 16; ++i) S[0][wt][i] *= gam64;
        }
        __syncthreads();
        {
            const int t = w8 >> 1, i0 = 8 * (w8 & 1), wt = t >> 1, qt = t & 1; float val[8];
#pragma unroll
            for (int ii = 0; ii < 8; ++ii) { float sum = 0.f;
#pragma unroll
                for (int src = 0; src < 8; ++src) sum += RED[((src * 4 + t) * 16 + i0 + ii) * 64 + lane];
                val[ii] = sum; }
            const int row = chunk_row(b, n, 32 * qt + r);
            if (row >= 0 && (n > 0 || b == 0)) {
#pragma unroll
                for (int g = 0; g < 2; ++g) { const int w0 = 32 * wt + 8 * (2 * (w8 & 1) + g) + 4 * hh;
                    *(f32x4*)(Y + (size_t)row * DM + h * DV + 64 * sl + w0) = (f32x4){val[4 * g], val[4 * g + 1], val[4 * g + 2], val[4 * g + 3]}; } }
        }
        __syncthreads();
    }
}
__device__ __forceinline__ void p3_scan(Frame& F) {
    for (int unit = blockIdx.x; unit < 512; unit += F.G) {
        if (unit < 256) scan_unit<true>(F, unit); else scan_unit<false>(F, unit - 256);
    }
}

__device__ __forceinline__ void p4_merge(Frame& F) {
    const int gw = blockIdx.x * NWAVES + F.wave, NGW = F.G * NWAVES, lane = F.lane;
    for (int m = gw; m < MROWS; m += NGW) {
        const bf16* pr = F.PROJ + (size_t)m * N1;
#pragma unroll 1
        for (int hg = 0; hg < 4; ++hg) {
            f32x4 yr[4], yg[4];
#pragma unroll
            for (int j = 0; j < 4; ++j) { const int c = hg * 1024 + j * 256 + lane * 4; yr[j] = *(const f32x4*)(F.YR + (size_t)m * DM + c); yg[j] = *(const f32x4*)(F.YG + (size_t)m * DM + c); }
            float sg = 0.f, sa = 0.f, sb = 0.f;
#pragma unroll
            for (int j = 0; j < 4; ++j) { sg += (yg[j].x * yg[j].x + yg[j].y * yg[j].y) + (yg[j].z * yg[j].z + yg[j].w * yg[j].w);
                const float t = (yr[j].x + yr[j].y) + (yr[j].z + yr[j].w); if (j < 2) sa += t; else sb += t; }
            sg = wave_sum(sg); sa = wave_sum(sa); sb = wave_sum(sb);
            const float rg = 1.0f / sqrtf(sg * (1.0f / 1024.0f) + EPS), ma = sa * (1.0f / 512.0f), mb = sb * (1.0f / 512.0f);
            float qa = 0.f, qb = 0.f;
#pragma unroll
            for (int j = 0; j < 4; ++j) { const float mu = j < 2 ? ma : mb; yr[j] = yr[j] - mu;
                const float t = (yr[j].x * yr[j].x + yr[j].y * yr[j].y) + (yr[j].z * yr[j].z + yr[j].w * yr[j].w); if (j < 2) qa += t; else qb += t; }
            qa = wave_sum(qa); qb = wave_sum(qb);
            const float ra = 1.0f / sqrtf(qa * (1.0f / 512.0f) + EPS), rb = 1.0f / sqrtf(qb * (1.0f / 512.0f) + EPS);
#pragma unroll
            for (int j = 0; j < 4; ++j) { const int c = hg * 1024 + j * 256 + lane * 4; const float rr = j < 2 ? ra : rb;
                const f32x4 gr = *(const f32x4*)(F.ret_norm + c), gg = *(const f32x4*)(F.gla_norm + c);
                const unsigned long long wor = *(const unsigned long long*)(pr + C_OR + c), wmr = *(const unsigned long long*)(pr + C_MR + c);
                const unsigned long long wog = *(const unsigned long long*)(pr + C_OG + c), wmg = *(const unsigned long long*)(pr + C_MG + c);
                float res[4];
#pragma unroll
                for (int e = 0; e < 4; ++e) {
                    const float o_r = bf2f((bf16)(wor >> (16 * e))), m_r = bf2f((bf16)(wmr >> (16 * e))), o_g = bf2f((bf16)(wog >> (16 * e))), m_g = bf2f((bf16)(wmg >> (16 * e)));
                    const float yrn = yr[j][e] * rr * gr[e], ygn = yg[j][e] * rg * gg[e];
                    res[e] = sigm(m_r) * (yrn * silu(o_r)) + sigm(m_g) * (ygn * silu(o_g)); }
                *(unsigned long long*)(F.MRG + (size_t)m * DM + c) = (unsigned long long)pk2(res[0], res[1]) | ((unsigned long long)pk2(res[2], res[3]) << 32); }
        }
    }
}

__device__ __forceinline__ void p6_rows(Frame& F) {
    const int gw = blockIdx.x * NWAVES + F.wave, NGW = F.G * NWAVES;
    for (int m = gw; m < MROWS; m += NGW) {
        const GAS f32x4* xr = (const GAS f32x4*)(F.H1 + (size_t)m * DM) + F.lane; float ss = 0.f;
        GAS unsigned long long* o8 = (GAS unsigned long long*)(F.H1B + (size_t)m * DM) + F.lane;
#pragma unroll
        for (int j = 0; j < 16; ++j) { const f32x4 v = xr[64 * j]; ss += (v.x * v.x + v.y * v.y) + (v.z * v.z + v.w * v.w);
            o8[64 * j] = (unsigned long long)pk2(v.x, v.y) | ((unsigned long long)pk2(v.z, v.w) << 32); }
        ss = wave_sum(ss);
        if (F.lane == 0) F.RS2[m] = 1.0f / sqrtf(ss * (1.0f / DM) + EPS);
    }
}

__device__ __forceinline__ void p8_act(Frame& F) {
    constexpr int FB = DFF / 8;
    for (size_t i = (size_t)blockIdx.x * NTHR + F.tid; i < (size_t)MR * FB; i += (size_t)F.G * NTHR) {
        const int m = (int)(i / FB), f = (int)(i % FB) * 8, t = m & (SEQ - 1);
        const int r1 = t >= 1 ? m - 1 : MR + 15, r2 = t >= 2 ? m - 2 : MR + 14 + t;
        const v4u u0 = *(const v4u*)(F.UG + (size_t)m * NF + f), u1 = *(const v4u*)(F.UG + (size_t)r1 * NF + f), u2 = *(const v4u*)(F.UG + (size_t)r2 * NF + f), gt = *(const v4u*)(F.UG + (size_t)m * NF + DFF + f);
        float res[8];
#pragma unroll
        for (int e = 0; e < 8; ++e) { const unsigned sh = 16 * (e & 1);
            const float a0 = bf2f((bf16)(u0[e >> 1] >> sh)), a1 = bf2f((bf16)(u1[e >> 1] >> sh)), a2 = bf2f((bf16)(u2[e >> 1] >> sh)), gv = bf2f((bf16)(gt[e >> 1] >> sh));
            const float c = F.conv_b[f + e] + F.conv_w[f + e] * a2 + F.conv_w[DFF + f + e] * a1 + F.conv_w[2 * DFF + f + e] * a0;
            res[e] = silu(c) * gv; }
        v4u o; o.x = pk2(res[0], res[1]); o.y = pk2(res[2], res[3]); o.z = pk2(res[4], res[5]); o.w = pk2(res[6], res[7]);
        *(v4u*)(F.ACT + (size_t)m * DFF + f) = o;
    }
}

__device__ __forceinline__ void p10_final(Frame& F) {
    const int gw = blockIdx.x * NWAVES + F.wave, NGW = F.G * NWAVES;
    for (int m = gw; m < MR; m += NGW) {
        GAS f32x4* xr = (GAS f32x4*)(F.out + (size_t)m * DM) + F.lane; f32x4 v[16]; float ss = 0.f;
#pragma unroll
        for (int j = 0; j < 16; ++j) { v[j] = xr[64 * j]; ss += (v[j].x * v[j].x + v[j].y * v[j].y) + (v[j].z * v[j].z + v[j].w * v[j].w); }
        ss = wave_sum(ss); const float r = 1.0f / sqrtf(ss * (1.0f / DM) + EPS);
#pragma unroll
        for (int j = 0; j < 16; ++j) { const f32x4 g = *((const GAS f32x4*)F.final_norm + F.lane + 64 * j); xr[64 * j] = v[j] * r * g; }
    }
}

struct Args { const void* in[16]; float* out; unsigned char* ws; int ph_lo, ph_hi, li, pad; };
__global__ void __launch_bounds__(NTHR, 2) fwd(Args args) {
    extern __shared__ __attribute__((aligned(16))) unsigned char lds[];
    Frame F;
    F.lds = (LAS unsigned char*)lds;
    F.MISC = (volatile LAS unsigned*)(F.lds + MISC_OFF);
    F.tid = threadIdx.x; F.lane = F.tid & 63; F.wave = __builtin_amdgcn_readfirstlane(F.tid >> 6); F.G = gridDim.x;
    unsigned char* ws = args.ws;
    F.ctl = (gu32*)(ws + WS_CTL);
    F.x = (const float*)args.in[0]; F.positions = (const int*)args.in[1]; F.meta = (const float*)args.in[2]; F.attn_norm = (const float*)args.in[3]; F.w_in = (const float*)args.in[4];
    F.w_gate_up = (const float*)args.in[5]; F.b_gate = (const float*)args.in[6]; F.ret_norm = (const float*)args.in[7]; F.gla_norm = (const float*)args.in[8]; F.w_out = (const float*)args.in[9];
    F.ffn_norm = (const float*)args.in[10]; F.w_ffn_in = (const float*)args.in[11]; F.conv_w = (const float*)args.in[12]; F.conv_b = (const float*)args.in[13]; F.w_ffn_out = (const float*)args.in[14];
    F.final_norm = (const float*)args.in[15]; F.out = args.out;
    F.W1t = (bf16*)(ws + WS_W1T); F.Wot = (bf16*)(ws + WS_WOT); F.Wft = (bf16*)(ws + WS_WFT); F.W2t = (bf16*)(ws + WS_W2T); F.XB = (bf16*)(ws + WS_XB);
    F.PROJ = (bf16*)(ws + WS_PROJ); F.UG = (bf16*)(ws + WS_UG); F.ACT = (bf16*)(ws + WS_ACT); F.MRG = (bf16*)(ws + WS_MRG); F.H1B = (bf16*)(ws + WS_H1B);
    F.RS1 = (float*)(ws + WS_RS1); F.RS2 = (float*)(ws + WS_RS2); F.ZB = (float*)(ws + WS_ZB); F.COS = (float*)(ws + WS_COS); F.SIN = (float*)(ws + WS_SIN);
    F.YR = (float*)(ws + WS_YR); F.YG = (float*)(ws + WS_YG); F.H1 = (float*)(ws + WS_H1); F.DECG = (float*)(ws + WS_DECG);
    F.QFG = (bf16*)(ws + WS_QFG); F.KFG = (bf16*)(ws + WS_KFG); F.QFR = (bf16*)(ws + WS_QFR); F.KFR = (bf16*)(ws + WS_KFR);
    F.VFG = (bf16*)(ws + WS_VFG); F.VFR = (bf16*)(ws + WS_VFR); F.PFG = (bf16*)(ws + WS_PFG); F.PFR = (bf16*)(ws + WS_PFR);
    for (int u = F.tid; u < (LDS_BYTES - LDSCTL_OFF) / 4; u += NTHR) ((LAS unsigned*)(F.lds + LDSCTL_OFF))[u] = 0u;
    __syncthreads();
    XcdBarrier bar; bar.bar = (unsigned*)(F.ctl + CW_BAR); bar.x = 0; bar.st = nullptr;
    if (N_LAUNCHES != NPH) bar = xcd_barrier_post((unsigned*)(F.ctl + CW_BAR) + args.li * XCD_BAR_WORDS, F.MISC + 8);
#define GRID_BAR(seam) do { if (N_LAUNCHES == NPH) { if (F.tid == 0) __hip_atomic_store(F.ctl + CW_TMO, 0xBADBA0u | (unsigned)(seam), RLX_AGENT); } else { xcd_barrier(bar); } } while (0)
    const int lo = args.ph_lo, hi = args.ph_hi;
#define IN(k) (lo <= (k) && (k) < hi)
#define BOTH(k) (IN(k) && IN((k) + 1))
    if (IN(0)) { p0_prologue(F); if (BOTH(0)) GRID_BAR(0); }
    if (IN(1)) {
        pg8::Gemm g{F.XB, F.W1t, MT, N1, DM}; pg8::StaticOrder S; S.init(MT, N1, F.G, (int)blockIdx.x);
        pg8::EpiG1 E{F.PROJ, N1, F.RS1, F.ZB};
        pg8::gemm_phase<pg8::EpiG1, pg8::StaticOrder, PG8_ALIGN, PG8_SP2>(F.lds + RING_OFF, g, S, E);
        if (BOTH(1)) GRID_BAR(1);
    }
    if (IN(2)) { p2_prep(F); if (BOTH(2)) GRID_BAR(2); }
    if (IN(3)) { p3_scan(F); if (BOTH(3)) GRID_BAR(3); }
    if (IN(4)) { p4_merge(F); if (BOTH(4)) GRID_BAR(4); }
    if (IN(5)) {
        pg8::Gemm g{F.MRG, F.Wot, MT, DM, DM}; pg8::StaticOrder S; S.init(MT, DM, F.G, (int)blockIdx.x);
        pg8::EpiResX E{F.x, F.meta, F.H1, DM, MR, NMETA};
        pg8::gemm_phase<pg8::EpiResX, pg8::StaticOrder, PG8_ALIGN, PG8_SP2>(F.lds + RING_OFF, g, S, E);
        if (BOTH(5)) GRID_BAR(5);
    }
    if (IN(6)) { p6_rows(F); if (BOTH(6)) GRID_BAR(6); }
    if (IN(7)) {
        pg8::Gemm g{F.H1B, F.Wft, MT, NF, DM}; pg8::StaticOrder S; S.init(MT, NF, F.G, (int)blockIdx.x);
        pg8::EpiScaleBf16 E{F.UG, NF, F.RS2};
        pg8::gemm_phase<pg8::EpiScaleBf16, pg8::StaticOrder, PG8_ALIGN, PG8_SP2>(F.lds + RING_OFF, g, S, E);
        if (BOTH(7)) GRID_BAR(7);
    }
    if (IN(8)) { p8_act(F); if (BOTH(8)) GRID_BAR(8); }
    if (IN(9)) {
        pg8::Gemm g{F.ACT, F.W2t, MR, DM, DFF}; pg8::StaticOrder S; S.init(MR, DM, F.G, (int)blockIdx.x);
        pg8::EpiResF32 E{F.H1, F.out, DM};
        pg8::gemm_phase<pg8::EpiResF32, pg8::StaticOrder, PG8_ALIGN, PG8_SP2>(F.lds + RING_OFF, g, S, E);
        if (BOTH(9)) GRID_BAR(9);
    }
    if (IN(10)) { p10_final(F); }
#undef IN
#undef BOTH
}

extern "C" void kernel_launch(void* const* d_in, const int* in_sizes, int n_in, void* d_out, int out_size, void* d_ws, size_t ws_size, hipStream_t stream) {
    static int grid = 0;
    if (grid == 0) {
        if (n_in != 16 || in_sizes[0] != MR * DM || out_size != MR * DM || ws_size < WS_END) {
            fprintf(stderr, "kernel_launch: shape/workspace mismatch: n_in %d in0 %d out %d ws %zu (need %zu); nothing launched\n", n_in, n_in > 0 ? in_sizes[0] : -1, out_size, ws_size, (size_t)WS_END); grid = -1; return; }
        int dev = 0, cus = 0, per_cu = 0;
        if (hipGetDevice(&dev) != hipSuccess || hipDeviceGetAttribute(&cus, hipDeviceAttributeMultiprocessorCount, dev) != hipSuccess) { fprintf(stderr, "kernel_launch: device query failed\n"); grid = -1; return; }
        if (hipFuncSetAttribute((const void*)fwd, hipFuncAttributeMaxDynamicSharedMemorySize, LDS_BYTES) != hipSuccess) { fprintf(stderr, "kernel_launch: hipFuncSetAttribute failed\n"); grid = -1; return; }
        if (hipOccupancyMaxActiveBlocksPerMultiprocessor(&per_cu, (const void*)fwd, NTHR, LDS_BYTES) != hipSuccess || per_cu < 1)
            fprintf(stderr, "kernel_launch: note: occupancy query reports %d workgroups per CU\n", per_cu);
        (void)hipGetLastError();
        grid = cus;
    }
    if (grid < 0) return;
    if (hipMemsetAsync((char*)d_ws + WS_CTL, 0, CTL_ZERO_BYTES, stream) != hipSuccess) { fprintf(stderr, "kernel_launch: memset failed\n"); return; }
    Args a{};
    for (int i = 0; i < 16; ++i) a.in[i] = d_in[i];
    a.out = (float*)d_out; a.ws = (unsigned char*)d_ws;
    for (int li = 0; li < N_LAUNCHES; ++li) {
        a.ph_lo = (N_LAUNCHES == NPH) ? li : 0; a.ph_hi = (N_LAUNCHES == NPH) ? li + 1 : NPH; a.li = (N_LAUNCHES == NPH) ? 0 : li;
        hipLaunchKernelGGL(fwd, dim3(grid), dim3(NTHR), LDS_BYTES, stream, a);
        const hipError_t le = hipPeekAtLastError();
        if (le != hipSuccess) { fprintf(stderr, "kernel_launch: launch %d failed: %s\n", li, hipGetErrorName(le)); break; }
    }
}
```

```cpp
#include <hip/hip_runtime.h>
#include <cstdio>
#include <cstdint>
namespace pg8 {
#define PG8_LAS __attribute__((address_space(3)))
typedef unsigned short bf16_t;
typedef short bf16x8 __attribute__((ext_vector_type(8)));
typedef float f32x4 __attribute__((ext_vector_type(4)));
typedef unsigned u32x4 __attribute__((ext_vector_type(4)));
constexpr int BM = 256, BK = 64, HALF = 128, HTB = HALF * BK * 2  , STAGE_BYTES = 8 * HTB, NXCD = 8, WGM = 8;

__host__ __device__ __forceinline__ int lds_byte(int r, int c) { const int st = (r >> 4) * 2 + (c >> 5), rr = r & 15, cc = c & 31, ob = rr * 64 + cc * 2; return st * 1024 + (ob ^ (((ob >> 9) & 1) << 5)); }
__host__ __device__ __forceinline__ void stage_rc(int b, int& R, int& C) { const int st = b / 1024, sb = b % 1024, swz = sb ^ (((sb >> 9) & 1) << 5); R = (st >> 1) * 16 + swz / 64; C = (st & 1) * 32 + (swz % 64) / 2; }
__host__ __device__ __forceinline__ int perm32(int rho) { const int n = rho >> 4, i = rho & 15; return 8 * (i >> 2) + 4 * n + (i & 3); }

struct Unit { int pm, pn; };
struct Gemm { const bf16_t* A; const bf16_t* Bt; int M, N, K; };

struct StaticOrder {
    int nM, nN, nwg, G, c;
    __host__ __device__ void init(int M, int N, int G_, int c_) { nM = M / BM; nN = N / BM; nwg = nM * nN; G = G_; c = c_; }
    __host__ __device__ bool next(int i, Unit& u) const {
        const long L = (long)i * G + c; if (L >= nwg) return false;
        int wgid = (int)L; { const int q = nwg / NXCD, r = nwg % NXCD, xcd = wgid % NXCD, off = wgid / NXCD; wgid = (xcd < r ? xcd * (q + 1) : r * (q + 1) + (xcd - r) * q) + off; }
        const int nig = WGM * nN, gid = wgid / nig, fm = gid * WGM, gsz = (nM - fm) < WGM ? (nM - fm) : WGM;
        u.pm = fm + ((wgid % nig) % gsz); u.pn = (wgid % nig) / gsz; return true;
    }
    __device__ __forceinline__ void a_ready(const Unit&) const {}
    __device__ __forceinline__ void done(const Unit&) const {}
};
__device__ __forceinline__ unsigned cvt_pk_bf16(float lo, float hi) { unsigned r; asm volatile("v_cvt_pk_bf16_f32 %0, %1, %2" : "=v"(r) : "v"(lo), "v"(hi)); return r; }
template <class Epi, class Sched, bool ALIGN_EPI = false, bool SP2 = false>
__device__ __forceinline__ void gemm_phase(PG8_LAS unsigned char* lds, const Gemm g, const Sched& S, const Epi& E) {
    const int tid = threadIdx.x, wid = __builtin_amdgcn_readfirstlane(tid >> 6), lane = tid & 63, wr = wid >> 2, wc = wid & 3, fr = lane & 15, fq = lane >> 4;
    const int K = g.K, nt = K / BK;
    unsigned voffA[2], voffB[2];
#pragma unroll
    for (int i = 0; i < 2; ++i) { int R, C; stage_rc(tid * 16 + i * 8192, R, C); const int Rb = Epi::PERM ? ((R & ~31) + perm32(R & 31)) : R;
        voffA[i] = (unsigned)(R * K + C) * 2u; voffB[i] = (unsigned)(Rb * K + C) * 2u; }
    const size_t kstep = (size_t)(BK * 2);
    const size_t hstep = (size_t)HALF * K * 2;
    const size_t tstep = 2 * hstep;
    const unsigned ldsw = (unsigned)wid * 1024u;
    const int aoff = lds_byte(wr * 64 + fr, fq * 8), boff = lds_byte(wc * 32 + fr, fq * 8);
#define PG8_SA(b, h) (((b) * 2 + (h)) * HTB)
#define PG8_SB(b, h) ((4 + (b) * 2 + (h)) * HTB)
#define PG8_STAGE(bufoff, gbase, voff) do { _Pragma("unroll") for (int _i = 0; _i < 2; ++_i) \
        __builtin_amdgcn_global_load_lds((const unsigned*)((const char*)(gbase) + (voff)[_i]), (PG8_LAS unsigned*)(lds + (bufoff) + ldsw + _i * 8192), 16, 0, 0); } while (0)
#define PG8_LDA(dst, b, h) do { _Pragma("unroll") for (int m = 0; m < 4; ++m) _Pragma("unroll") for (int k = 0; k < 2; ++k) dst[m][k] = *(const PG8_LAS bf16x8*)(lds + PG8_SA(b, h) + aoff + m * 2048 + k * 1024); } while (0)
#define PG8_LDB(dst, b, h) do { _Pragma("unroll") for (int n = 0; n < 2; ++n) _Pragma("unroll") for (int k = 0; k < 2; ++k) dst[n][k] = *(const PG8_LAS bf16x8*)(lds + PG8_SB(b, h) + boff + n * 2048 + k * 1024); } while (0)
#define PG8_MMA(ai, bj, At, Bt) do { __builtin_amdgcn_s_setprio(1); _Pragma("unroll") for (int m = 0; m < 4; ++m) _Pragma("unroll") for (int n = 0; n < 2; ++n) _Pragma("unroll") for (int k = 0; k < 2; ++k) \
        acc[ai][bj][m][n] = __builtin_amdgcn_mfma_f32_16x16x32_bf16(Bt[n][k], At[m][k], acc[ai][bj][m][n], 0, 0, 0); __builtin_amdgcn_s_setprio(0); } while (0)
#define PG8_WAIT_V(n) asm volatile("s_waitcnt vmcnt(" #n ")" ::: "memory")
#define PG8_WAIT_L(n) asm volatile("s_waitcnt lgkmcnt(" #n ")" ::: "memory")
#define PG8_BAR __builtin_amdgcn_s_barrier()
#define PG8_SCHED __builtin_amdgcn_sched_barrier(0)
    Unit cur, nxt; int ui = 0;
    if (!S.next(0, cur)) return;
    f32x4 acc[2][2][4][2];
#pragma unroll
    for (int a = 0; a < 2; ++a)
#pragma unroll
        for (int b = 0; b < 2; ++b)
#pragma unroll
            for (int m = 0; m < 4; ++m)
#pragma unroll
                for (int n = 0; n < 2; ++n) acc[a][b][m][n] = (f32x4){0.f, 0.f, 0.f, 0.f};
    bf16x8 At[4][2], B0[2][2], B1[2][2];
    const char* cA = (const char*)g.A + (size_t)cur.pm * tstep; const char* cB = (const char*)g.Bt + (size_t)cur.pn * tstep;
    S.a_ready(cur);
    if constexpr (SP2) {
        PG8_STAGE(PG8_SB(0, 0), cB, voffB); PG8_STAGE(PG8_SB(0, 1), cB + hstep, voffB); PG8_STAGE(PG8_SA(0, 0), cA, voffA); PG8_STAGE(PG8_SA(0, 1), cA + hstep, voffA);
        if (wr == 1) PG8_BAR;
        PG8_WAIT_V(2); PG8_BAR;
        PG8_STAGE(PG8_SB(1, 0), cB + kstep, voffB); PG8_STAGE(PG8_SA(1, 0), cA + kstep, voffA); PG8_STAGE(PG8_SB(1, 1), cB + hstep + kstep, voffB);
        PG8_WAIT_V(6); PG8_BAR;
    } else {
        PG8_STAGE(PG8_SB(0, 0), cB, voffB); PG8_STAGE(PG8_SA(0, 0), cA, voffA); PG8_STAGE(PG8_SB(0, 1), cB + hstep, voffB); PG8_STAGE(PG8_SA(0, 1), cA + hstep, voffA);
        if (wr == 1) PG8_BAR;
        PG8_WAIT_V(4); PG8_BAR;
        PG8_STAGE(PG8_SB(1, 0), cB + kstep, voffB); PG8_STAGE(PG8_SA(1, 0), cA + kstep, voffA); PG8_STAGE(PG8_SB(1, 1), cB + hstep + kstep, voffB);
        PG8_WAIT_V(6); PG8_BAR;
    }
    for (;;) {
        const bool has_next = S.next(ui + 1, nxt);
        const char* nA = has_next ? (const char*)g.A + (size_t)nxt.pm * tstep : cA; const char* nB = has_next ? (const char*)g.Bt + (size_t)nxt.pn * tstep : cB;
        for (int t = 0; t < nt; t += 2) {
            const bool last = (t == nt - 2);
            const char* a1 = cA + (size_t)(t + 1) * kstep;
            const char* a2 = last ? nA : cA + (size_t)(t + 2) * kstep; const char* b2 = last ? nB : cB + (size_t)(t + 2) * kstep;
            const char* a3 = a2 + kstep; const char* b3 = b2 + kstep;
            if (last && has_next) S.a_ready(nxt);
            if constexpr (SP2) {
            PG8_LDB(B0, 0, 0); PG8_LDB(B1, 0, 1); PG8_SCHED; PG8_LDA(At, 0, 0); PG8_STAGE(PG8_SA(1, 1), a1 + hstep, voffA);
            PG8_WAIT_V(8); PG8_WAIT_L(0); PG8_BAR; PG8_MMA(0, 0, At, B0); PG8_MMA(0, 1, At, B1); PG8_BAR; PG8_SCHED;
            PG8_LDA(At, 0, 1); PG8_STAGE(PG8_SB(0, 0), b2, voffB); PG8_STAGE(PG8_SB(0, 1), b2 + hstep, voffB); PG8_STAGE(PG8_SA(0, 0), a2, voffA);
            PG8_WAIT_V(8); PG8_WAIT_L(0); PG8_BAR; PG8_MMA(1, 0, At, B0); PG8_MMA(1, 1, At, B1); PG8_BAR; PG8_SCHED;
            PG8_LDB(B0, 1, 0); PG8_LDB(B1, 1, 1); PG8_SCHED; PG8_LDA(At, 1, 0); PG8_STAGE(PG8_SA(0, 1), a2 + hstep, voffA);
            PG8_WAIT_V(8); PG8_WAIT_L(0); PG8_BAR; PG8_MMA(0, 0, At, B0); PG8_MMA(0, 1, At, B1); PG8_BAR; PG8_SCHED;
            PG8_LDA(At, 1, 1); PG8_STAGE(PG8_SB(1, 0), b3, voffB); PG8_STAGE(PG8_SB(1, 1), b3 + hstep, voffB); PG8_STAGE(PG8_SA(1, 0), a3, voffA);
            PG8_WAIT_V(8); PG8_WAIT_L(0); PG8_BAR; PG8_MMA(1, 0, At, B0); PG8_MMA(1, 1, At, B1); PG8_BAR; PG8_SCHED;
            } else {
            PG8_LDB(B0, 0, 0); PG8_SCHED; PG8_LDA(At, 0, 0); PG8_STAGE(PG8_SA(1, 1), a1 + hstep, voffA);
            PG8_WAIT_L(8); PG8_BAR; PG8_WAIT_L(0); PG8_MMA(0, 0, At, B0); PG8_BAR; PG8_SCHED;
            PG8_LDB(B1, 0, 1); PG8_STAGE(PG8_SB(0, 0), b2, voffB);
            PG8_BAR; PG8_WAIT_L(0); PG8_MMA(0, 1, At, B1); PG8_BAR;
            PG8_LDA(At, 0, 1); PG8_STAGE(PG8_SA(0, 0), a2, voffA);
            PG8_BAR; PG8_WAIT_L(0); PG8_MMA(1, 0, At, B0); PG8_BAR; PG8_SCHED;
            PG8_STAGE(PG8_SB(0, 1), b2 + hstep, voffB);
            PG8_WAIT_V(6); PG8_BAR; PG8_MMA(1, 1, At, B1); PG8_BAR;
            PG8_LDB(B0, 1, 0); PG8_SCHED; PG8_LDA(At, 1, 0); PG8_STAGE(PG8_SA(0, 1), a2 + hstep, voffA);
            PG8_WAIT_L(8); PG8_BAR; PG8_WAIT_L(0); PG8_MMA(0, 0, At, B0); PG8_BAR; PG8_SCHED;
            PG8_LDB(B1, 1, 1); PG8_STAGE(PG8_SB(1, 0), b3, voffB);
            PG8_BAR; PG8_WAIT_L(0); PG8_MMA(0, 1, At, B1); PG8_BAR;
            PG8_LDA(At, 1, 1); PG8_STAGE(PG8_SA(1, 0), a3, voffA);
            PG8_BAR; PG8_WAIT_L(0); PG8_MMA(1, 0, At, B0); PG8_BAR; PG8_SCHED;
            PG8_STAGE(PG8_SB(1, 1), b3 + hstep, voffB);
            PG8_WAIT_V(6); PG8_BAR; PG8_MMA(1, 1, At, B1); PG8_BAR;
            }
        }
        if constexpr (ALIGN_EPI) { if (wr == 0) PG8_BAR; }
        if constexpr (!Epi::AFTER_DRAIN) { E(acc, cur, wr, wc, fr, fq); S.done(cur); }
        if (!has_next) break;
#pragma unroll
        for (int a = 0; a < 2; ++a)
#pragma unroll
            for (int b = 0; b < 2; ++b)
#pragma unroll
                for (int m = 0; m < 4; ++m)
#pragma unroll
                    for (int n = 0; n < 2; ++n) acc[a][b][m][n] = (f32x4){0.f, 0.f, 0.f, 0.f};
        cur = nxt; cA = nA; cB = nB; ++ui;
        if constexpr (ALIGN_EPI) { if (wr == 1) PG8_BAR; }
    }
    PG8_WAIT_V(0);
    if constexpr (!ALIGN_EPI) { if (wr == 0) PG8_BAR; }
    PG8_BAR;
    if constexpr (Epi::AFTER_DRAIN) { E.fused(acc, cur, wr, wc, fr, fq, lds, wid, lane); S.done(cur); }
#undef PG8_SA
#undef PG8_SB
#undef PG8_STAGE
#undef PG8_LDA
#undef PG8_LDB
#undef PG8_MMA
#undef PG8_WAIT_V
#undef PG8_WAIT_L
#undef PG8_BAR
#undef PG8_SCHED
}
}
#define GAS __attribute__((address_space(1)))
#define LAS __attribute__((address_space(3)))
typedef unsigned short bf16;
typedef unsigned v4u __attribute__((ext_vector_type(4)));
typedef float f32x4 __attribute__((ext_vector_type(4)));
typedef short bf16x8 __attribute__((ext_vector_type(8)));
typedef GAS unsigned gu32;
typedef GAS unsigned long long gu64;
#define RLX_AGENT __ATOMIC_RELAXED, __HIP_MEMORY_SCOPE_AGENT
#define LDS_WAIT() asm volatile("s_waitcnt lgkmcnt(0)" ::: "memory")
#define VM_WAIT() asm volatile("s_waitcnt vmcnt(0)" ::: "memory")
__device__ __forceinline__ unsigned long long rt() { return __builtin_amdgcn_s_memrealtime(); }
__device__ __forceinline__ unsigned f2bf(float f) { unsigned u = __builtin_bit_cast(unsigned, f); return (u + 0x7fffu + ((u >> 16) & 1u)) >> 16; }
__device__ __forceinline__ unsigned pk2(float lo, float hi) { return f2bf(lo) | (f2bf(hi) << 16); }
#define XB_TMO      128
#define XB_XCNT(j)  (256  + 64 * (j))
#define XB_XSUB(j)  (1280 + 64 * (j))
#define XB_XGEN(j)  (2304 + 64 * (j))
#define XB_TOP      3328
#define XB_TOPGEN   3392
#define XCD_BAR_WORDS 3456
#define XB_SPIN_CAP (1u << 18)

__device__ __forceinline__ unsigned xb_ld(unsigned* p)              { return __hip_atomic_load(p, __ATOMIC_RELAXED, __HIP_MEMORY_SCOPE_AGENT); }
__device__ __forceinline__ unsigned xb_add(unsigned* p, unsigned v) { return __hip_atomic_fetch_add(p, v, __ATOMIC_RELAXED, __HIP_MEMORY_SCOPE_AGENT); }
__device__ __forceinline__ unsigned xb_xcc_id() { return (unsigned)__builtin_amdgcn_s_getreg((3 << 11) | 20) & 0xFu; }
#define XB_SPIN(cond, bar) do { unsigned _sp = 0; while (cond) { __builtin_amdgcn_s_sleep(1); \
    if ((++_sp & 255u) == 0u) { if (xb_ld(&(bar)[XB_TMO])) break; if (_sp > XB_SPIN_CAP) { atomicAdd(&(bar)[XB_TMO], 1u); break; } } } } while (0)

struct XcdBarrier {
    unsigned* bar; unsigned x;
    volatile LAS unsigned* st;
};

__device__ __forceinline__ XcdBarrier xcd_barrier_post(unsigned* bar, volatile LAS unsigned* st) {
    XcdBarrier b; b.bar = bar; b.x = xb_xcc_id(); b.st = st;
    if (threadIdx.x == 0) (void)xb_add(&bar[XB_XCNT(b.x)], 1u);
    return b;
}
__device__ __forceinline__ void xcd_barrier_complete(unsigned* bar, unsigned x, unsigned& nloc, unsigned& nx) {
    const unsigned G = gridDim.x * gridDim.y * gridDim.z;
    unsigned sum, cnt, mine, sp = 0u;
    for (;;) {
        sum = 0u; cnt = 0u; mine = 0u;
#pragma unroll
        for (unsigned j = 0; j < 16; ++j) { const unsigned c = xb_ld(&bar[XB_XCNT(j)]); sum += c; cnt += (c > 0u) ? 1u : 0u; mine = (j == x) ? c : mine; }
        if (sum == G) break;
        __builtin_amdgcn_s_sleep(1);
        if ((++sp & 255u) == 0u) { if (xb_ld(&bar[XB_TMO])) break; if (sp > XB_SPIN_CAP) { atomicAdd(&bar[XB_TMO], 1u); break; } }
    }
    nloc = mine > 0u ? mine : 1u; nx = cnt > 0u ? cnt : 1u;
}

__device__ __forceinline__ void xcd_barrier(const XcdBarrier& b) {
    asm volatile("s_waitcnt vmcnt(0)" ::: "memory");
    __syncthreads();
    if (threadIdx.x == 0) {
        unsigned* bar = b.bar;
        __builtin_amdgcn_s_waitcnt(0);
        unsigned nloc = b.st[0], nx = b.st[1];
        if (nloc == 0u) { xcd_barrier_complete(bar, b.x, nloc, nx); b.st[0] = nloc; b.st[1] = nx; }
        const unsigned old = xb_add(&bar[XB_XSUB(b.x)], 1u);
        const unsigned gen = old / nloc;
        if (old + 1u == (gen + 1u) * nloc) {
            __builtin_amdgcn_fence(__ATOMIC_RELEASE, "agent");
            asm volatile("s_waitcnt vmcnt(0)" ::: "memory");
            const unsigned og = xb_add(&bar[XB_TOP], 1u);
            const unsigned tg = og / nx;
            if (og + 1u == (tg + 1u) * nx) xb_add(&bar[XB_TOPGEN], 1u);
            else XB_SPIN(xb_ld(&bar[XB_TOPGEN]) == tg, bar);
            __builtin_amdgcn_fence(__ATOMIC_ACQUIRE, "agent");
            xb_add(&bar[XB_XGEN(b.x)], 1u);
            asm volatile("s_waitcnt vmcnt(0)" ::: "memory");
        } else {
            XB_SPIN(xb_ld(&bar[XB_XGEN(b.x)]) == gen, bar);
            __builtin_amdgcn_fence(__ATOMIC_ACQUIRE, "agent");
            asm volatile("s_waitcnt vmcnt(0)" ::: "memory");
        }
    }
    __syncthreads();
}
#define REP_MASK 0u
#ifndef PG8_SP2
#define PG8_SP2 true
#endif
#ifndef PG8_ALIGN
#define PG8_ALIGN true
#endif
constexpr int NWAVES = 8, NTHR = NWAVES * 64;
constexpr int BATCH = 4, SEQ = 2048, DM = 4096, NMETA = 16;
constexpr int MR = BATCH * SEQ;
constexpr int MROWS = MR + NMETA;
constexpr int MT = 8448;
constexpr int NIN = 32784;
constexpr int N1 = 33024;
constexpr int DFF = 11008, NF = 2 * DFF;
constexpr int RET_H = 8, RET_DK = 256, RET_DV = 512, GLA_H = 4, GLA_DK = 512, GLA_DV = 1024, GLA_RANK = 16;
constexpr float EPS = 1e-6f;
constexpr int C_QR = 0, C_KR = 2048, C_VR = 4096, C_OR = 8192, C_QG = 12288, C_KG = 14336, C_VG = 16384, C_OG = 20480, C_MR = 24576, C_MG = 28672, C_Z = 32768;
constexpr int NPH = 11;
#ifndef MK_N_LAUNCHES
#define MK_N_LAUNCHES 1
#endif
constexpr int N_LAUNCHES = MK_N_LAUNCHES;

constexpr size_t al256(size_t x) { return (x + 255) & ~(size_t)255; }
constexpr size_t WS_CTL = 0, CTL_ZERO_BYTES = 1u << 20;
constexpr size_t WS_W1T = WS_CTL + CTL_ZERO_BYTES;
constexpr size_t WS_WOT = WS_W1T + al256((size_t)N1 * DM * 2);
constexpr size_t WS_WFT = WS_WOT + al256((size_t)DM * DM * 2);
constexpr size_t WS_W2T = WS_WFT + al256((size_t)NF * DM * 2);
constexpr size_t WS_XB  = WS_W2T + al256((size_t)DM * DFF * 2);
constexpr size_t WS_RS1 = WS_XB + al256((size_t)MT * DM * 2);
constexpr size_t WS_RS2 = WS_RS1 + al256((size_t)MT * 4);
constexpr size_t WS_ZB  = WS_RS2 + al256((size_t)MT * 4);
constexpr size_t WS_COS = WS_ZB + al256((size_t)MT * 16 * 4);
constexpr size_t WS_SIN = WS_COS + al256((size_t)MROWS * 128 * 4);
constexpr size_t WS_PROJ = WS_SIN + al256((size_t)MROWS * 128 * 4);
constexpr size_t WS_UG  = WS_PROJ;
constexpr size_t WS_ACT = WS_UG + al256((size_t)MT * NF * 2);
constexpr size_t WS_YR  = WS_PROJ + al256((size_t)MT * N1 * 2);
constexpr size_t WS_YG  = WS_YR + al256((size_t)MROWS * DM * 4);
constexpr size_t WS_MRG = WS_YG + al256((size_t)MROWS * DM * 4);
constexpr size_t WS_H1  = WS_MRG + al256((size_t)MT * DM * 2);
constexpr size_t WS_H1B = WS_H1 + al256((size_t)MT * DM * 4);
constexpr size_t WS_QFG = WS_H1B + al256((size_t)MT * DM * 2);
constexpr size_t WS_KFG = WS_QFG + (size_t)4 * 4 * 33 * 65536;
constexpr size_t WS_QFR = WS_KFG + (size_t)4 * 4 * 33 * 65536;
constexpr size_t WS_KFR = WS_QFR + (size_t)4 * 8 * 33 * 32768;
constexpr size_t WS_VFG = WS_KFR + (size_t)4 * 8 * 33 * 32768;
constexpr size_t WS_VFR = WS_VFG + (size_t)4 * 33 * 64 * 8192;
constexpr size_t WS_PFG = WS_VFR + (size_t)4 * 33 * 64 * 8192;
constexpr size_t WS_PFR = WS_PFG + (size_t)4 * 4 * 33 * 8192;
constexpr size_t WS_DECG = WS_PFR + (size_t)4 * 8 * 33 * 8192;
constexpr size_t WS_END = WS_DECG + (size_t)4 * 4 * 33 * 512 * 4;
static_assert(WS_ACT + (size_t)MR * DFF * 2 <= WS_YR, "UG | ACT overlay fits inside PROJ");
static_assert(WS_END <= (size_t)4 * 4096 * NIN * 4, "workspace map fits 4 x the largest tensor");
constexpr int CW_TMO = 0, CW_CODE = 1, CW_BAR = 4096;

constexpr int RING_OFF = 0, RING_BYTES = 131072;
constexpr int LDS_BYTES = 163840;
constexpr int LDSCTL_OFF = LDS_BYTES - 1024, MISC_OFF = LDSCTL_OFF + 320;
static_assert(MISC_OFF + 128 <= LDS_BYTES, "LDS map");

__device__ __forceinline__ float bf2f(bf16 v) { return __builtin_bit_cast(float, (unsigned)v << 16); }
__device__ __forceinline__ float wave_sum(float v) {
#pragma unroll
    for (int o = 1; o < 64; o <<= 1) v += __shfl_xor(v, o);
    return v;
}
__device__ __forceinline__ float sigm(float x) { return 1.f / (1.f + __expf(-x)); }
__device__ __forceinline__ float silu(float x) { return x / (1.f + __expf(-x)); }
__device__ __forceinline__ float logsig(float x) { return fminf(x, 0.f) - log1pf(__expf(-fabsf(x))); }

typedef float f32x16 __attribute__((ext_vector_type(16)));
#define MFMA32(a, b, c) __builtin_amdgcn_mfma_f32_32x32x16_bf16((a), (b), (c), 0, 0, 0)
__device__ __forceinline__ unsigned pkbf(float lo, float hi) { typedef __bf16 b2 __attribute__((ext_vector_type(2))); typedef float f2 __attribute__((ext_vector_type(2))); return __builtin_bit_cast(unsigned, __builtin_convertvector((f2){lo, hi}, b2)); }
__device__ __forceinline__ bf16 f2b(float x) { return (bf16)(pkbf(x, 0.f) & 0xffffu); }
__device__ __forceinline__ int chunk_row(int b, int n, int i) { return n == 0 ? (i < 48 ? -1 : MR + i - 48) : b * SEQ + 64 * (n - 1) + i; }

struct Frame {
    LAS unsigned char* lds;
    volatile LAS unsigned* MISC;
    gu32* ctl;
    int tid, lane, wave, G;
    const float *x, *meta, *attn_norm, *w_in, *w_gate_up, *b_gate, *ret_norm, *gla_norm, *w_out, *ffn_norm, *w_ffn_in, *conv_w, *conv_b, *w_ffn_out, *final_norm;
    const int* positions;
    float* out;
    bf16 *W1t, *Wot, *Wft, *W2t, *XB, *PROJ, *UG, *ACT, *MRG, *H1B;
    float *RS1, *RS2, *ZB, *COS, *SIN, *YR, *YG, *H1, *DECG;
    bf16 *QFG, *KFG, *QFR, *KFR, *VFG, *VFR, *PFG, *PFR;
};

namespace pg8 {
struct EpiG1 {
    static constexpr bool PERM = true, AFTER_DRAIN = false;
    bf16_t* O; int ldc; const float* rs; float* zb;
    __device__ __forceinline__ void operator()(const f32x4 (&acc)[2][2][4][2], const Unit& u, int wr, int wc, int fr, int fq) const {
        const int row0 = u.pm * BM + wr * 64 + fr, col0 = u.pn * BM + wc * 32 + 8 * fq;
#pragma unroll
        for (int ai = 0; ai < 2; ++ai)
#pragma unroll
            for (int m = 0; m < 4; ++m) { const int row = row0 + ai * HALF + m * 16; const float s = rs[row]; bf16_t* rowp = O + (size_t)row * ldc + col0;
#pragma unroll
                for (int bj = 0; bj < 2; ++bj) { const f32x4 v0 = acc[ai][bj][m][0] * s, v1 = acc[ai][bj][m][1] * s;
                    u32x4 w; w.x = cvt_pk_bf16(v0[0], v0[1]); w.y = cvt_pk_bf16(v0[2], v0[3]); w.z = cvt_pk_bf16(v1[0], v1[1]); w.w = cvt_pk_bf16(v1[2], v1[3]);
                    *(u32x4*)(rowp + bj * HALF) = w;
                    if (bj == 0 && u.pn == 128 && wc == 0 && fq < 2) { float* zp = zb + (size_t)row * 16 + 8 * fq; *(f32x4*)zp = v0; *(f32x4*)(zp + 4) = v1; } } }
    }
};
struct EpiScaleBf16 {
    static constexpr bool PERM = true, AFTER_DRAIN = false;
    bf16_t* O; int ldc; const float* rs;
    __device__ __forceinline__ void operator()(const f32x4 (&acc)[2][2][4][2], const Unit& u, int wr, int wc, int fr, int fq) const {
        const int row0 = u.pm * BM + wr * 64 + fr, col0 = u.pn * BM + wc * 32 + 8 * fq;
#pragma unroll
        for (int ai = 0; ai < 2; ++ai)
#pragma unroll
            for (int m = 0; m < 4; ++m) { const int row = row0 + ai * HALF + m * 16; const float s = rs[row]; bf16_t* rowp = O + (size_t)row * ldc + col0;
#pragma unroll
                for (int bj = 0; bj < 2; ++bj) { const f32x4 v0 = acc[ai][bj][m][0] * s, v1 = acc[ai][bj][m][1] * s;
                    u32x4 w; w.x = cvt_pk_bf16(v0[0], v0[1]); w.y = cvt_pk_bf16(v0[2], v0[3]); w.z = cvt_pk_bf16(v1[0], v1[1]); w.w = cvt_pk_bf16(v1[2], v1[3]);
                    *(u32x4*)(rowp + bj * HALF) = w; } }
    }
};
struct EpiResX {
    static constexpr bool PERM = false, AFTER_DRAIN = false;
    const float* x; const float* meta; float* out; int ldc; int nreal, nmeta;
    __device__ __forceinline__ void operator()(const f32x4 (&acc)[2][2][4][2], const Unit& u, int wr, int wc, int fr, int fq) const {
        const int row0 = u.pm * BM + wr * 64 + fr, col0 = u.pn * BM + wc * 32 + 4 * fq;
#pragma unroll
        for (int ai = 0; ai < 2; ++ai)
#pragma unroll
            for (int m = 0; m < 4; ++m) { const int row = row0 + ai * HALF + m * 16;
                const float* bp = row < nreal ? x + (size_t)row * ldc : (row < nreal + nmeta ? meta + (size_t)(row - nreal) * ldc : nullptr);
                float* rowp = out + (size_t)row * ldc + col0;
#pragma unroll
                for (int bj = 0; bj < 2; ++bj)
#pragma unroll
                    for (int n = 0; n < 2; ++n) { f32x4 o = (f32x4){0.f, 0.f, 0.f, 0.f};
                        if (bp) o = *(const f32x4*)(bp + col0 + bj * HALF + n * 16) + acc[ai][bj][m][n];
                        *(f32x4*)(rowp + bj * HALF + n * 16) = o; } }
    }
};
struct EpiResF32 {
    static constexpr bool PERM = false, AFTER_DRAIN = false;
    const float* base; float* out; int ldc;
    __device__ __forceinline__ void operator()(const f32x4 (&acc)[2][2][4][2], const Unit& u, int wr, int wc, int fr, int fq) const {
        const int row0 = u.pm * BM + wr * 64 + fr, col0 = u.pn * BM + wc * 32 + 4 * fq;
#pragma unroll
        for (int ai = 0; ai < 2; ++ai)
#pragma unroll
            for (int m = 0; m < 4; ++m) { const size_t off = (size_t)(row0 + ai * HALF + m * 16) * ldc + col0;
#pragma unroll
                for (int bj = 0; bj < 2; ++bj)
#pragma unroll
                    for (int n = 0; n < 2; ++n) *(f32x4*)(out + off + bj * HALF + n * 16) = *(const f32x4*)(base + off + bj * HALF + n * 16) + acc[ai][bj][m][n]; }
    }
};
}

struct TItem { const float* W; int K, ldw, c0, nc; bf16* WT; int row_off; const float* kscale; int item; };
__device__ __forceinline__ void titem_load(const TItem& t, f32x4 (&v)[16], int lane) {
    const int nblk = (t.nc + 63) / 64, kb = t.item / nblk, nb = t.item % nblk, k0 = 64 * kb, n = 64 * nb + 4 * (lane & 15);
    const bool ok = n < t.nc;
    const float* p = t.W + (size_t)(k0 + (lane >> 4)) * t.ldw + t.c0 + n;
#pragma unroll
    for (int i = 0; i < 16; ++i) v[i] = ok ? *(const f32x4*)(p + (size_t)(4 * i) * t.ldw) : (f32x4){0.f, 0.f, 0.f, 0.f};
}
__device__ __forceinline__ void titem_store(const TItem& t, const f32x4 (&v)[16], LAS float* scr, int lane) {
    const int nblk = (t.nc + 63) / 64, kb = t.item / nblk, nb = t.item % nblk, k0 = 64 * kb, n0 = 64 * nb;
#pragma unroll
    for (int i = 0; i < 16; ++i) { LAS float* d = scr + (4 * i + (lane >> 4)) * 65 + 4 * (lane & 15); d[0] = v[i].x; d[1] = v[i].y; d[2] = v[i].z; d[3] = v[i].w; }
    LDS_WAIT(); asm volatile("" ::: "memory");
    const int c = lane & 7;
    f32x4 s0 = (f32x4){1.f, 1.f, 1.f, 1.f}, s1 = s0;
    if (t.kscale) { s0 = *(const f32x4*)(t.kscale + k0 + 8 * c); s1 = *(const f32x4*)(t.kscale + k0 + 8 * c + 4); }
#pragma unroll
    for (int j = 0; j < 8; ++j) { const int nn = (lane >> 3) + 8 * j; const LAS float* s = scr + (8 * c) * 65 + nn;
        v4u o; o.x = pk2(s[0 * 65] * s0.x, s[1 * 65] * s0.y); o.y = pk2(s[2 * 65] * s0.z, s[3 * 65] * s0.w); o.z = pk2(s[4 * 65] * s1.x, s[5 * 65] * s1.y); o.w = pk2(s[6 * 65] * s1.z, s[7 * 65] * s1.w);
        *(GAS v4u*)(t.WT + (size_t)(t.row_off + n0 + nn) * t.K + k0 + 8 * c) = o; }
    LDS_WAIT(); asm volatile("" ::: "memory");
}
__device__ __forceinline__ void p0_prologue(Frame& F) {
    LAS float* scr = (LAS float*)(F.lds + RING_OFF + F.wave * 17408);
    const int gw = blockIdx.x * NWAVES + F.wave, NGW = F.G * NWAVES;
    constexpr int I_A = 64 * (24576 / 64), I_Z = 64, I_M = 64 * (8192 / 64), I_O = 64 * (DM / 64), I_F = 64 * (NF / 64), I_2 = (DFF / 64) * (DM / 64);
    constexpr int NITEMS = I_A + I_Z + I_M + I_O + I_F + I_2;
    auto mk = [&](int it) { TItem t; int r = it;
        if (r < I_A) { t = TItem{F.w_in, DM, NIN, 0, 24576, F.W1t, 0, F.attn_norm, r}; return t; } r -= I_A;
        if (r < I_Z) { t = TItem{F.w_in, DM, NIN, 24576, 16, F.W1t, C_Z, F.attn_norm, r}; return t; } r -= I_Z;
        if (r < I_M) { t = TItem{F.w_in, DM, NIN, 24592, 8192, F.W1t, C_MR, F.attn_norm, r}; return t; } r -= I_M;
        if (r < I_O) { t = TItem{F.w_out, DM, DM, 0, DM, F.Wot, 0, nullptr, r}; return t; } r -= I_O;
        if (r < I_F) { t = TItem{F.w_ffn_in, DM, NF, 0, NF, F.Wft, 0, F.ffn_norm, r}; return t; } r -= I_F;
        t = TItem{F.w_ffn_out, DFF, DM, 0, DM, F.W2t, 0, nullptr, r}; return t; };
    if (gw < NITEMS) {
        f32x4 cur[16], nxt[16]; TItem tc = mk(gw); titem_load(tc, cur, F.lane);
        for (int it = gw; it < NITEMS; it += NGW) {
            const bool more = it + NGW < NITEMS; TItem tn = tc;
            if (more) { tn = mk(it + NGW); titem_load(tn, nxt, F.lane); }
            titem_store(tc, cur, scr, F.lane);
            if (more) {
#pragma unroll
                for (int i = 0; i < 16; ++i) cur[i] = nxt[i];
                tc = tn; }
        }
    }
    { const size_t n16 = (size_t)(N1 - C_Z - 64) * DM * 2 / 16; GAS v4u* p = (GAS v4u*)(F.W1t + (size_t)(C_Z + 64) * DM);
      for (size_t i = (size_t)blockIdx.x * NTHR + F.tid; i < n16; i += (size_t)F.G * NTHR) p[i] = (v4u){0u, 0u, 0u, 0u}; }
    for (int m = gw; m < MT; m += NGW) {
        GAS unsigned long long* o8 = (GAS unsigned long long*)(F.XB + (size_t)m * DM) + F.lane;
        if (m < MROWS) {
            const float* xrow = m < MR ? F.x + (size_t)m * DM : F.meta + (size_t)(m - MR) * DM;
            const GAS f32x4* xr = (const GAS f32x4*)xrow + F.lane; float ss = 0.f;
#pragma unroll
            for (int j = 0; j < 16; ++j) { const f32x4 v = xr[64 * j]; ss += (v.x * v.x + v.y * v.y) + (v.z * v.z + v.w * v.w);
                o8[64 * j] = (unsigned long long)pk2(v.x, v.y) | ((unsigned long long)pk2(v.z, v.w) << 32); }
            ss = wave_sum(ss);
            if (F.lane == 0) F.RS1[m] = 1.0f / sqrtf(ss * (1.0f / DM) + EPS);
        } else {
            GAS unsigned long long* o2 = (GAS unsigned long long*)(F.MRG + (size_t)m * DM) + F.lane;
            GAS unsigned long long* o3 = (GAS unsigned long long*)(F.H1B + (size_t)m * DM) + F.lane;
#pragma unroll
            for (int j = 0; j < 16; ++j) { o8[64 * j] = 0ull; o2[64 * j] = 0ull; o3[64 * j] = 0ull; }
            if (F.lane == 0) { F.RS1[m] = 0.f; F.RS2[m] = 0.f; }
        }
    }
    for (int i = blockIdx.x * NTHR + F.tid; i < MROWS * 128; i += F.G * NTHR) {
        const int m = i >> 7, j = i & 127;
        const int pos = m < MR ? F.positions[m] + NMETA : m - MR;
        const float inv_freq = powf(10000.0f, -(float)j * (1.0f / 128.0f));
        const float ang = (float)pos * inv_freq; float s, c; sincosf(ang, &s, &c);
        F.COS[i] = c; F.SIN[i] = s;
    }
}

template <bool GLA> __device__ __forceinline__ void prep_qkp(Frame& F, int u) {
    constexpr int DK = GLA ? GLA_DK : RET_DK, NH = GLA ? GLA_H : RET_H, LDQ = DK + 8, DKW = DK / 8, NKS = DKW / 16, NDT = DKW / 32;
    const int n = u % 33, h = (u / 33) % NH, b = u / (33 * NH);
    LAS bf16* Qs = (LAS bf16*)F.lds; LAS bf16* Ks = Qs + 64 * LDQ; LAS float* zs = (LAS float*)(Ks + 64 * LDQ);
    const int tid = F.tid, lane = F.lane, w8 = F.wave, r = lane & 31, hh = lane >> 5;
    if (GLA) {
        for (int e = tid; e < 64 * 16; e += NTHR) { const int row = chunk_row(b, n, e >> 4); zs[e] = row >= 0 ? F.ZB[(size_t)row * 16 + (e & 15)] : 0.f; }
        __syncthreads();
        const int d = tid, ch = h * GLA_DK + d; float wg[GLA_RANK];
#pragma unroll
        for (int q = 0; q < GLA_RANK; ++q) wg[q] = F.w_gate_up[q * 2048 + ch];
        const float bg = F.b_gate[ch]; float bc = 0.f;
        for (int i = 0; i < 64; ++i) { const int row = chunk_row(b, n, i); float qv = 0.f, kv = 0.f;
            if (row >= 0) { float lg = bg;
#pragma unroll
                for (int q = 0; q < GLA_RANK; ++q) lg += zs[i * 16 + q] * wg[q];
                bc += logsig(lg) * (1.0f / 16.0f);
                const bf16* pr = F.PROJ + (size_t)row * N1;
                qv = bf2f(pr[C_QG + ch]) * 0.04419417382415922f * __expf(bc); kv = bf2f(pr[C_KG + ch]) * __expf(-bc); }
            Qs[i * LDQ + d] = f2b(qv); Ks[i * LDQ + d] = f2b(kv); }
        F.DECG[((size_t)(b * GLA_H + h) * 33 + n) * GLA_DK + d] = __expf(bc);
    } else {
        const int p = tid & 127, tg = tid >> 7; const float l2g = log2f(1.0f - exp2f(-5.0f - (float)h));
        for (int ii = 0; ii < 16; ++ii) { const int i = tg * 16 + ii, row = chunk_row(b, n, i); float qa = 0.f, qb = 0.f, ka = 0.f, kb = 0.f;
            if (row >= 0) { const float c = F.COS[row * 128 + p], sn = F.SIN[row * 128 + p]; const bf16* pr = F.PROJ + (size_t)row * N1;
                const float q1 = bf2f(pr[C_QR + h * 256 + p]), q2 = bf2f(pr[C_QR + h * 256 + 128 + p]), k1 = bf2f(pr[C_KR + h * 256 + p]), k2 = bf2f(pr[C_KR + h * 256 + 128 + p]);
                const float dq = exp2f((float)(i + 1) * l2g), dkk = 0.0625f / dq;
                qa = (q1 * c - q2 * sn) * dq; qb = (q2 * c + q1 * sn) * dq; ka = (k1 * c - k2 * sn) * dkk; kb = (k2 * c + k1 * sn) * dkk; }
            Qs[i * LDQ + p] = f2b(qa); Qs[i * LDQ + p + 128] = f2b(qb); Ks[i * LDQ + p] = f2b(ka); Ks[i * LDQ + p + 128] = f2b(kb); }
    }
    __syncthreads();
    const size_t cb = (size_t)(b * NH + h) * 33 + n;
    {
        char* qdst = (char*)(GLA ? F.QFG : F.QFR) + ((cb * 8 + w8) * (NKS * 2)) * 1024 + lane * 16;
#pragma unroll
        for (int ks = 0; ks < NKS; ++ks)
#pragma unroll
            for (int qt = 0; qt < 2; ++qt) { const LAS bf16* src = Qs + (32 * qt + r) * LDQ + DKW * w8 + 16 * ks + 4 * hh;
                const unsigned long long lo = *(const LAS unsigned long long*)src, hi = *(const LAS unsigned long long*)(src + 8);
                *(v4u*)(qdst + (ks * 2 + qt) * 1024) = (v4u){(unsigned)lo, (unsigned)(lo >> 32), (unsigned)hi, (unsigned)(hi >> 32)}; }
        char* kdst = (char*)(GLA ? F.KFG : F.KFR) + ((cb * 8 + w8) * (NDT * 4)) * 1024 + lane * 16;
#pragma unroll
        for (int dkt = 0; dkt < NDT; ++dkt)
#pragma unroll
            for (int ks = 0; ks < 4; ++ks) { unsigned w[4];
#pragma unroll
                for (int jj = 0; jj < 4; ++jj) { const int j0 = 2 * jj, t0 = 16 * ks + 8 * (j0 >> 2) + 4 * hh + (j0 & 3);
                    const unsigned e0 = Ks[t0 * LDQ + DKW * w8 + 32 * dkt + r], e1 = Ks[(t0 + 1) * LDQ + DKW * w8 + 32 * dkt + r]; w[jj] = e0 | (e1 << 16); }
                *(v4u*)(kdst + (dkt * 4 + ks) * 1024) = (v4u){w[0], w[1], w[2], w[3]}; }
    }
    if (w8 < 4) {
        const int kt = w8 >> 1, qt = w8 & 1; f32x16 acc;
#pragma unroll
        for (int i = 0; i < 16; ++i) acc[i] = 0.f;
        if (!(kt == 1 && qt == 0)) {
            const LAS bf16* ap = Ks + (32 * kt + r) * LDQ + 8 * hh; const LAS bf16* bp = Qs + (32 * qt + r) * LDQ + 8 * hh;
#pragma unroll 8
            for (int s = 0; s < DK / 16; ++s) acc = MFMA32(*(const LAS bf16x8*)(ap + 16 * s), *(const LAS bf16x8*)(bp + 16 * s), acc);
        }
        char* pdst = (char*)(GLA ? F.PFG : F.PFR) + (cb * 8) * 1024 + lane * 16;
#pragma unroll
        for (int s2 = 0; s2 < 2; ++s2) { unsigned w[4];
#pragma unroll
            for (int jj = 0; jj < 4; ++jj) { const int i0 = 8 * s2 + 2 * jj, i1 = i0 + 1;
                const int k0 = 32 * kt + (i0 & 3) + 8 * (i0 >> 2) + 4 * hh, k1 = 32 * kt + (i1 & 3) + 8 * (i1 >> 2) + 4 * hh, qc = 32 * qt + r;
                w[jj] = pkbf(k0 <= qc ? acc[i0] : 0.f, k1 <= qc ? acc[i1] : 0.f); }
            *(v4u*)(pdst + ((2 * kt + s2) * 2 + qt) * 1024) = (v4u){w[0], w[1], w[2], w[3]}; }
    }
    __syncthreads();
}
__device__ __forceinline__ void prep_vf(Frame& F, int u) {
    const int n = u % 33, b = (u / 33) % 4, br = u / 132; const int cv = br ? C_VG : C_VR; char* VF = (char*)(br ? F.VFG : F.VFR);
    const int lane = F.lane, r = lane & 31, hh = lane >> 5;
    for (int f = F.wave; f < 512; f += 8) { const int slg = f >> 3, wt = (f >> 2) & 1, ks = f & 3; unsigned w[4];
#pragma unroll
        for (int jj = 0; jj < 4; ++jj) { const int j0 = 2 * jj, t0 = 16 * ks + 8 * (j0 >> 2) + 4 * hh + (j0 & 3);
            const int r0 = chunk_row(b, n, t0), r1 = chunk_row(b, n, t0 + 1); const int col = cv + 64 * slg + 32 * wt + r;
            const unsigned e0 = r0 >= 0 ? (unsigned)F.PROJ[(size_t)r0 * N1 + col] : 0u, e1 = r1 >= 0 ? (unsigned)F.PROJ[(size_t)r1 * N1 + col] : 0u; w[jj] = e0 | (e1 << 16); }
        *(v4u*)(VF + ((((size_t)b * 33 + n) * 64 + slg) * 8 + wt * 4 + ks) * 1024 + lane * 16) = (v4u){w[0], w[1], w[2], w[3]}; }
}
__device__ __forceinline__ void p2_prep(Frame& F) {
    constexpr int U_R = 4 * 8 * 33, U_G = 4 * 4 * 33, U_V = 2 * 4 * 33;
    for (int u = blockIdx.x; u < U_G + U_R + U_V; u += F.G) {
        if (u < U_G) prep_qkp<true>(F, u); else if (u < U_G + U_R) prep_qkp<false>(F, u - U_G); else prep_vf(F, u - U_G - U_R);
    }
}

__device__ __forceinline__ bf16x8 pack8(const f32x16& x, int s) { v4u w;
    if (s == 0) { w.x = pkbf(x[0], x[1]); w.y = pkbf(x[2], x[3]); w.z = pkbf(x[4], x[5]); w.w = pkbf(x[6], x[7]); }
    else { w.x = pkbf(x[8], x[9]); w.y = pkbf(x[10], x[11]); w.z = pkbf(x[12], x[13]); w.w = pkbf(x[14], x[15]); }
    return __builtin_bit_cast(bf16x8, w); }
template <bool GLA> __device__ __forceinline__ void scan_unit(Frame& F, int u) {
    constexpr int DK = GLA ? GLA_DK : RET_DK, DV = GLA ? GLA_DV : RET_DV, NH = GLA ? GLA_H : RET_H, NSL = DV / 64, DKW = DK / 8, NKS = DKW / 16, NDT = DKW / 32;
    const int b = u / (NH * NSL), h = (u / NSL) % NH, sl = u % NSL, slg = h * NSL + sl;
    const int lane = F.lane, r = lane & 31, hh = lane >> 5, w8 = F.wave;
    LAS float* RED = (LAS float*)F.lds;
    f32x16 S[NDT][2];
#pragma unroll
    for (int a = 0; a < NDT; ++a)
#pragma unroll
        for (int c = 0; c < 2; ++c)
#pragma unroll
            for (int i = 0; i < 16; ++i) S[a][c][i] = 0.f;
    const char* QFb = (const char*)(GLA ? F.QFG : F.QFR); const char* KFb = (const char*)(GLA ? F.KFG : F.KFR);
    const char* VFb = (const char*)(GLA ? F.VFG : F.VFR); const char* PFb = (const char*)(GLA ? F.PFG : F.PFR);
    float* Y = GLA ? F.YG : F.YR;
    const float gam64 = exp2f(64.0f * log2f(1.0f - exp2f(-5.0f - (float)h)));
#pragma unroll 1
    for (int n = 0; n < 33; ++n) {
        const size_t cb = (size_t)(b * NH + h) * 33 + n;
        const char* qp = QFb + ((cb * 8 + w8) * (NKS * 2)) * 1024 + lane * 16;
        const char* kp = KFb + ((cb * 8 + w8) * (NDT * 4)) * 1024 + lane * 16;
        const char* vp = VFb + ((((size_t)b * 33 + n) * 64 + slg) * 8) * 1024 + lane * 16;
        const char* pp = PFb + (cb * 8) * 1024 + lane * 16;
        f32x16 o[2][2];
#pragma unroll
        for (int a = 0; a < 2; ++a)
#pragma unroll
            for (int c = 0; c < 2; ++c)
#pragma unroll
                for (int i = 0; i < 16; ++i) o[a][c][i] = 0.f;
#pragma unroll
        for (int ks = 0; ks < NKS; ++ks) { const int dkt = ks >> 1, s = ks & 1; bf16x8 a[2];
#pragma unroll
            for (int wt = 0; wt < 2; ++wt) a[wt] = pack8(S[dkt][wt], s);
#pragma unroll
            for (int qt = 0; qt < 2; ++qt) { const bf16x8 bq = *(const bf16x8*)(qp + (ks * 2 + qt) * 1024);
#pragma unroll
                for (int wt = 0; wt < 2; ++wt) o[wt][qt] = MFMA32(a[wt], bq, o[wt][qt]); } }
        { const int ks2 = w8 >> 1, qt2 = w8 & 1; const bf16x8 bp = *(const bf16x8*)(pp + (ks2 * 2 + qt2) * 1024);
#pragma unroll
          for (int wt = 0; wt < 2; ++wt) { const bf16x8 av = *(const bf16x8*)(vp + (wt * 4 + ks2) * 1024);
              if (qt2 == 0) o[wt][0] = MFMA32(av, bp, o[wt][0]); else o[wt][1] = MFMA32(av, bp, o[wt][1]); } }
#pragma unroll
        for (int wt = 0; wt < 2; ++wt)
#pragma unroll
            for (int qt = 0; qt < 2; ++qt)
#pragma unroll
                for (int i = 0; i < 16; ++i) RED[((w8 * 4 + wt * 2 + qt) * 16 + i) * 64 + lane] = o[wt][qt][i];
#pragma unroll
        for (int dkt = 0; dkt < NDT; ++dkt)
#pragma unroll
            for (int ks = 0; ks < 4; ++ks) { const bf16x8 ak = *(const bf16x8*)(kp + (dkt * 4 + ks) * 1024);
#pragma unroll
                for (int wt = 0; wt < 2; ++wt) { const bf16x8 bv = *(const bf16x8*)(vp + (wt * 4 + ks) * 1024); S[dkt][wt] = MFMA32(ak, bv, S[dkt][wt]); } }
        if (GLA) {
#pragma unroll
            for (int dkt = 0; dkt < NDT; ++dkt) { const float* dp = F.DECG + cb * GLA_DK + DKW * w8 + 32 * dkt + 4 * hh;
#pragma unroll
                for (int g4 = 0; g4 < 4; ++g4) { const f32x4 dv = *(const f32x4*)(dp + 8 * g4);
#pragma unroll
                    for (int e = 0; e < 4; ++e) { S[dkt][0][4 * g4 + e] *= dv[e]; S[dkt][1][4 * g4 + e] *= dv[e]; } } }
        } else {
#pragma unroll
            for (int wt = 0; wt < 2; ++wt)
#pragma unroll
                for (int i = 0; i < 16; ++i) S[0][wt][i] *= gam64;
        }
        __syncthreads();
        {
            const int t = w8 >> 1, i0 = 8 * (w8 & 1), wt = t >> 1, qt = t & 1; float val[8];
#pragma unroll
            for (int ii = 0; ii < 8; ++ii) { float sum = 0.f;
#pragma unroll
                for (int src = 0; src < 8; ++src) sum += RED[((src * 4 + t) * 16 + i0 + ii) * 64 + lane];
                val[ii] = sum; }
            const int row = chunk_row(b, n, 32 * qt + r);
            if (row >= 0 && (n > 0 || b == 0)) {
#pragma unroll
                for (int g = 0; g < 2; ++g) { const int w0 = 32 * wt + 8 * (2 * (w8 & 1) + g) + 4 * hh;
                    *(f32x4*)(Y + (size_t)row * DM + h * DV + 64 * sl + w0) = (f32x4){val[4 * g], val[4 * g + 1], val[4 * g + 2], val[4 * g + 3]}; } }
        }
        __syncthreads();
    }
}
__device__ __forceinline__ void p3_scan(Frame& F) {
    for (int unit = blockIdx.x; unit < 512; unit += F.G) {
        if (unit < 256) scan_unit<true>(F, unit); else scan_unit<false>(F, unit - 256);
    }
}

__device__ __forceinline__ void p4_merge(Frame& F) {
    const int gw = blockIdx.x * NWAVES + F.wave, NGW = F.G * NWAVES, lane = F.lane;
    for (int m = gw; m < MROWS; m += NGW) {
        const bf16* pr = F.PROJ + (size_t)m * N1;
#pragma unroll 1
        for (int hg = 0; hg < 4; ++hg) {
            f32x4 yr[4], yg[4];
#pragma unroll
            for (int j = 0; j < 4; ++j) { const int c = hg * 1024 + j * 256 + lane * 4; yr[j] = *(const f32x4*)(F.YR + (size_t)m * DM + c); yg[j] = *(const f32x4*)(F.YG + (size_t)m * DM + c); }
            float sg = 0.f, sa = 0.f, sb = 0.f;
#pragma unroll
            for (int j = 0; j < 4; ++j) { sg += (yg[j].x * yg[j].x + yg[j].y * yg[j].y) + (yg[j].z * yg[j].z + yg[j].w * yg[j].w);
                const float t = (yr[j].x + yr[j].y) + (yr[j].z + yr[j].w); if (j < 2) sa += t; else sb += t; }
            sg = wave_sum(sg); sa = wave_sum(sa); sb = wave_sum(sb);
            const float rg = 1.0f / sqrtf(sg * (1.0f / 1024.0f) + EPS), ma = sa * (1.0f / 512.0f), mb = sb * (1.0f / 512.0f);
            float qa = 0.f, qb = 0.f;
#pragma unroll
            for (int j = 0; j < 4; ++j) { const float mu = j < 2 ? ma : mb; yr[j] = yr[j] - mu;
                const float t = (yr[j].x * yr[j].x + yr[j].y * yr[j].y) + (yr[j].z * yr[j].z + yr[j].w * yr[j].w); if (j < 2) qa += t; else qb += t; }
            qa = wave_sum(qa); qb = wave_sum(qb);
            const float ra = 1.0f / sqrtf(qa * (1.0f / 512.0f) + EPS), rb = 1.0f / sqrtf(qb * (1.0f / 512.0f) + EPS);
#pragma unroll
            for (int j = 0; j < 4; ++j) { const int c = hg * 1024 + j * 256 + lane * 4; const float rr = j < 2 ? ra : rb;
                const f32x4 gr = *(const f32x4*)(F.ret_norm + c), gg = *(const f32x4*)(F.gla_norm + c);
                const unsigned long long wor = *(const unsigned long long*)(pr + C_OR + c), wmr = *(const unsigned long long*)(pr + C_MR + c);
                const unsigned long long wog = *(const unsigned long long*)(pr + C_OG + c), wmg = *(const unsigned long long*)(pr + C_MG + c);
                float res[4];
#pragma unroll
                for (int e = 0; e < 4; ++e) {
                    const float o_r = bf2f((bf16)(wor >> (16 * e))), m_r = bf2f((bf16)(wmr >> (16 * e))), o_g = bf2f((bf16)(wog >> (16 * e))), m_g = bf2f((bf16)(wmg >> (16 * e)));
                    const float yrn = yr[j][e] * rr * gr[e], ygn = yg[j][e] * rg * gg[e];
                    res[e] = sigm(m_r) * (yrn * silu(o_r)) + sigm(m_g) * (ygn * silu(o_g)); }
                *(unsigned long long*)(F.MRG + (size_t)m * DM + c) = (unsigned long long)pk2(res[0], res[1]) | ((unsigned long long)pk2(res[2], res[3]) << 32); }
        }
    }
}

__device__ __forceinline__ void p6_rows(Frame& F) {
    const int gw = blockIdx.x * NWAVES + F.wave, NGW = F.G * NWAVES;
    for (int m = gw; m < MROWS; m += NGW) {
        const GAS f32x4* xr = (const GAS f32x4*)(F.H1 + (size_t)m * DM) + F.lane; float ss = 0.f;
        GAS unsigned long long* o8 = (GAS unsigned long long*)(F.H1B + (size_t)m * DM) + F.lane;
#pragma unroll
        for (int j = 0; j < 16; ++j) { const f32x4 v = xr[64 * j]; ss += (v.x * v.x + v.y * v.y) + (v.z * v.z + v.w * v.w);
            o8[64 * j] = (unsigned long long)pk2(v.x, v.y) | ((unsigned long long)pk2(v.z, v.w) << 32); }
        ss = wave_sum(ss);
        if (F.lane == 0) F.RS2[m] = 1.0f / sqrtf(ss * (1.0f / DM) + EPS);
    }
}

__device__ __forceinline__ void p8_act(Frame& F) {
    constexpr int FB = DFF / 8;
    for (size_t i = (size_t)blockIdx.x * NTHR + F.tid; i < (size_t)MR * FB; i += (size_t)F.G * NTHR) {
        const int m = (int)(i / FB), f = (int)(i % FB) * 8, t = m & (SEQ - 1);
        const int r1 = t >= 1 ? m - 1 : MR + 15, r2 = t >= 2 ? m - 2 : MR + 14 + t;
        const v4u u0 = *(const v4u*)(F.UG + (size_t)m * NF + f), u1 = *(const v4u*)(F.UG + (size_t)r1 * NF + f), u2 = *(const v4u*)(F.UG + (size_t)r2 * NF + f), gt = *(const v4u*)(F.UG + (size_t)m * NF + DFF + f);
        float res[8];
#pragma unroll
        for (int e = 0; e < 8; ++e) { const unsigned sh = 16 * (e & 1);
            const float a0 = bf2f((bf16)(u0[e >> 1] >> sh)), a1 = bf2f((bf16)(u1[e >> 1] >> sh)), a2 = bf2f((bf16)(u2[e >> 1] >> sh)), gv = bf2f((bf16)(gt[e >> 1] >> sh));
            const float c = F.conv_b[f + e] + F.conv_w[f + e] * a2 + F.conv_w[DFF + f + e] * a1 + F.conv_w[2 * DFF + f + e] * a0;
            res[e] = silu(c) * gv; }
        v4u o; o.x = pk2(res[0], res[1]); o.y = pk2(res[2], res[3]); o.z = pk2(res[4], res[5]); o.w = pk2(res[6], res[7]);
        *(v4u*)(F.ACT + (size_t)m * DFF + f) = o;
    }
}

__device__ __forceinline__ void p10_final(Frame& F) {
    const int gw = blockIdx.x * NWAVES + F.wave, NGW = F.G * NWAVES;
    for (int m = gw; m < MR; m += NGW) {
        GAS f32x4* xr = (GAS f32x4*)(F.out + (size_t)m * DM) + F.lane; f32x4 v[16]; float ss = 0.f;
#pragma unroll
        for (int j = 0; j < 16; ++j) { v[j] = xr[64 * j]; ss += (v[j].x * v[j].x + v[j].y * v[j].y) + (v[j].z * v[j].z + v[j].w * v[j].w); }
        ss = wave_sum(ss); const float r = 1.0f / sqrtf(ss * (1.0f / DM) + EPS);
#pragma unroll
        for (int j = 0; j < 16; ++j) { const f32x4 g = *((const GAS f32x4*)F.final_norm + F.lane + 64 * j); xr[64 * j] = v[j] * r * g; }
    }
}

#ifndef REP_MASK
#define REP_MASK 0u
#endif
#define REPS(k) (((REP_MASK >> (k)) & 1u) ? 2 : 1)
struct Args { const void* in[16]; float* out; unsigned char* ws; int ph_lo, ph_hi, li, pad; };
__global__ void __launch_bounds__(NTHR, 2) fwd(Args args) {
    extern __shared__ __attribute__((aligned(16))) unsigned char lds[];
    Frame F;
    F.lds = (LAS unsigned char*)lds;
    F.MISC = (volatile LAS unsigned*)(F.lds + MISC_OFF);
    F.tid = threadIdx.x; F.lane = F.tid & 63; F.wave = __builtin_amdgcn_readfirstlane(F.tid >> 6); F.G = gridDim.x;
    unsigned char* ws = args.ws;
    F.ctl = (gu32*)(ws + WS_CTL);
    F.x = (const float*)args.in[0]; F.positions = (const int*)args.in[1]; F.meta = (const float*)args.in[2]; F.attn_norm = (const float*)args.in[3]; F.w_in = (const float*)args.in[4];
    F.w_gate_up = (const float*)args.in[5]; F.b_gate = (const float*)args.in[6]; F.ret_norm = (const float*)args.in[7]; F.gla_norm = (const float*)args.in[8]; F.w_out = (const float*)args.in[9];
    F.ffn_norm = (const float*)args.in[10]; F.w_ffn_in = (const float*)args.in[11]; F.conv_w = (const float*)args.in[12]; F.conv_b = (const float*)args.in[13]; F.w_ffn_out = (const float*)args.in[14];
    F.final_norm = (const float*)args.in[15]; F.out = args.out;
    F.W1t = (bf16*)(ws + WS_W1T); F.Wot = (bf16*)(ws + WS_WOT); F.Wft = (bf16*)(ws + WS_WFT); F.W2t = (bf16*)(ws + WS_W2T); F.XB = (bf16*)(ws + WS_XB);
    F.PROJ = (bf16*)(ws + WS_PROJ); F.UG = (bf16*)(ws + WS_UG); F.ACT = (bf16*)(ws + WS_ACT); F.MRG = (bf16*)(ws + WS_MRG); F.H1B = (bf16*)(ws + WS_H1B);
    F.RS1 = (float*)(ws + WS_RS1); F.RS2 = (float*)(ws + WS_RS2); F.ZB = (float*)(ws + WS_ZB); F.COS = (float*)(ws + WS_COS); F.SIN = (float*)(ws + WS_SIN);
    F.YR = (float*)(ws + WS_YR); F.YG = (float*)(ws + WS_YG); F.H1 = (float*)(ws + WS_H1); F.DECG = (float*)(ws + WS_DECG);
    F.QFG = (bf16*)(ws + WS_QFG); F.KFG = (bf16*)(ws + WS_KFG); F.QFR = (bf16*)(ws + WS_QFR); F.KFR = (bf16*)(ws + WS_KFR);
    F.VFG = (bf16*)(ws + WS_VFG); F.VFR = (bf16*)(ws + WS_VFR); F.PFG = (bf16*)(ws + WS_PFG); F.PFR = (bf16*)(ws + WS_PFR);
    for (int u = F.tid; u < (LDS_BYTES - LDSCTL_OFF) / 4; u += NTHR) ((LAS unsigned*)(F.lds + LDSCTL_OFF))[u] = 0u;
    __syncthreads();
    XcdBarrier bar; bar.bar = (unsigned*)(F.ctl + CW_BAR); bar.x = 0; bar.st = nullptr;
    if (N_LAUNCHES != NPH) bar = xcd_barrier_post((unsigned*)(F.ctl + CW_BAR) + args.li * XCD_BAR_WORDS, F.MISC + 8);
#define GRID_BAR(seam) do { if (N_LAUNCHES == NPH) { if (F.tid == 0) __hip_atomic_store(F.ctl + CW_TMO, 0xBADBA0u | (unsigned)(seam), RLX_AGENT); } else { xcd_barrier(bar); } } while (0)
    const int lo = args.ph_lo, hi = args.ph_hi;
#define IN(k) (lo <= (k) && (k) < hi)
#define BOTH(k) (IN(k) && IN((k) + 1))
#define PH1() do { pg8::Gemm g{F.XB, F.W1t, MT, N1, DM}; pg8::StaticOrder S; S.init(MT, N1, F.G, (int)blockIdx.x); pg8::EpiG1 E{F.PROJ, N1, F.RS1, F.ZB}; \
        pg8::gemm_phase<pg8::EpiG1, pg8::StaticOrder, PG8_ALIGN, PG8_SP2>(F.lds + RING_OFF, g, S, E); } while (0)
#define PH5() do { pg8::Gemm g{F.MRG, F.Wot, MT, DM, DM}; pg8::StaticOrder S; S.init(MT, DM, F.G, (int)blockIdx.x); pg8::EpiResX E{F.x, F.meta, F.H1, DM, MR, NMETA}; \
        pg8::gemm_phase<pg8::EpiResX, pg8::StaticOrder, PG8_ALIGN, PG8_SP2>(F.lds + RING_OFF, g, S, E); } while (0)
#define PH7() do { pg8::Gemm g{F.H1B, F.Wft, MT, NF, DM}; pg8::StaticOrder S; S.init(MT, NF, F.G, (int)blockIdx.x); pg8::EpiScaleBf16 E{F.UG, NF, F.RS2}; \
        pg8::gemm_phase<pg8::EpiScaleBf16, pg8::StaticOrder, PG8_ALIGN, PG8_SP2>(F.lds + RING_OFF, g, S, E); } while (0)
#define PH9() do { pg8::Gemm g{F.ACT, F.W2t, MR, DM, DFF}; pg8::StaticOrder S; S.init(MR, DM, F.G, (int)blockIdx.x); pg8::EpiResF32 E{F.H1, F.out, DM}; \
        pg8::gemm_phase<pg8::EpiResF32, pg8::StaticOrder, PG8_ALIGN, PG8_SP2>(F.lds + RING_OFF, g, S, E); } while (0)
#define RUN(k, body) do { if (IN(k)) { body; if (REPS(k) == 2) { __syncthreads(); body; } if (BOTH(k)) GRID_BAR(k); } } while (0)
    RUN(0, p0_prologue(F));
    RUN(1, PH1());
    RUN(2, p2_prep(F));
    RUN(3, p3_scan(F));
    RUN(4, p4_merge(F));
    RUN(5, PH5());
    RUN(6, p6_rows(F));
    RUN(7, PH7());
    RUN(8, p8_act(F));
    RUN(9, PH9());
    if (IN(10)) { p10_final(F); }
#undef IN
#undef BOTH
}

extern "C" void kernel_launch(void* const* d_in, const int* in_sizes, int n_in, void* d_out, int out_size, void* d_ws, size_t ws_size, hipStream_t stream) {
    static int grid = 0;
    if (grid == 0) {
        if (n_in != 16 || in_sizes[0] != MR * DM || out_size != MR * DM || ws_size < WS_END) {
            fprintf(stderr, "kernel_launch: shape/workspace mismatch: n_in %d in0 %d out %d ws %zu (need %zu); nothing launched\n", n_in, n_in > 0 ? in_sizes[0] : -1, out_size, ws_size, (size_t)WS_END); grid = -1; return; }
        int dev = 0, cus = 0, per_cu = 0;
        if (hipGetDevice(&dev) != hipSuccess || hipDeviceGetAttribute(&cus, hipDeviceAttributeMultiprocessorCount, dev) != hipSuccess) { fprintf(stderr, "kernel_launch: device query failed\n"); grid = -1; return; }
        if (hipFuncSetAttribute((const void*)fwd, hipFuncAttributeMaxDynamicSharedMemorySize, LDS_BYTES) != hipSuccess) { fprintf(stderr, "kernel_launch: hipFuncSetAttribute failed\n"); grid = -1; return; }
        if (hipOccupancyMaxActiveBlocksPerMultiprocessor(&per_cu, (const void*)fwd, NTHR, LDS_BYTES) != hipSuccess || per_cu < 1)
            fprintf(stderr, "kernel_launch: note: occupancy query reports %d workgroups per CU\n", per_cu);
        (void)hipGetLastError();
        grid = cus;
    }
    if (grid < 0) return;
    if (hipMemsetAsync((char*)d_ws + WS_CTL, 0, CTL_ZERO_BYTES, stream) != hipSuccess) { fprintf(stderr, "kernel_launch: memset failed\n"); return; }
    Args a{};
    for (int i = 0; i < 16; ++i) a.in[i] = d_in[i];
    a.out = (float*)d_out; a.ws = (unsigned char*)d_ws;
    for (int li = 0; li < N_LAUNCHES; ++li) {
        a.ph_lo = (N_LAUNCHES == NPH) ? li : 0; a.ph_hi = (N_LAUNCHES == NPH) ? li + 1 : NPH; a.li = (N_LAUNCHES == NPH) ? 0 : li;
        hipLaunchKernelGGL(fwd, dim3(grid), dim3(NTHR), LDS_BYTES, stream, a);
        const hipError_t le = hipPeekAtLastError();
        if (le != hipSuccess) { fprintf(stderr, "kernel_launch: launch %d failed: %s\n", li, hipGetErrorName(le)); break; }
    }
}
```

```cpp
#include <hip/hip_runtime.h>
#include <cstdio>
#include <cstdint>
namespace pg8 {
#define PG8_LAS __attribute__((address_space(3)))
typedef unsigned short bf16_t;
typedef short bf16x8 __attribute__((ext_vector_type(8)));
typedef float f32x4 __attribute__((ext_vector_type(4)));
typedef unsigned u32x4 __attribute__((ext_vector_type(4)));
constexpr int BM = 256, BK = 64, HALF = 128, HTB = HALF * BK * 2  , STAGE_BYTES = 8 * HTB, NXCD = 8, WGM = 8;

__host__ __device__ __forceinline__ int lds_byte(int r, int c) { const int st = (r >> 4) * 2 + (c >> 5), rr = r & 15, cc = c & 31, ob = rr * 64 + cc * 2; return st * 1024 + (ob ^ (((ob >> 9) & 1) << 5)); }
__host__ __device__ __forceinline__ void stage_rc(int b, int& R, int& C) { const int st = b / 1024, sb = b % 1024, swz = sb ^ (((sb >> 9) & 1) << 5); R = (st >> 1) * 16 + swz / 64; C = (st & 1) * 32 + (swz % 64) / 2; }
__host__ __device__ __forceinline__ int perm32(int rho) { const int n = rho >> 4, i = rho & 15; return 8 * (i >> 2) + 4 * n + (i & 3); }

struct Unit { int pm, pn; };
struct Gemm { const bf16_t* A; const bf16_t* Bt; int M, N, K; };

struct StaticOrder {
    int nM, nN, nwg, G, c;
    __host__ __device__ void init(int M, int N, int G_, int c_) { nM = M / BM; nN = N / BM; nwg = nM * nN; G = G_; c = c_; }
    __host__ __device__ bool next(int i, Unit& u) const {
        const long L = (long)i * G + c; if (L >= nwg) return false;
        int wgid = (int)L; { const int q = nwg / NXCD, r = nwg % NXCD, xcd = wgid % NXCD, off = wgid / NXCD; wgid = (xcd < r ? xcd * (q + 1) : r * (q + 1) + (xcd - r) * q) + off; }
        const int nig = WGM * nN, gid = wgid / nig, fm = gid * WGM, gsz = (nM - fm) < WGM ? (nM - fm) : WGM;
        u.pm = fm + ((wgid % nig) % gsz); u.pn = (wgid % nig) / gsz; return true;
    }
    __device__ __forceinline__ void a_ready(const Unit&) const {}
    __device__ __forceinline__ void done(const Unit&) const {}
};
__device__ __forceinline__ unsigned cvt_pk_bf16(float lo, float hi) { unsigned r; asm volatile("v_cvt_pk_bf16_f32 %0, %1, %2" : "=v"(r) : "v"(lo), "v"(hi)); return r; }
template <class Epi, class Sched, bool ALIGN_EPI = false, bool SP2 = false, bool TR = true  >
__device__ __forceinline__ void gemm_phase(PG8_LAS unsigned char* lds, const Gemm g, const Sched& S, const Epi& E) {
    const int tid = threadIdx.x, wid = __builtin_amdgcn_readfirstlane(tid >> 6), lane = tid & 63, wr = wid >> 2, wc = wid & 3, fr = lane & 15, fq = lane >> 4;
    const int K = g.K, nt = K / BK;
    unsigned voffA[2], voffB[2];
#pragma unroll
    for (int i = 0; i < 2; ++i) { int R, C; stage_rc(tid * 16 + i * 8192, R, C); const int Rb = Epi::PERM ? ((R & ~31) + perm32(R & 31)) : R;
        voffA[i] = (unsigned)(R * K + C) * 2u; voffB[i] = (unsigned)(Rb * K + C) * 2u; }
    const size_t kstep = (size_t)(BK * 2);
    const size_t hstep = (size_t)HALF * K * 2;
    const size_t tstep = 2 * hstep;
    const unsigned ldsw = (unsigned)wid * 1024u;
    const int aoff = lds_byte(wr * 64 + fr, fq * 8), boff = lds_byte(wc * 32 + fr, fq * 8);
#define PG8_SA(b, h) (((b) * 2 + (h)) * HTB)
#define PG8_SB(b, h) ((4 + (b) * 2 + (h)) * HTB)
#define PG8_STAGE(bufoff, gbase, voff) do { _Pragma("unroll") for (int _i = 0; _i < 2; ++_i) \
        __builtin_amdgcn_global_load_lds((const unsigned*)((const char*)(gbase) + (voff)[_i]), (PG8_LAS unsigned*)(lds + (bufoff) + ldsw + _i * 8192), 16, 0, 0); } while (0)
#define PG8_LDA(dst, b, h) do { _Pragma("unroll") for (int m = 0; m < 4; ++m) _Pragma("unroll") for (int k = 0; k < 2; ++k) dst[m][k] = *(const PG8_LAS bf16x8*)(lds + PG8_SA(b, h) + aoff + m * 2048 + k * 1024); } while (0)
#define PG8_LDB(dst, b, h) do { _Pragma("unroll") for (int n = 0; n < 2; ++n) _Pragma("unroll") for (int k = 0; k < 2; ++k) dst[n][k] = *(const PG8_LAS bf16x8*)(lds + PG8_SB(b, h) + boff + n * 2048 + k * 1024); } while (0)
#define PG8_MMA(ai, bj, At, Bt) do { __builtin_amdgcn_s_setprio(1); _Pragma("unroll") for (int m = 0; m < 4; ++m) _Pragma("unroll") for (int n = 0; n < 2; ++n) _Pragma("unroll") for (int k = 0; k < 2; ++k) \
        acc[ai][bj][m][n] = TR ? __builtin_amdgcn_mfma_f32_16x16x32_bf16(Bt[n][k], At[m][k], acc[ai][bj][m][n], 0, 0, 0) : __builtin_amdgcn_mfma_f32_16x16x32_bf16(At[m][k], Bt[n][k], acc[ai][bj][m][n], 0, 0, 0); __builtin_amdgcn_s_setprio(0); } while (0)
#define PG8_WAIT_V(n) asm volatile("s_waitcnt vmcnt(" #n ")" ::: "memory")
#define PG8_WAIT_L(n) asm volatile("s_waitcnt lgkmcnt(" #n ")" ::: "memory")
#define PG8_BAR __builtin_amdgcn_s_barrier()
#define PG8_SCHED __builtin_amdgcn_sched_barrier(0)
    Unit cur, nxt; int ui = 0;
    if (!S.next(0, cur)) return;
    f32x4 acc[2][2][4][2];
#pragma unroll
    for (int a = 0; a < 2; ++a)
#pragma unroll
        for (int b = 0; b < 2; ++b)
#pragma unroll
            for (int m = 0; m < 4; ++m)
#pragma unroll
                for (int n = 0; n < 2; ++n) acc[a][b][m][n] = (f32x4){0.f, 0.f, 0.f, 0.f};
    bf16x8 At[4][2], B0[2][2], B1[2][2];
    const char* cA = (const char*)g.A + (size_t)cur.pm * tstep; const char* cB = (const char*)g.Bt + (size_t)cur.pn * tstep;
    S.a_ready(cur);
    if constexpr (SP2) {
        PG8_STAGE(PG8_SB(0, 0), cB, voffB); PG8_STAGE(PG8_SB(0, 1), cB + hstep, voffB); PG8_STAGE(PG8_SA(0, 0), cA, voffA); PG8_STAGE(PG8_SA(0, 1), cA + hstep, voffA);
        if (wr == 1) PG8_BAR;
        PG8_WAIT_V(2); PG8_BAR;
        PG8_STAGE(PG8_SB(1, 0), cB + kstep, voffB); PG8_STAGE(PG8_SA(1, 0), cA + kstep, voffA); PG8_STAGE(PG8_SB(1, 1), cB + hstep + kstep, voffB);
        PG8_WAIT_V(6); PG8_BAR;
    } else {
        PG8_STAGE(PG8_SB(0, 0), cB, voffB); PG8_STAGE(PG8_SA(0, 0), cA, voffA); PG8_STAGE(PG8_SB(0, 1), cB + hstep, voffB); PG8_STAGE(PG8_SA(0, 1), cA + hstep, voffA);
        if (wr == 1) PG8_BAR;
        PG8_WAIT_V(4); PG8_BAR;
        PG8_STAGE(PG8_SB(1, 0), cB + kstep, voffB); PG8_STAGE(PG8_SA(1, 0), cA + kstep, voffA); PG8_STAGE(PG8_SB(1, 1), cB + hstep + kstep, voffB);
        PG8_WAIT_V(6); PG8_BAR;
    }
    for (;;) {
        const bool has_next = S.next(ui + 1, nxt);
        const char* nA = has_next ? (const char*)g.A + (size_t)nxt.pm * tstep : cA; const char* nB = has_next ? (const char*)g.Bt + (size_t)nxt.pn * tstep : cB;
        for (int t = 0; t < nt; t += 2) {
            const bool last = (t == nt - 2);
            const char* a1 = cA + (size_t)(t + 1) * kstep;
            const char* a2 = last ? nA : cA + (size_t)(t + 2) * kstep; const char* b2 = last ? nB : cB + (size_t)(t + 2) * kstep;
            const char* a3 = a2 + kstep; const char* b3 = b2 + kstep;
            if (last && has_next) S.a_ready(nxt);
            if constexpr (SP2) {
            PG8_LDB(B0, 0, 0); PG8_LDB(B1, 0, 1); PG8_SCHED; PG8_LDA(At, 0, 0); PG8_STAGE(PG8_SA(1, 1), a1 + hstep, voffA);
            PG8_WAIT_V(8); PG8_WAIT_L(0); PG8_BAR; PG8_MMA(0, 0, At, B0); PG8_MMA(0, 1, At, B1); PG8_BAR; PG8_SCHED;
            PG8_LDA(At, 0, 1); PG8_STAGE(PG8_SB(0, 0), b2, voffB); PG8_STAGE(PG8_SB(0, 1), b2 + hstep, voffB); PG8_STAGE(PG8_SA(0, 0), a2, voffA);
            PG8_WAIT_V(8); PG8_WAIT_L(0); PG8_BAR; PG8_MMA(1, 0, At, B0); PG8_MMA(1, 1, At, B1); PG8_BAR; PG8_SCHED;
            PG8_LDB(B0, 1, 0); PG8_LDB(B1, 1, 1); PG8_SCHED; PG8_LDA(At, 1, 0); PG8_STAGE(PG8_SA(0, 1), a2 + hstep, voffA);
            PG8_WAIT_V(8); PG8_WAIT_L(0); PG8_BAR; PG8_MMA(0, 0, At, B0); PG8_MMA(0, 1, At, B1); PG8_BAR; PG8_SCHED;
            PG8_LDA(At, 1, 1); PG8_STAGE(PG8_SB(1, 0), b3, voffB); PG8_STAGE(PG8_SB(1, 1), b3 + hstep, voffB); PG8_STAGE(PG8_SA(1, 0), a3, voffA);
            PG8_WAIT_V(8); PG8_WAIT_L(0); PG8_BAR; PG8_MMA(1, 0, At, B0); PG8_MMA(1, 1, At, B1); PG8_BAR; PG8_SCHED;
            } else {
            PG8_LDB(B0, 0, 0); PG8_SCHED; PG8_LDA(At, 0, 0); PG8_STAGE(PG8_SA(1, 1), a1 + hstep, voffA);
            PG8_WAIT_L(8); PG8_BAR; PG8_WAIT_L(0); PG8_MMA(0, 0, At, B0); PG8_BAR; PG8_SCHED;
            PG8_LDB(B1, 0, 1); PG8_STAGE(PG8_SB(0, 0), b2, voffB);
            PG8_BAR; PG8_WAIT_L(0); PG8_MMA(0, 1, At, B1); PG8_BAR;
            PG8_LDA(At, 0, 1); PG8_STAGE(PG8_SA(0, 0), a2, voffA);
            PG8_BAR; PG8_WAIT_L(0); PG8_MMA(1, 0, At, B0); PG8_BAR; PG8_SCHED;
            PG8_STAGE(PG8_SB(0, 1), b2 + hstep, voffB);
            PG8_WAIT_V(6); PG8_BAR; PG8_MMA(1, 1, At, B1); PG8_BAR;
            PG8_LDB(B0, 1, 0); PG8_SCHED; PG8_LDA(At, 1, 0); PG8_STAGE(PG8_SA(0, 1), a2 + hstep, voffA);
            PG8_WAIT_L(8); PG8_BAR; PG8_WAIT_L(0); PG8_MMA(0, 0, At, B0); PG8_BAR; PG8_SCHED;
            PG8_LDB(B1, 1, 1); PG8_STAGE(PG8_SB(1, 0), b3, voffB);
            PG8_BAR; PG8_WAIT_L(0); PG8_MMA(0, 1, At, B1); PG8_BAR;
            PG8_LDA(At, 1, 1); PG8_STAGE(PG8_SA(1, 0), a3, voffA);
            PG8_BAR; PG8_WAIT_L(0); PG8_MMA(1, 0, At, B0); PG8_BAR; PG8_SCHED;
            PG8_STAGE(PG8_SB(1, 1), b3 + hstep, voffB);
            PG8_WAIT_V(6); PG8_BAR; PG8_MMA(1, 1, At, B1); PG8_BAR;
            }
        }
        if constexpr (ALIGN_EPI) { if (wr == 0) PG8_BAR; }
        if constexpr (!Epi::AFTER_DRAIN) { E(acc, cur, wr, wc, fr, fq); S.done(cur); }
        if (!has_next) break;
#pragma unroll
        for (int a = 0; a < 2; ++a)
#pragma unroll
            for (int b = 0; b < 2; ++b)
#pragma unroll
                for (int m = 0; m < 4; ++m)
#pragma unroll
                    for (int n = 0; n < 2; ++n) acc[a][b][m][n] = (f32x4){0.f, 0.f, 0.f, 0.f};
        cur = nxt; cA = nA; cB = nB; ++ui;
        if constexpr (ALIGN_EPI) { if (wr == 1) PG8_BAR; }
    }
    PG8_WAIT_V(0);
    if constexpr (!ALIGN_EPI) { if (wr == 0) PG8_BAR; }
    PG8_BAR;
    if constexpr (Epi::AFTER_DRAIN) { E.fused(acc, cur, wr, wc, fr, fq, lds, wid, lane); S.done(cur); }
#undef PG8_SA
#undef PG8_SB
#undef PG8_STAGE
#undef PG8_LDA
#undef PG8_LDB
#undef PG8_MMA
#undef PG8_WAIT_V
#undef PG8_WAIT_L
#undef PG8_BAR
#undef PG8_SCHED
}
}
#define GAS __attribute__((address_space(1)))
#define LAS __attribute__((address_space(3)))
typedef unsigned short bf16;
typedef unsigned v4u __attribute__((ext_vector_type(4)));
typedef float f32x4 __attribute__((ext_vector_type(4)));
typedef short bf16x8 __attribute__((ext_vector_type(8)));
typedef GAS unsigned gu32;
typedef GAS unsigned long long gu64;
#define RLX_AGENT __ATOMIC_RELAXED, __HIP_MEMORY_SCOPE_AGENT
#define LDS_WAIT() asm volatile("s_waitcnt lgkmcnt(0)" ::: "memory")
#define VM_WAIT() asm volatile("s_waitcnt vmcnt(0)" ::: "memory")
__device__ __forceinline__ unsigned long long rt() { return __builtin_amdgcn_s_memrealtime(); }
__device__ __forceinline__ unsigned f2bf(float f) { unsigned u = __builtin_bit_cast(unsigned, f); return (u + 0x7fffu + ((u >> 16) & 1u)) >> 16; }
__device__ __forceinline__ unsigned pk2(float lo, float hi) { return f2bf(lo) | (f2bf(hi) << 16); }
#define XB_TMO      128
#define XB_XCNT(j)  (256  + 64 * (j))
#define XB_XSUB(j)  (1280 + 64 * (j))
#define XB_XGEN(j)  (2304 + 64 * (j))
#define XB_TOP      3328
#define XB_TOPGEN   3392
#define XCD_BAR_WORDS 3456
#define XB_SPIN_CAP (1u << 18)

__device__ __forceinline__ unsigned xb_ld(unsigned* p)              { return __hip_atomic_load(p, __ATOMIC_RELAXED, __HIP_MEMORY_SCOPE_AGENT); }
__device__ __forceinline__ unsigned xb_add(unsigned* p, unsigned v) { return __hip_atomic_fetch_add(p, v, __ATOMIC_RELAXED, __HIP_MEMORY_SCOPE_AGENT); }
__device__ __forceinline__ unsigned xb_xcc_id() { return (unsigned)__builtin_amdgcn_s_getreg((3 << 11) | 20) & 0xFu; }
#define XB_SPIN(cond, bar) do { unsigned _sp = 0; while (cond) { __builtin_amdgcn_s_sleep(1); \
    if ((++_sp & 255u) == 0u) { if (xb_ld(&(bar)[XB_TMO])) break; if (_sp > XB_SPIN_CAP) { atomicAdd(&(bar)[XB_TMO], 1u); break; } } } } while (0)

struct XcdBarrier {
    unsigned* bar; unsigned x;
    volatile LAS unsigned* st;
};

__device__ __forceinline__ XcdBarrier xcd_barrier_post(unsigned* bar, volatile LAS unsigned* st) {
    XcdBarrier b; b.bar = bar; b.x = xb_xcc_id(); b.st = st;
    if (threadIdx.x == 0) (void)xb_add(&bar[XB_XCNT(b.x)], 1u);
    return b;
}
__device__ __forceinline__ void xcd_barrier_complete(unsigned* bar, unsigned x, unsigned& nloc, unsigned& nx) {
    const unsigned G = gridDim.x * gridDim.y * gridDim.z;
    unsigned sum, cnt, mine, sp = 0u;
    for (;;) {
        sum = 0u; cnt = 0u; mine = 0u;
#pragma unroll
        for (unsigned j = 0; j < 16; ++j) { const unsigned c = xb_ld(&bar[XB_XCNT(j)]); sum += c; cnt += (c > 0u) ? 1u : 0u; mine = (j == x) ? c : mine; }
        if (sum == G) break;
        __builtin_amdgcn_s_sleep(1);
        if ((++sp & 255u) == 0u) { if (xb_ld(&bar[XB_TMO])) break; if (sp > XB_SPIN_CAP) { atomicAdd(&bar[XB_TMO], 1u); break; } }
    }
    nloc = mine > 0u ? mine : 1u; nx = cnt > 0u ? cnt : 1u;
}

__device__ __forceinline__ void xcd_barrier(const XcdBarrier& b) {
    asm volatile("s_waitcnt vmcnt(0)" ::: "memory");
    __syncthreads();
    if (threadIdx.x == 0) {
        unsigned* bar = b.bar;
        __builtin_amdgcn_s_waitcnt(0);
        unsigned nloc = b.st[0], nx = b.st[1];
        if (nloc == 0u) { xcd_barrier_complete(bar, b.x, nloc, nx); b.st[0] = nloc; b.st[1] = nx; }
        const unsigned old = xb_add(&bar[XB_XSUB(b.x)], 1u);
        const unsigned gen = old / nloc;
        if (old + 1u == (gen + 1u) * nloc) {
            __builtin_amdgcn_fence(__ATOMIC_RELEASE, "agent");
            asm volatile("s_waitcnt vmcnt(0)" ::: "memory");
            const unsigned og = xb_add(&bar[XB_TOP], 1u);
            const unsigned tg = og / nx;
            if (og + 1u == (tg + 1u) * nx) xb_add(&bar[XB_TOPGEN], 1u);
            else XB_SPIN(xb_ld(&bar[XB_TOPGEN]) == tg, bar);
            __builtin_amdgcn_fence(__ATOMIC_ACQUIRE, "agent");
            xb_add(&bar[XB_XGEN(b.x)], 1u);
            asm volatile("s_waitcnt vmcnt(0)" ::: "memory");
        } else {
            XB_SPIN(xb_ld(&bar[XB_XGEN(b.x)]) == gen, bar);
            __builtin_amdgcn_fence(__ATOMIC_ACQUIRE, "agent");
            asm volatile("s_waitcnt vmcnt(0)" ::: "memory");
        }
    }
    __syncthreads();
}
#define REP_MASK 0u
#ifndef PG8_SP2
#define PG8_SP2 true
#endif
#ifndef PG8_ALIGN
#define PG8_ALIGN true
#endif
constexpr int NWAVES = 8, NTHR = NWAVES * 64;
constexpr int BATCH = 4, SEQ = 2048, DM = 4096, NMETA = 16;
constexpr int MR = BATCH * SEQ;
constexpr int MROWS = MR + NMETA;
constexpr int MT = 8448;
constexpr int NIN = 32784;
constexpr int N1 = 33024;
constexpr int DFF = 11008, NF = 2 * DFF;
constexpr int RET_H = 8, RET_DK = 256, RET_DV = 512, GLA_H = 4, GLA_DK = 512, GLA_DV = 1024, GLA_RANK = 16;
constexpr float EPS = 1e-6f;
constexpr int C_QR = 0, C_KR = 2048, C_QG = 4096, C_KG = 6144, LDP = 8192, C_GR = 8192, C_GG = 16384, C_V = 24576, C_Z = 32768;
constexpr int NPH = 11;
#ifndef MK_N_LAUNCHES
#define MK_N_LAUNCHES 1
#endif
constexpr int N_LAUNCHES = MK_N_LAUNCHES;

constexpr size_t al256(size_t x) { return (x + 255) & ~(size_t)255; }
constexpr size_t WS_CTL = 0, CTL_ZERO_BYTES = 1u << 20;
constexpr size_t WS_W1T = WS_CTL + CTL_ZERO_BYTES;
constexpr size_t WS_WOT = WS_W1T + al256((size_t)N1 * DM * 2);
constexpr size_t WS_WFT = WS_WOT + al256((size_t)DM * DM * 2);
constexpr size_t WS_W2T = WS_WFT + al256((size_t)NF * DM * 2);
constexpr size_t WS_XB  = WS_W2T + al256((size_t)DM * DFF * 2);
constexpr size_t WS_RS1 = WS_XB + al256((size_t)MT * DM * 2);
constexpr size_t WS_RS2 = WS_RS1 + al256((size_t)MT * 4);
constexpr size_t WS_ZB  = WS_RS2 + al256((size_t)MT * 4);
constexpr size_t WS_COS = WS_ZB + al256((size_t)MT * 16 * 4);
constexpr size_t WS_SIN = WS_COS + al256((size_t)MROWS * 128 * 4);
constexpr size_t WS_PROJ = WS_SIN + al256((size_t)MROWS * 128 * 4);
constexpr size_t WS_UG  = WS_PROJ;
constexpr size_t WS_ACT = WS_UG + al256((size_t)MT * NF * 2);
constexpr size_t WS_YR  = WS_PROJ + al256((size_t)MT * N1 * 2);
constexpr size_t WS_YG  = WS_YR + al256((size_t)MROWS * DM * 2);
constexpr size_t WS_GR  = WS_YG + al256((size_t)MROWS * DM * 2);
constexpr size_t WS_GG  = WS_GR + al256((size_t)MT * DM * 2);
constexpr size_t WS_MRG = WS_GG + al256((size_t)MT * DM * 2);
constexpr size_t WS_H1  = WS_MRG + al256((size_t)MT * DM * 2);
constexpr size_t WS_H1B = WS_H1 + al256((size_t)MT * DM * 4);
constexpr size_t WS_QFG = WS_H1B + al256((size_t)MT * DM * 2);
constexpr size_t WS_KFG = WS_QFG + (size_t)4 * 4 * 33 * 65536;
constexpr size_t WS_QFR = WS_KFG + (size_t)4 * 4 * 33 * 65536;
constexpr size_t WS_KFR = WS_QFR + (size_t)4 * 8 * 33 * 32768;
constexpr size_t WS_VFG = WS_KFR + (size_t)4 * 8 * 33 * 32768;
constexpr size_t WS_VFR = WS_VFG + (size_t)4 * 33 * 64 * 8192;
constexpr size_t WS_PFG = WS_VFR + (size_t)4 * 33 * 64 * 8192;
constexpr size_t WS_PFR = WS_PFG + (size_t)4 * 4 * 33 * 8192;
constexpr size_t WS_DECG = WS_PFR + (size_t)4 * 8 * 33 * 8192;
constexpr size_t WS_END = WS_DECG + (size_t)4 * 4 * 33 * 512 * 4;
static_assert(WS_ACT + (size_t)MR * DFF * 2 <= WS_YR, "UG | ACT overlay fits inside PROJ");
static_assert(WS_END <= (size_t)4 * 4096 * NIN * 4, "workspace map fits 4 x the largest tensor");
constexpr int CW_TMO = 0, CW_CODE = 1, CW_BAR = 4096, CW_SS2 = 8192;

constexpr int RING_OFF = 0, RING_BYTES = 131072;
constexpr int LDS_BYTES = 163840;
constexpr int LDSCTL_OFF = LDS_BYTES - 1024, MISC_OFF = LDSCTL_OFF + 320;
static_assert(MISC_OFF + 128 <= LDS_BYTES, "LDS map");

__device__ __forceinline__ float bf2f(bf16 v) { return __builtin_bit_cast(float, (unsigned)v << 16); }
__device__ __forceinline__ float wave_sum(float v) {
#pragma unroll
    for (int o = 1; o < 64; o <<= 1) v += __shfl_xor(v, o);
    return v;
}
__device__ __forceinline__ float sigm(float x) { return 1.f / (1.f + __expf(-x)); }
__device__ __forceinline__ float silu(float x) { return x / (1.f + __expf(-x)); }
__device__ __forceinline__ float logsig(float x) { return fminf(x, 0.f) - __logf(1.0f + __expf(-fabsf(x))); }

typedef float f32x16 __attribute__((ext_vector_type(16)));
#define MFMA32(a, b, c) __builtin_amdgcn_mfma_f32_32x32x16_bf16((a), (b), (c), 0, 0, 0)
__device__ __forceinline__ unsigned pkbf(float lo, float hi) { typedef __bf16 b2 __attribute__((ext_vector_type(2))); typedef float f2 __attribute__((ext_vector_type(2))); return __builtin_bit_cast(unsigned, __builtin_convertvector((f2){lo, hi}, b2)); }
__device__ __forceinline__ bf16 f2b(float x) { return (bf16)(pkbf(x, 0.f) & 0xffffu); }
__device__ __forceinline__ int chunk_row(int b, int n, int i) { return n == 0 ? (i < 48 ? -1 : MR + i - 48) : b * SEQ + 64 * (n - 1) + i; }

struct Frame {
    LAS unsigned char* lds;
    volatile LAS unsigned* MISC;
    gu32* ctl;
    int tid, lane, wave, G;
    const float *x, *meta, *attn_norm, *w_in, *w_gate_up, *b_gate, *ret_norm, *gla_norm, *w_out, *ffn_norm, *w_ffn_in, *conv_w, *conv_b, *w_ffn_out, *final_norm;
    const int* positions;
    float* out;
    bf16 *W1t, *Wot, *Wft, *W2t, *XB, *PROJ, *UG, *ACT, *MRG, *H1B;
    float *RS1, *SS2, *ZB, *COS, *SIN, *H1, *DECG;
    bf16 *YR, *YG, *GR, *GG, *QFG, *KFG, *QFR, *KFR, *VFG, *VFR, *PFG, *PFR;
};

namespace pg8 {
__device__ __forceinline__ float gate2(float o, float m) { return o * __builtin_amdgcn_rcpf((1.0f + __expf(-o)) * (1.0f + __expf(-m))); }
struct EpiG1 {
    static constexpr bool PERM = true, AFTER_DRAIN = false;
    bf16_t* O; const float* rs; float* zb; bf16_t* GR; bf16_t* GG;
    __device__ __forceinline__ void operator()(const f32x4 (&acc)[2][2][4][2], const Unit& u, int wr, int wc, int fr, int fq) const {
        const int row0 = u.pm * BM + wr * 64 + fr;
        if (u.pn < 32) {
            const int col0 = u.pn * BM + wc * 32 + 8 * fq;
#pragma unroll
            for (int ai = 0; ai < 2; ++ai)
#pragma unroll
                for (int m = 0; m < 4; ++m) { const int row = row0 + ai * HALF + m * 16; const float s = rs[row]; bf16_t* rowp = O + (size_t)row * LDP + col0;
#pragma unroll
                    for (int bj = 0; bj < 2; ++bj) { const f32x4 v0 = acc[ai][bj][m][0] * s, v1 = acc[ai][bj][m][1] * s;
                        u32x4 w; w.x = cvt_pk_bf16(v0[0], v0[1]); w.y = cvt_pk_bf16(v0[2], v0[3]); w.z = cvt_pk_bf16(v1[0], v1[1]); w.w = cvt_pk_bf16(v1[2], v1[3]);
                        *(u32x4*)(rowp + bj * HALF) = w; } }
        } else {
            bf16_t* G = u.pn < 64 ? GR : GG; const int col0 = 128 * ((u.pn - 32) & 31) + wc * 32 + 8 * fq;
#pragma unroll
            for (int ai = 0; ai < 2; ++ai)
#pragma unroll
                for (int m = 0; m < 4; ++m) { const int row = row0 + ai * HALF + m * 16; const float s = rs[row];
                    const f32x4 o0 = acc[ai][0][m][0] * s, o1 = acc[ai][0][m][1] * s, m0 = acc[ai][1][m][0] * s, m1 = acc[ai][1][m][1] * s;
                    u32x4 w; w.x = cvt_pk_bf16(gate2(o0[0], m0[0]), gate2(o0[1], m0[1])); w.y = cvt_pk_bf16(gate2(o0[2], m0[2]), gate2(o0[3], m0[3]));
                    w.z = cvt_pk_bf16(gate2(o1[0], m1[0]), gate2(o1[1], m1[1])); w.w = cvt_pk_bf16(gate2(o1[2], m1[2]), gate2(o1[3], m1[3]));
                    *(u32x4*)(G + (size_t)row * DM + col0) = w; }
        }
    }
};
struct EpiV {
    static constexpr bool PERM = false, AFTER_DRAIN = false;
    unsigned char* VFR; unsigned char* VFG; const float* rs;
    __device__ __forceinline__ void operator()(const f32x4 (&acc)[2][2][4][2], const Unit& u, int wr, int wc, int fr, int fq) const {
        unsigned char* VF = u.pn < 16 ? VFR : VFG; const int b = u.pm >> 3;
#pragma unroll
        for (int ai = 0; ai < 2; ++ai) { const int nc = 1 + 4 * (u.pm & 7) + 2 * ai + wr;
#pragma unroll
            for (int m = 0; m < 4; ++m) { const f32x4 s4 = *(const f32x4*)(rs + u.pm * BM + ai * HALF + wr * 64 + m * 16 + 4 * fq);
#pragma unroll
                for (int bj = 0; bj < 2; ++bj) { const int slg = 4 * (u.pn & 15) + 2 * bj + (wc >> 1);
                    unsigned char* fb = VF + ((((size_t)b * 33 + nc) * 64 + slg) * 8 + (wc & 1) * 4 + m) * 1024 + (fr + 32 * (fq & 1)) * 16 + 8 * (fq >> 1);
#pragma unroll
                    for (int n = 0; n < 2; ++n) { const f32x4 v = acc[ai][bj][m][n] * s4; unsigned long long w = (unsigned long long)cvt_pk_bf16(v[0], v[1]) | ((unsigned long long)cvt_pk_bf16(v[2], v[3]) << 32);
                        *(unsigned long long*)(fb + n * 256) = w; } } } }
    }
};
struct EpiScaleBf16 {
    static constexpr bool PERM = true, AFTER_DRAIN = false;
    bf16_t* O; int ldc; const float* ss;
    __device__ __forceinline__ void operator()(const f32x4 (&acc)[2][2][4][2], const Unit& u, int wr, int wc, int fr, int fq) const {
        const int row0 = u.pm * BM + wr * 64 + fr, col0 = u.pn * BM + wc * 32 + 8 * fq;
#pragma unroll
        for (int ai = 0; ai < 2; ++ai)
#pragma unroll
            for (int m = 0; m < 4; ++m) { const int row = row0 + ai * HALF + m * 16; const float s = 1.0f / sqrtf(ss[row] * (1.0f / 4096.0f) + 1e-6f); bf16_t* rowp = O + (size_t)row * ldc + col0;
#pragma unroll
                for (int bj = 0; bj < 2; ++bj) { const f32x4 v0 = acc[ai][bj][m][0] * s, v1 = acc[ai][bj][m][1] * s;
                    u32x4 w; w.x = cvt_pk_bf16(v0[0], v0[1]); w.y = cvt_pk_bf16(v0[2], v0[3]); w.z = cvt_pk_bf16(v1[0], v1[1]); w.w = cvt_pk_bf16(v1[2], v1[3]);
                    *(u32x4*)(rowp + bj * HALF) = w; } }
    }
};
struct EpiResX {
    static constexpr bool PERM = true, AFTER_DRAIN = false;
    const float* x; const float* meta; float* out; bf16_t* outb; float* ss; int ldc; int nreal, nmeta;
    __device__ __forceinline__ void operator()(const f32x4 (&acc)[2][2][4][2], const Unit& u, int wr, int wc, int fr, int fq) const {
        const int row0 = u.pm * BM + wr * 64 + fr, col0 = u.pn * BM + wc * 32 + 8 * fq;
#pragma unroll
        for (int ai = 0; ai < 2; ++ai)
#pragma unroll
            for (int m = 0; m < 4; ++m) { const int row = row0 + ai * HALF + m * 16;
                const float* bp = row < nreal ? x + (size_t)row * ldc : (row < nreal + nmeta ? meta + (size_t)(row - nreal) * ldc : nullptr);
                float* rowp = out + (size_t)row * ldc + col0; bf16_t* rowb = outb + (size_t)row * ldc + col0; float q = 0.f;
#pragma unroll
                for (int bj = 0; bj < 2; ++bj) { f32x4 o0 = (f32x4){0.f, 0.f, 0.f, 0.f}, o1 = o0;
                    if (bp) { o0 = *(const f32x4*)(bp + col0 + bj * HALF) + acc[ai][bj][m][0]; o1 = *(const f32x4*)(bp + col0 + bj * HALF + 4) + acc[ai][bj][m][1]; }
                    *(f32x4*)(rowp + bj * HALF) = o0; *(f32x4*)(rowp + bj * HALF + 4) = o1;
                    u32x4 w; w.x = cvt_pk_bf16(o0[0], o0[1]); w.y = cvt_pk_bf16(o0[2], o0[3]); w.z = cvt_pk_bf16(o1[0], o1[1]); w.w = cvt_pk_bf16(o1[2], o1[3]);
                    *(u32x4*)(rowb + bj * HALF) = w;
                    q += (o0[0] * o0[0] + o0[1] * o0[1]) + (o0[2] * o0[2] + o0[3] * o0[3]) + (o1[0] * o1[0] + o1[1] * o1[1]) + (o1[2] * o1[2] + o1[3] * o1[3]); }
                q += __shfl_xor(q, 16); q += __shfl_xor(q, 32);
                if (fq == 0 && bp) atomicAdd(ss + row, q); }
    }
};
struct EpiResF32 {
    static constexpr bool PERM = false, AFTER_DRAIN = false;
    const float* base; float* out; int ldc;
    __device__ __forceinline__ void operator()(const f32x4 (&acc)[2][2][4][2], const Unit& u, int wr, int wc, int fr, int fq) const {
        const int row0 = u.pm * BM + wr * 64 + fr, col0 = u.pn * BM + wc * 32 + 4 * fq;
#pragma unroll
        for (int ai = 0; ai < 2; ++ai)
#pragma unroll
            for (int m = 0; m < 4; ++m) { const size_t off = (size_t)(row0 + ai * HALF + m * 16) * ldc + col0;
#pragma unroll
                for (int bj = 0; bj < 2; ++bj)
#pragma unroll
                    for (int n = 0; n < 2; ++n) *(f32x4*)(out + off + bj * HALF + n * 16) = *(const f32x4*)(base + off + bj * HALF + n * 16) + acc[ai][bj][m][n]; }
    }
};
}

struct TItem { const float* W; int K, ldw, c0, nc; bf16* WT; int row_off; const float* kscale; int item; int blk, bstride; };
__device__ __forceinline__ void titem_load(const TItem& t, f32x4 (&v)[16], int lane) {
    const int nblk = (t.nc + 63) / 64, kb = t.item / nblk, nb = t.item % nblk, k0 = 64 * kb, n = 64 * nb + 4 * (lane & 15);
    const bool ok = n < t.nc;
    const float* p = t.W + (size_t)(k0 + (lane >> 4)) * t.ldw + t.c0 + n;
#pragma unroll
    for (int i = 0; i < 16; ++i) v[i] = ok ? *(const f32x4*)(p + (size_t)(4 * i) * t.ldw) : (f32x4){0.f, 0.f, 0.f, 0.f};
}
__device__ __forceinline__ void titem_store(const TItem& t, const f32x4 (&v)[16], LAS float* scr, int lane) {
    const int nblk = (t.nc + 63) / 64, kb = t.item / nblk, nb = t.item % nblk, k0 = 64 * kb, n0 = 64 * nb;
#pragma unroll
    for (int i = 0; i < 16; ++i) { LAS float* d = scr + (4 * i + (lane >> 4)) * 65 + 4 * (lane & 15); d[0] = v[i].x; d[1] = v[i].y; d[2] = v[i].z; d[3] = v[i].w; }
    LDS_WAIT(); asm volatile("" ::: "memory");
    const int c = lane & 7;
    f32x4 s0 = (f32x4){1.f, 1.f, 1.f, 1.f}, s1 = s0;
    if (t.kscale) { s0 = *(const f32x4*)(t.kscale + k0 + 8 * c); s1 = *(const f32x4*)(t.kscale + k0 + 8 * c + 4); }
#pragma unroll
    for (int j = 0; j < 8; ++j) { const int nn = (lane >> 3) + 8 * j; const LAS float* s = scr + (8 * c) * 65 + nn;
        v4u o; o.x = pk2(s[0 * 65] * s0.x, s[1 * 65] * s0.y); o.y = pk2(s[2 * 65] * s0.z, s[3 * 65] * s0.w); o.z = pk2(s[4 * 65] * s1.x, s[5 * 65] * s1.y); o.w = pk2(s[6 * 65] * s1.z, s[7 * 65] * s1.w);
        const int nd = n0 + nn; *(GAS v4u*)(t.WT + (size_t)(t.row_off + (nd / t.blk) * t.bstride + nd % t.blk) * t.K + k0 + 8 * c) = o; }
    LDS_WAIT(); asm volatile("" ::: "memory");
}
__device__ __forceinline__ void p0_prologue(Frame& F) {
    LAS float* scr = (LAS float*)(F.lds + RING_OFF + F.wave * 17408);
    const int gw = blockIdx.x * NWAVES + F.wave, NGW = F.G * NWAVES;
    constexpr int BIG = 1 << 30;
    constexpr int I_QK = 64 * (4096 / 64), I_V = 64 * (4096 / 64), I_G = 64 * (4096 / 64), I_Z = 64;
    constexpr int I_O = 64 * (DM / 64), I_F = 64 * (NF / 64), I_2 = (DFF / 64) * (DM / 64);
    constexpr int NITEMS = 2 * I_QK + 2 * I_V + 4 * I_G + I_Z + I_O + I_F + I_2;
    auto mk = [&](int it) { TItem t; int r = it;
        if (r < I_QK) { t = TItem{F.w_in, DM, NIN, 0, 4096, F.W1t, C_QR, F.attn_norm, r, BIG, 0}; return t; } r -= I_QK;
        if (r < I_V) { t = TItem{F.w_in, DM, NIN, 4096, 4096, F.W1t, C_V, F.attn_norm, r, BIG, 0}; return t; } r -= I_V;
        if (r < I_G) { t = TItem{F.w_in, DM, NIN, 8192, 4096, F.W1t, C_GR, F.attn_norm, r, 128, 256}; return t; } r -= I_G;
        if (r < I_QK) { t = TItem{F.w_in, DM, NIN, 12288, 4096, F.W1t, C_QG, F.attn_norm, r, BIG, 0}; return t; } r -= I_QK;
        if (r < I_V) { t = TItem{F.w_in, DM, NIN, 16384, 4096, F.W1t, C_V + 4096, F.attn_norm, r, BIG, 0}; return t; } r -= I_V;
        if (r < I_G) { t = TItem{F.w_in, DM, NIN, 20480, 4096, F.W1t, C_GG, F.attn_norm, r, 128, 256}; return t; } r -= I_G;
        if (r < I_Z) { t = TItem{F.w_in, DM, NIN, 24576, 16, F.W1t, C_Z, F.attn_norm, r, BIG, 0}; return t; } r -= I_Z;
        if (r < I_G) { t = TItem{F.w_in, DM, NIN, 24592, 4096, F.W1t, C_GR + 128, F.attn_norm, r, 128, 256}; return t; } r -= I_G;
        if (r < I_G) { t = TItem{F.w_in, DM, NIN, 28688, 4096, F.W1t, C_GG + 128, F.attn_norm, r, 128, 256}; return t; } r -= I_G;
        if (r < I_O) { t = TItem{F.w_out, DM, DM, 0, DM, F.Wot, 0, nullptr, r, BIG, 0}; return t; } r -= I_O;
        if (r < I_F) { t = TItem{F.w_ffn_in, DM, NF, 0, NF, F.Wft, 0, F.ffn_norm, r, BIG, 0}; return t; } r -= I_F;
        t = TItem{F.w_ffn_out, DFF, DM, 0, DM, F.W2t, 0, nullptr, r, BIG, 0}; return t; };
    if (gw < NITEMS) {
        f32x4 cur[16], nxt[16]; TItem tc = mk(gw); titem_load(tc, cur, F.lane);
        for (int it = gw; it < NITEMS; it += NGW) {
            const bool more = it + NGW < NITEMS; TItem tn = tc;
            if (more) { tn = mk(it + NGW); titem_load(tn, nxt, F.lane); }
            titem_store(tc, cur, scr, F.lane);
            if (more) {
#pragma unroll
                for (int i = 0; i < 16; ++i) cur[i] = nxt[i];
                tc = tn; }
        }
    }
    { const size_t n16 = (size_t)(N1 - C_Z - 64) * DM * 2 / 16; GAS v4u* p = (GAS v4u*)(F.W1t + (size_t)(C_Z + 64) * DM);
      for (size_t i = (size_t)blockIdx.x * NTHR + F.tid; i < n16; i += (size_t)F.G * NTHR) p[i] = (v4u){0u, 0u, 0u, 0u}; }
    { const size_t n16 = (size_t)64 * 8 * 1024 / 16;
      for (size_t i = (size_t)blockIdx.x * NTHR + F.tid; i < 2 * n16; i += (size_t)F.G * NTHR) ((GAS v4u*)(i < n16 ? F.VFR : F.VFG))[i < n16 ? i : i - n16] = (v4u){0u, 0u, 0u, 0u}; }
    for (int m = gw; m < MT; m += NGW) {
        GAS unsigned long long* o8 = (GAS unsigned long long*)(F.XB + (size_t)m * DM) + F.lane;
        if (m < MROWS) {
            const float* xrow = m < MR ? F.x + (size_t)m * DM : F.meta + (size_t)(m - MR) * DM;
            const GAS f32x4* xr = (const GAS f32x4*)xrow + F.lane; float ss = 0.f;
#pragma unroll
            for (int j = 0; j < 16; ++j) { const f32x4 v = xr[64 * j]; ss += (v.x * v.x + v.y * v.y) + (v.z * v.z + v.w * v.w);
                o8[64 * j] = (unsigned long long)pk2(v.x, v.y) | ((unsigned long long)pk2(v.z, v.w) << 32); }
            ss = wave_sum(ss);
            if (F.lane == 0) F.RS1[m] = 1.0f / sqrtf(ss * (1.0f / DM) + EPS);
        } else {
            GAS unsigned long long* o2 = (GAS unsigned long long*)(F.MRG + (size_t)m * DM) + F.lane;
            GAS unsigned long long* o3 = (GAS unsigned long long*)(F.H1B + (size_t)m * DM) + F.lane;
#pragma unroll
            for (int j = 0; j < 16; ++j) { o8[64 * j] = 0ull; o2[64 * j] = 0ull; o3[64 * j] = 0ull; }
            if (F.lane == 0) F.RS1[m] = 0.f;
        }
    }
    for (int i = blockIdx.x * NTHR + F.tid; i < MROWS * 128; i += F.G * NTHR) {
        const int m = i >> 7, j = i & 127;
        const int pos = m < MR ? F.positions[m] + NMETA : m - MR;
        const float inv_freq = powf(10000.0f, -(float)j * (1.0f / 128.0f));
        const float ang = (float)pos * inv_freq; float s, c; sincosf(ang, &s, &c);
        F.COS[i] = c; F.SIN[i] = s;
    }
}

typedef float f32x4v __attribute__((ext_vector_type(4)));
#define MFMA16(a, b, c) __builtin_amdgcn_mfma_f32_16x16x32_bf16((a), (b), (c), 0, 0, 0)
__device__ __forceinline__ f32x4v skinny_dot(const bf16* A, const bf16* Bt, int n0, int k0, int nks, int lane) {
    const int fr = lane & 15, fq = lane >> 4;
    const bf16* ap = A + (size_t)fr * DM + k0 + 8 * fq; const bf16* bp = Bt + (size_t)(n0 + fr) * DM + k0 + 8 * fq;
    f32x4v acc = (f32x4v){0.f, 0.f, 0.f, 0.f};
#pragma unroll 8
    for (int ks = 0; ks < nks; ++ks) acc = MFMA16(*(const bf16x8*)(ap + 32 * ks), *(const bf16x8*)(bp + 32 * ks), acc);
    return acc;
}
__device__ __forceinline__ void meta_proj(Frame& F) {
    const int lane = F.lane, fr = lane & 15, fq = lane >> 4, w8 = F.wave; LAS float* ex = (LAS float*)F.lds;
    const bf16* A = F.XB + (size_t)MR * DM;
    for (int it = blockIdx.x; it < 256; it += F.G) {
        if (it < 64) {
            const int n0 = 128 * it + 16 * w8; const f32x4v acc = skinny_dot(A, F.W1t, n0, 0, DM / 32, lane);
#pragma unroll
            for (int e = 0; e < 4; ++e) { const int row = MR + 4 * fq + e; F.PROJ[(size_t)row * LDP + n0 + fr] = f2b(acc[e] * F.RS1[row]); }
        } else if (it < 128) {
            const int cvv = 128 * (it - 64) + 16 * w8 + fr; const f32x4v acc = skinny_dot(A, F.W1t, C_V + 128 * (it - 64) + 16 * w8, 0, DM / 32, lane);
            const int cv = cvv & 4095, slg = cv >> 6, wt = (cv >> 5) & 1, rp = cv & 31; unsigned char* VF = (unsigned char*)(cvv < 4096 ? F.VFR : F.VFG);
            const f32x4v sc = *(const f32x4v*)(F.RS1 + MR + 4 * fq);
            *(unsigned long long*)(VF + ((size_t)slg * 8 + wt * 4 + 3) * 1024 + (rp + 32 * (fq & 1)) * 16 + 8 * (fq >> 1)) = (unsigned long long)pkbf(acc[0] * sc[0], acc[1] * sc[1]) | ((unsigned long long)pkbf(acc[2] * sc[2], acc[3] * sc[3]) << 32);
        } else if (it < 256) {
            const int t = (it - 128) >> 1, sp = (it - 128) & 1;
            const int n0 = C_GR + 256 * t + (w8 >= 4 ? 128 : 0) + 64 * sp + 16 * (w8 & 3);
            const f32x4v acc = skinny_dot(A, F.W1t, n0, 0, DM / 32, lane);
#pragma unroll
            for (int e = 0; e < 4; ++e) ex[(w8 * 4 + e) * 64 + lane] = acc[e] * F.RS1[MR + 4 * fq + e];
            __syncthreads();
            if (w8 < 4) { bf16* G = t < 32 ? F.GR : F.GG; const int ch = 128 * (t & 31) + 64 * sp + 16 * w8 + fr;
#pragma unroll
                for (int e = 0; e < 4; ++e) { const int row = MR + 4 * fq + e; G[(size_t)row * DM + ch] = f2b(pg8::gate2(ex[(w8 * 4 + e) * 64 + lane], ex[((w8 + 4) * 4 + e) * 64 + lane])); } }
            __syncthreads();
        }
    }
    __syncthreads();
}
__device__ __forceinline__ void z_proj(Frame& F) {
    const int lane = F.lane, fr = lane & 15, fq = lane >> 4;
    for (int g = blockIdx.x * NWAVES + F.wave; g < MROWS / 16; g += F.G * NWAVES) {
        const f32x4v acc = skinny_dot(F.XB + (size_t)(16 * g) * DM, F.W1t, C_Z, 0, DM / 32, lane);
#pragma unroll
        for (int e = 0; e < 4; ++e) { const int row = 16 * g + 4 * fq + e; F.ZB[(size_t)row * 16 + fr] = acc[e] * F.RS1[row]; }
    }
}
__device__ __forceinline__ void meta_wout(Frame& F) {
    const int lane = F.lane, fr = lane & 15, fq = lane >> 4, w8 = F.wave; LAS float* ex = (LAS float*)F.lds;
    for (int it = blockIdx.x; it < DM / 16; it += F.G) {
        const int n0 = 16 * it; const f32x4v acc = skinny_dot(F.MRG + (size_t)MR * DM, F.Wot, n0, 512 * w8, 16, lane);
#pragma unroll
        for (int e = 0; e < 4; ++e) ex[(w8 * 4 + e) * 64 + lane] = acc[e];
        __syncthreads();
        if (w8 == 0) {
#pragma unroll
            for (int e = 2; e < 4; ++e) { float v = 0.f;
#pragma unroll
                for (int w = 0; w < 8; ++w) v += ex[(w * 4 + e) * 64 + lane];
                const int mrow = 4 * fq + e;
                const float hv = F.meta[(size_t)(mrow & 15) * DM + n0 + fr] + v; float q = hv * hv;
                q += __shfl_xor(q, 1); q += __shfl_xor(q, 2); q += __shfl_xor(q, 4); q += __shfl_xor(q, 8);
                if (fq == 3) { F.H1[(size_t)(MR + mrow) * DM + n0 + fr] = hv; F.H1B[(size_t)(MR + mrow) * DM + n0 + fr] = f2b(hv); if (fr == 0) atomicAdd(F.SS2 + MR + mrow, q); } }
        }
        __syncthreads();
    }
}
__device__ __forceinline__ void meta_up(Frame& F) {
    const int lane = F.lane, fr = lane & 15, fq = lane >> 4;
    for (int g = blockIdx.x * NWAVES + F.wave; g < DFF / 16; g += F.G * NWAVES) {
        const f32x4v acc = skinny_dot(F.H1B + (size_t)MR * DM, F.Wft, 16 * g, 0, DM / 32, lane);
        if (fq == 3) {
#pragma unroll
            for (int e = 2; e < 4; ++e) { const int row = MR + 12 + e; const float rs = 1.0f / sqrtf(F.SS2[row] * (1.0f / 4096.0f) + EPS);
                F.UG[(size_t)row * NF + 16 * g + fr] = f2b(acc[e] * rs); } }
    }
}

template <bool GLA> __device__ __forceinline__ void prep_qkp(Frame& F, int u) {
    constexpr int DK = GLA ? GLA_DK : RET_DK, NH = GLA ? GLA_H : RET_H, LDQ = DK + 8, DKW = DK / 8, NKS = DKW / 16, NDT = DKW / 32;
    const int n = u % 33, h = (u / 33) % NH, b = u / (33 * NH);
    LAS bf16* Qs = (LAS bf16*)F.lds; LAS bf16* Ks = Qs + 64 * LDQ; LAS float* zs = (LAS float*)(Ks + 64 * LDQ);
    const int tid = F.tid, lane = F.lane, w8 = F.wave, r = lane & 31, hh = lane >> 5;
    if (GLA) {
        for (int e = tid; e < 64 * 16; e += NTHR) { const int row = chunk_row(b, n, e >> 4); zs[e] = row >= 0 ? F.ZB[(size_t)row * 16 + (e & 15)] : 0.f; }
        __syncthreads();
        const int d = tid, ch = h * GLA_DK + d; float wg[GLA_RANK];
#pragma unroll
        for (int q = 0; q < GLA_RANK; ++q) wg[q] = F.w_gate_up[q * 2048 + ch];
        const float bg = F.b_gate[ch]; float bc = 0.f;
#pragma unroll 1
        for (int i0 = 0; i0 < 64; i0 += 16) {
            unsigned qr[16], kr[16];
#pragma unroll
            for (int ii = 0; ii < 16; ++ii) { const int row = chunk_row(b, n, i0 + ii); qr[ii] = 0u; kr[ii] = 0u;
                if (row >= 0) { const bf16* pr = F.PROJ + (size_t)row * LDP; qr[ii] = pr[C_QG + ch]; kr[ii] = pr[C_KG + ch]; } }
#pragma unroll
            for (int ii = 0; ii < 16; ++ii) { const int i = i0 + ii, row = chunk_row(b, n, i); float qv = 0.f, kv = 0.f;
                if (row >= 0) { float lg = bg;
#pragma unroll
                    for (int q = 0; q < GLA_RANK; ++q) lg += zs[i * 16 + q] * wg[q];
                    bc += logsig(lg) * (1.0f / 16.0f);
                    qv = bf2f((bf16)qr[ii]) * 0.04419417382415922f * __expf(bc); kv = bf2f((bf16)kr[ii]) * __expf(-bc); }
                Qs[i * LDQ + d] = f2b(qv); Ks[i * LDQ + d] = f2b(kv); }
        }
        F.DECG[((size_t)(b * GLA_H + h) * 33 + n) * GLA_DK + d] = __expf(bc);
    } else {
        const int p = tid & 127, tg = tid >> 7; const float l2g = log2f(1.0f - exp2f(-5.0f - (float)h));
#pragma unroll 1
        for (int i8 = 0; i8 < 16; i8 += 8) {
            unsigned q1r[8], q2r[8], k1r[8], k2r[8]; float cr[8], sr[8];
#pragma unroll
            for (int ii = 0; ii < 8; ++ii) { const int row = chunk_row(b, n, tg * 16 + i8 + ii); q1r[ii] = q2r[ii] = k1r[ii] = k2r[ii] = 0u; cr[ii] = 0.f; sr[ii] = 0.f;
                if (row >= 0) { const bf16* pr = F.PROJ + (size_t)row * LDP; cr[ii] = F.COS[row * 128 + p]; sr[ii] = F.SIN[row * 128 + p];
                    q1r[ii] = pr[C_QR + h * 256 + p]; q2r[ii] = pr[C_QR + h * 256 + 128 + p]; k1r[ii] = pr[C_KR + h * 256 + p]; k2r[ii] = pr[C_KR + h * 256 + 128 + p]; } }
#pragma unroll
            for (int ii = 0; ii < 8; ++ii) { const int i = tg * 16 + i8 + ii; const float c = cr[ii], sn = sr[ii];
                const float q1 = bf2f((bf16)q1r[ii]), q2 = bf2f((bf16)q2r[ii]), k1 = bf2f((bf16)k1r[ii]), k2 = bf2f((bf16)k2r[ii]);
                const float dq = exp2f((float)(i + 1) * l2g), dkk = 0.0625f / dq;
                Qs[i * LDQ + p] = f2b((q1 * c - q2 * sn) * dq); Qs[i * LDQ + p + 128] = f2b((q2 * c + q1 * sn) * dq);
                Ks[i * LDQ + p] = f2b((k1 * c - k2 * sn) * dkk); Ks[i * LDQ + p + 128] = f2b((k2 * c + k1 * sn) * dkk); }
        }
    }
    __syncthreads();
    const size_t cb = (size_t)(b * NH + h) * 33 + n;
    {
        char* qdst = (char*)(GLA ? F.QFG : F.QFR) + ((cb * 8 + w8) * (NKS * 2)) * 1024 + lane * 16;
#pragma unroll
        for (int ks = 0; ks < NKS; ++ks)
#pragma unroll
            for (int qt = 0; qt < 2; ++qt) { const LAS bf16* src = Qs + (32 * qt + r) * LDQ + DKW * w8 + 16 * ks + 4 * hh;
                const unsigned long long lo = *(const LAS unsigned long long*)src, hi = *(const LAS unsigned long long*)(src + 8);
                *(v4u*)(qdst + (ks * 2 + qt) * 1024) = (v4u){(unsigned)lo, (unsigned)(lo >> 32), (unsigned)hi, (unsigned)(hi >> 32)}; }
        char* kdst = (char*)(GLA ? F.KFG : F.KFR) + ((cb * 8 + w8) * (NDT * 4)) * 1024 + lane * 16;
#pragma unroll
        for (int dkt = 0; dkt < NDT; ++dkt)
#pragma unroll
            for (int ks = 0; ks < 4; ++ks) { unsigned w[4];
#pragma unroll
                for (int jj = 0; jj < 4; ++jj) { const int j0 = 2 * jj, t0 = 16 * ks + 8 * (j0 >> 2) + 4 * hh + (j0 & 3);
                    const unsigned e0 = Ks[t0 * LDQ + DKW * w8 + 32 * dkt + r], e1 = Ks[(t0 + 1) * LDQ + DKW * w8 + 32 * dkt + r]; w[jj] = e0 | (e1 << 16); }
                *(v4u*)(kdst + (dkt * 4 + ks) * 1024) = (v4u){w[0], w[1], w[2], w[3]}; }
    }
    if (w8 < 4) {
        const int kt = w8 >> 1, qt = w8 & 1; f32x16 acc;
#pragma unroll
        for (int i = 0; i < 16; ++i) acc[i] = 0.f;
        if (!(kt == 1 && qt == 0)) {
            const LAS bf16* ap = Ks + (32 * kt + r) * LDQ + 8 * hh; const LAS bf16* bp = Qs + (32 * qt + r) * LDQ + 8 * hh;
#pragma unroll 8
            for (int s = 0; s < DK / 16; ++s) acc = MFMA32(*(const LAS bf16x8*)(ap + 16 * s), *(const LAS bf16x8*)(bp + 16 * s), acc);
        }
        char* pdst = (char*)(GLA ? F.PFG : F.PFR) + (cb * 8) * 1024 + lane * 16;
#pragma unroll
        for (int s2 = 0; s2 < 2; ++s2) { unsigned w[4];
#pragma unroll
            for (int jj = 0; jj < 4; ++jj) { const int i0 = 8 * s2 + 2 * jj, i1 = i0 + 1;
                const int k0 = 32 * kt + (i0 & 3) + 8 * (i0 >> 2) + 4 * hh, k1 = 32 * kt + (i1 & 3) + 8 * (i1 >> 2) + 4 * hh, qc = 32 * qt + r;
                w[jj] = pkbf(k0 <= qc ? acc[i0] : 0.f, k1 <= qc ? acc[i1] : 0.f); }
            *(v4u*)(pdst + ((2 * kt + s2) * 2 + qt) * 1024) = (v4u){w[0], w[1], w[2], w[3]}; }
    }
    __syncthreads();
}
#ifndef PREP_REP
#define PREP_REP 0
#endif
__device__ __forceinline__ void p2_prep(Frame& F) {
    constexpr int U_R = 4 * 8 * 33, U_G = 4 * 4 * 33;
    for (int u = blockIdx.x; u < U_G + U_R; u += F.G) {
        if (u < U_G) { prep_qkp<true>(F, u); if (PREP_REP & 1) prep_qkp<true>(F, u); }
        else { prep_qkp<false>(F, u - U_G); if (PREP_REP & 2) prep_qkp<false>(F, u - U_G); }
    }
}

__device__ __forceinline__ bf16x8 pack8(const f32x16& x, int s) { v4u w;
    if (s == 0) { w.x = pkbf(x[0], x[1]); w.y = pkbf(x[2], x[3]); w.z = pkbf(x[4], x[5]); w.w = pkbf(x[6], x[7]); }
    else { w.x = pkbf(x[8], x[9]); w.y = pkbf(x[10], x[11]); w.z = pkbf(x[12], x[13]); w.w = pkbf(x[14], x[15]); }
    return __builtin_bit_cast(bf16x8, w); }
#define LDS_BAR() do { asm volatile("s_waitcnt lgkmcnt(0)" ::: "memory"); __builtin_amdgcn_s_barrier(); asm volatile("" ::: "memory"); } while (0)
template <bool GLA> __device__ __forceinline__ void scan_unit(Frame& F, int u) {
    constexpr int DK = GLA ? GLA_DK : RET_DK, DV = GLA ? GLA_DV : RET_DV, NH = GLA ? GLA_H : RET_H, NSL = DV / 64, DKW = DK / 8, NKS = DKW / 16, NDT = DKW / 32;
    const int b = u / (NH * NSL), h = (u / NSL) % NH, sl = u % NSL, slg = h * NSL + sl;
    const int lane = F.lane, r = lane & 31, hh = lane >> 5, w8 = F.wave;
    LAS float* RED = (LAS float*)F.lds;
    LAS unsigned char* VL = F.lds + 131072;
    f32x16 S[NDT][2];
#pragma unroll
    for (int a = 0; a < NDT; ++a)
#pragma unroll
        for (int c = 0; c < 2; ++c)
#pragma unroll
            for (int i = 0; i < 16; ++i) S[a][c][i] = 0.f;
    const char* QFb = (const char*)(GLA ? F.QFG : F.QFR) + (((size_t)(b * NH + h) * 33 * 8 + w8) * (NKS * 2)) * 1024 + lane * 16;
    const char* KFb = (const char*)(GLA ? F.KFG : F.KFR) + (((size_t)(b * NH + h) * 33 * 8 + w8) * (NDT * 4)) * 1024 + lane * 16;
    const char* VF0 = (const char*)(GLA ? F.VFG : F.VFR) + ((size_t)slg * 8 + w8) * 1024 + lane * 16;
    const char* VFb = VF0 + (size_t)b * 33 * 64 * 8 * 1024;
    const char* PFb = (const char*)(GLA ? F.PFG : F.PFR) + ((size_t)(b * NH + h) * 33 * 8 + w8) * 1024 + lane * 16;
    bf16* Y = GLA ? F.YG : F.YR;
    const float gam64 = exp2f(64.0f * log2f(1.0f - exp2f(-5.0f - (float)h)));
    bf16x8 qf[NKS * 2];
#pragma unroll
    for (int f = 0; f < NKS * 2; ++f) qf[f] = *(const bf16x8*)(QFb + f * 1024);
    *(LAS bf16x8*)(VL + w8 * 1024 + lane * 16) = *(const bf16x8*)VF0;
    __syncthreads();
#pragma unroll 1
    for (int n = 0; n < 33; ++n) {
        const size_t cb = (size_t)(b * NH + h) * 33 + n;
        const char* kp = KFb + (size_t)n * (8 * NDT * 4 * 1024);
        const LAS unsigned char* vl = VL + (n & 1) * 8192 + lane * 16;
        const int nn = n < 32 ? n + 1 : n;
        bf16x8 kf[NDT * 4];
#pragma unroll
        for (int f = 0; f < NDT * 4; ++f) kf[f] = *(const bf16x8*)(kp + f * 1024);
        const bf16x8 bp = *(const bf16x8*)(PFb + (size_t)n * 8192);
        const bf16x8 vnext = *(const bf16x8*)(VFb + (size_t)nn * (64 * 8 * 1024));
        { const int ks2 = w8 >> 1, qt2 = w8 & 1;
#pragma unroll
          for (int wt = 0; wt < 2; ++wt) { f32x16 o0, o1;
#pragma unroll
            for (int i = 0; i < 16; ++i) { o0[i] = 0.f; o1[i] = 0.f; }
#pragma unroll
            for (int ks = 0; ks < NKS; ++ks) { const bf16x8 a = pack8(S[ks >> 1][wt], ks & 1); o0 = MFMA32(a, qf[ks * 2], o0); o1 = MFMA32(a, qf[ks * 2 + 1], o1); }
            const bf16x8 av = *(const LAS bf16x8*)(vl + (wt * 4 + ks2) * 1024);
            if (qt2 == 0) o0 = MFMA32(av, bp, o0); else o1 = MFMA32(av, bp, o1);
#pragma unroll
            for (int i = 0; i < 16; ++i) { RED[((w8 * 4 + wt * 2) * 16 + i) * 64 + lane] = o0[i]; RED[((w8 * 4 + wt * 2 + 1) * 16 + i) * 64 + lane] = o1[i]; } } }
        { const char* qn = QFb + (size_t)nn * (8 * NKS * 2 * 1024);
#pragma unroll
          for (int f = 0; f < NKS * 2; ++f) qf[f] = *(const bf16x8*)(qn + f * 1024); }
#pragma unroll
        for (int ks = 0; ks < 4; ++ks) { bf16x8 bv[2];
#pragma unroll
            for (int wt = 0; wt < 2; ++wt) bv[wt] = *(const LAS bf16x8*)(vl + (wt * 4 + ks) * 1024);
#pragma unroll
            for (int dkt = 0; dkt < NDT; ++dkt)
#pragma unroll
                for (int wt = 0; wt < 2; ++wt) S[dkt][wt] = MFMA32(kf[dkt * 4 + ks], bv[wt], S[dkt][wt]); }
        if (GLA) {
#pragma unroll
            for (int dkt = 0; dkt < NDT; ++dkt) { const float* dp = F.DECG + cb * GLA_DK + DKW * w8 + 32 * dkt + 4 * hh;
#pragma unroll
                for (int g4 = 0; g4 < 4; ++g4) { const f32x4 dv = *(const f32x4*)(dp + 8 * g4);
#pragma unroll
                    for (int e = 0; e < 4; ++e) { S[dkt][0][4 * g4 + e] *= dv[e]; S[dkt][1][4 * g4 + e] *= dv[e]; } } }
        } else {
#pragma unroll
            for (int wt = 0; wt < 2; ++wt)
#pragma unroll
                for (int i = 0; i < 16; ++i) S[0][wt][i] *= gam64;
        }
        *(LAS bf16x8*)(VL + ((n + 1) & 1) * 8192 + w8 * 1024 + lane * 16) = vnext;
        LDS_BAR();
        {
            const int t = w8 >> 1, i0 = 8 * (w8 & 1), wt = t >> 1, qt = t & 1; float val[8];
#pragma unroll
            for (int ii = 0; ii < 8; ++ii) { float sum = 0.f;
#pragma unroll
                for (int src = 0; src < 8; ++src) sum += RED[((src * 4 + t) * 16 + i0 + ii) * 64 + lane];
                val[ii] = sum; }
            const int row = chunk_row(b, n, 32 * qt + r);
            if (row >= 0 && (n > 0 || b == 0)) {
#pragma unroll
                for (int g = 0; g < 2; ++g) { const int w0 = 32 * wt + 8 * (2 * (w8 & 1) + g) + 4 * hh;
                    *(unsigned long long*)(Y + (size_t)row * DM + h * DV + 64 * sl + w0) = (unsigned long long)pkbf(val[4 * g], val[4 * g + 1]) | ((unsigned long long)pkbf(val[4 * g + 2], val[4 * g + 3]) << 32); } }
        }
        LDS_BAR();
    }
    __syncthreads();
}
__device__ __forceinline__ void p3_scan(Frame& F) {
    for (int i = blockIdx.x; i < 512; i += F.G) {
        const int w = i & 255, x = w & 7, idx = w >> 3;
        if (i < 256) scan_unit<true>(F, (2 * x + (idx >> 4)) * 16 + (idx & 15)); else scan_unit<false>(F, (4 * x + (idx >> 3)) * 8 + (idx & 7));
    }
}

__device__ __forceinline__ f32x4 ld4bf(const bf16* p) { const unsigned long long w = *(const unsigned long long*)p; return (f32x4){bf2f((bf16)w), bf2f((bf16)(w >> 16)), bf2f((bf16)(w >> 32)), bf2f((bf16)(w >> 48))}; }
__device__ __forceinline__ void p4_merge(Frame& F) {
    const int gw = blockIdx.x * NWAVES + F.wave, NGW = F.G * NWAVES, lane = F.lane;
    for (int m = gw; m < MROWS; m += NGW) {
#pragma unroll 1
        for (int hg = 0; hg < 4; ++hg) {
            f32x4 yr[4], yg[4];
#pragma unroll
            for (int j = 0; j < 4; ++j) { const int c = hg * 1024 + j * 256 + lane * 4; yr[j] = ld4bf(F.YR + (size_t)m * DM + c); yg[j] = ld4bf(F.YG + (size_t)m * DM + c); }
            float sg = 0.f, sa = 0.f, sb = 0.f;
#pragma unroll
            for (int j = 0; j < 4; ++j) { sg += (yg[j].x * yg[j].x + yg[j].y * yg[j].y) + (yg[j].z * yg[j].z + yg[j].w * yg[j].w);
                const float t = (yr[j].x + yr[j].y) + (yr[j].z + yr[j].w); if (j < 2) sa += t; else sb += t; }
            sg = wave_sum(sg); sa = wave_sum(sa); sb = wave_sum(sb);
            const float rg = 1.0f / sqrtf(sg * (1.0f / 1024.0f) + EPS), ma = sa * (1.0f / 512.0f), mb = sb * (1.0f / 512.0f);
            float qa = 0.f, qb = 0.f;
#pragma unroll
            for (int j = 0; j < 4; ++j) { const float mu = j < 2 ? ma : mb; yr[j] = yr[j] - mu;
                const float t = (yr[j].x * yr[j].x + yr[j].y * yr[j].y) + (yr[j].z * yr[j].z + yr[j].w * yr[j].w); if (j < 2) qa += t; else qb += t; }
            qa = wave_sum(qa); qb = wave_sum(qb);
            const float ra = 1.0f / sqrtf(qa * (1.0f / 512.0f) + EPS), rb = 1.0f / sqrtf(qb * (1.0f / 512.0f) + EPS);
#pragma unroll
            for (int j = 0; j < 4; ++j) { const int c = hg * 1024 + j * 256 + lane * 4; const float rr = j < 2 ? ra : rb;
                const f32x4 gr = *(const f32x4*)(F.ret_norm + c), gg = *(const f32x4*)(F.gla_norm + c);
                const f32x4 tr = ld4bf(F.GR + (size_t)m * DM + c), tg = ld4bf(F.GG + (size_t)m * DM + c);
                const f32x4 res = tr * (yr[j] * rr * gr) + tg * (yg[j] * rg * gg);
                *(unsigned long long*)(F.MRG + (size_t)m * DM + c) = (unsigned long long)pk2(res[0], res[1]) | ((unsigned long long)pk2(res[2], res[3]) << 32); }
        }
    }
}

__device__ __forceinline__ void p8_act(Frame& F) {
    constexpr int FB = DFF / 8;
    for (size_t i = (size_t)blockIdx.x * NTHR + F.tid; i < (size_t)MR * FB; i += (size_t)F.G * NTHR) {
        const int m = (int)(i / FB), f = (int)(i % FB) * 8, t = m & (SEQ - 1);
        const int r1 = t >= 1 ? m - 1 : MR + 15, r2 = t >= 2 ? m - 2 : MR + 14 + t;
        const v4u u0 = *(const v4u*)(F.UG + (size_t)m * NF + f), u1 = *(const v4u*)(F.UG + (size_t)r1 * NF + f), u2 = *(const v4u*)(F.UG + (size_t)r2 * NF + f), gt = *(const v4u*)(F.UG + (size_t)m * NF + DFF + f);
        float res[8];
#pragma unroll
        for (int e = 0; e < 8; ++e) { const unsigned sh = 16 * (e & 1);
            const float a0 = bf2f((bf16)(u0[e >> 1] >> sh)), a1 = bf2f((bf16)(u1[e >> 1] >> sh)), a2 = bf2f((bf16)(u2[e >> 1] >> sh)), gv = bf2f((bf16)(gt[e >> 1] >> sh));
            const float c = F.conv_b[f + e] + F.conv_w[f + e] * a2 + F.conv_w[DFF + f + e] * a1 + F.conv_w[2 * DFF + f + e] * a0;
            res[e] = silu(c) * gv; }
        v4u o; o.x = pk2(res[0], res[1]); o.y = pk2(res[2], res[3]); o.z = pk2(res[4], res[5]); o.w = pk2(res[6], res[7]);
        *(v4u*)(F.ACT + (size_t)m * DFF + f) = o;
    }
}

__device__ __forceinline__ void p10_final(Frame& F) {
    const int gw = blockIdx.x * NWAVES + F.wave, NGW = F.G * NWAVES;
    for (int m = gw; m < MR; m += NGW) {
        GAS f32x4* xr = (GAS f32x4*)(F.out + (size_t)m * DM) + F.lane; f32x4 v[16]; float ss = 0.f;
#pragma unroll
        for (int j = 0; j < 16; ++j) { v[j] = xr[64 * j]; ss += (v[j].x * v[j].x + v[j].y * v[j].y) + (v[j].z * v[j].z + v[j].w * v[j].w); }
        ss = wave_sum(ss); const float r = 1.0f / sqrtf(ss * (1.0f / DM) + EPS);
#pragma unroll
        for (int j = 0; j < 16; ++j) { const f32x4 g = *((const GAS f32x4*)F.final_norm + F.lane + 64 * j); xr[64 * j] = v[j] * r * g; }
    }
}

#ifndef REP_MASK
#define REP_MASK 0u
#endif
#define REPS(k) (((REP_MASK >> (k)) & 1u) ? 2 : 1)
struct Args { const void* in[16]; float* out; unsigned char* ws; int ph_lo, ph_hi, li, pad; };
__global__ void __launch_bounds__(NTHR, 2) fwd(Args args) {
    extern __shared__ __attribute__((aligned(16))) unsigned char lds[];
    Frame F;
    F.lds = (LAS unsigned char*)lds;
    F.MISC = (volatile LAS unsigned*)(F.lds + MISC_OFF);
    F.tid = threadIdx.x; F.lane = F.tid & 63; F.wave = __builtin_amdgcn_readfirstlane(F.tid >> 6); F.G = gridDim.x;
    unsigned char* ws = args.ws;
    F.ctl = (gu32*)(ws + WS_CTL);
    F.x = (const float*)args.in[0]; F.positions = (const int*)args.in[1]; F.meta = (const float*)args.in[2]; F.attn_norm = (const float*)args.in[3]; F.w_in = (const float*)args.in[4];
    F.w_gate_up = (const float*)args.in[5]; F.b_gate = (const float*)args.in[6]; F.ret_norm = (const float*)args.in[7]; F.gla_norm = (const float*)args.in[8]; F.w_out = (const float*)args.in[9];
    F.ffn_norm = (const float*)args.in[10]; F.w_ffn_in = (const float*)args.in[11]; F.conv_w = (const float*)args.in[12]; F.conv_b = (const float*)args.in[13]; F.w_ffn_out = (const float*)args.in[14];
    F.final_norm = (const float*)args.in[15]; F.out = args.out;
    F.W1t = (bf16*)(ws + WS_W1T); F.Wot = (bf16*)(ws + WS_WOT); F.Wft = (bf16*)(ws + WS_WFT); F.W2t = (bf16*)(ws + WS_W2T); F.XB = (bf16*)(ws + WS_XB);
    F.PROJ = (bf16*)(ws + WS_PROJ); F.UG = (bf16*)(ws + WS_UG); F.ACT = (bf16*)(ws + WS_ACT); F.MRG = (bf16*)(ws + WS_MRG); F.H1B = (bf16*)(ws + WS_H1B);
    F.RS1 = (float*)(ws + WS_RS1); F.SS2 = (float*)(F.ctl + CW_SS2); F.ZB = (float*)(ws + WS_ZB); F.COS = (float*)(ws + WS_COS); F.SIN = (float*)(ws + WS_SIN);
    F.YR = (bf16*)(ws + WS_YR); F.YG = (bf16*)(ws + WS_YG); F.GR = (bf16*)(ws + WS_GR); F.GG = (bf16*)(ws + WS_GG); F.H1 = (float*)(ws + WS_H1); F.DECG = (float*)(ws + WS_DECG);
    F.QFG = (bf16*)(ws + WS_QFG); F.KFG = (bf16*)(ws + WS_KFG); F.QFR = (bf16*)(ws + WS_QFR); F.KFR = (bf16*)(ws + WS_KFR);
    F.VFG = (bf16*)(ws + WS_VFG); F.VFR = (bf16*)(ws + WS_VFR); F.PFG = (bf16*)(ws + WS_PFG); F.PFR = (bf16*)(ws + WS_PFR);
    for (int u = F.tid; u < (LDS_BYTES - LDSCTL_OFF) / 4; u += NTHR) ((LAS unsigned*)(F.lds + LDSCTL_OFF))[u] = 0u;
    __syncthreads();
    XcdBarrier bar; bar.bar = (unsigned*)(F.ctl + CW_BAR); bar.x = 0; bar.st = nullptr;
    if (N_LAUNCHES != NPH) bar = xcd_barrier_post((unsigned*)(F.ctl + CW_BAR) + args.li * XCD_BAR_WORDS, F.MISC + 8);
#define GRID_BAR(seam) do { if (N_LAUNCHES == NPH) { if (F.tid == 0) __hip_atomic_store(F.ctl + CW_TMO, 0xBADBA0u | (unsigned)(seam), RLX_AGENT); } else { xcd_barrier(bar); } } while (0)
    const int lo = args.ph_lo, hi = args.ph_hi;
#define IN(k) (lo <= (k) && (k) < hi)
#define BOTH(k) (IN(k) && IN((k) + 1))
#define PH1() do { z_proj(F); meta_proj(F); \
        { pg8::Gemm g{F.XB, F.W1t, MR, C_V, DM}; pg8::StaticOrder S; S.init(MR, C_V, F.G, (int)blockIdx.x); pg8::EpiG1 E{F.PROJ, F.RS1, F.ZB, F.GR, F.GG}; \
          pg8::gemm_phase<pg8::EpiG1, pg8::StaticOrder, PG8_ALIGN, PG8_SP2>(F.lds + RING_OFF, g, S, E); } \
        { pg8::Gemm g{F.XB, F.W1t + (size_t)C_V * DM, MR, 8192, DM}; pg8::StaticOrder S; S.init(MR, 8192, F.G, (int)blockIdx.x); pg8::EpiV E{(unsigned char*)F.VFR, (unsigned char*)F.VFG, F.RS1}; \
          pg8::gemm_phase<pg8::EpiV, pg8::StaticOrder, PG8_ALIGN, PG8_SP2, false>(F.lds + RING_OFF, g, S, E); } } while (0)
#define PH5() do { meta_wout(F); pg8::Gemm g{F.MRG, F.Wot, MR, DM, DM}; pg8::StaticOrder S; S.init(MR, DM, F.G, (int)blockIdx.x); pg8::EpiResX E{F.x, F.meta, F.H1, F.H1B, F.SS2, DM, MR, NMETA}; \
        pg8::gemm_phase<pg8::EpiResX, pg8::StaticOrder, PG8_ALIGN, PG8_SP2>(F.lds + RING_OFF, g, S, E); } while (0)
#define PH7() do { meta_up(F); pg8::Gemm g{F.H1B, F.Wft, MR, NF, DM}; pg8::StaticOrder S; S.init(MR, NF, F.G, (int)blockIdx.x); pg8::EpiScaleBf16 E{F.UG, NF, F.SS2}; \
        pg8::gemm_phase<pg8::EpiScaleBf16, pg8::StaticOrder, PG8_ALIGN, PG8_SP2>(F.lds + RING_OFF, g, S, E); } while (0)
#define PH9() do { pg8::Gemm g{F.ACT, F.W2t, MR, DM, DFF}; pg8::StaticOrder S; S.init(MR, DM, F.G, (int)blockIdx.x); pg8::EpiResF32 E{F.H1, F.out, DM}; \
        pg8::gemm_phase<pg8::EpiResF32, pg8::StaticOrder, PG8_ALIGN, PG8_SP2>(F.lds + RING_OFF, g, S, E); } while (0)
#define RUN(k, body) do { if (IN(k)) { body; if (REPS(k) == 2) { __syncthreads(); body; } if (BOTH(k)) GRID_BAR(k); } } while (0)
    RUN(0, p0_prologue(F));
    RUN(1, PH1());
    RUN(2, p2_prep(F));
    RUN(3, p3_scan(F));
    RUN(4, p4_merge(F));
    RUN(5, PH5());
    RUN(7, PH7());
    RUN(8, p8_act(F));
    RUN(9, PH9());
    if (IN(10)) { p10_final(F); }
#undef IN
#undef BOTH
}

extern "C" void kernel_launch(void* const* d_in, const int* in_sizes, int n_in, void* d_out, int out_size, void* d_ws, size_t ws_size, hipStream_t stream) {
    static int grid = 0;
    if (grid == 0) {
        if (n_in != 16 || in_sizes[0] != MR * DM || out_size != MR * DM || ws_size < WS_END) {
            fprintf(stderr, "kernel_launch: shape/workspace mismatch: n_in %d in0 %d out %d ws %zu (need %zu); nothing launched\n", n_in, n_in > 0 ? in_sizes[0] : -1, out_size, ws_size, (size_t)WS_END); grid = -1; return; }
        int dev = 0, cus = 0, per_cu = 0;
        if (hipGetDevice(&dev) != hipSuccess || hipDeviceGetAttribute(&cus, hipDeviceAttributeMultiprocessorCount, dev) != hipSuccess) { fprintf(stderr, "kernel_launch: device query failed\n"); grid = -1; return; }
        if (hipFuncSetAttribute((const void*)fwd, hipFuncAttributeMaxDynamicSharedMemorySize, LDS_BYTES) != hipSuccess) { fprintf(stderr, "kernel_launch: hipFuncSetAttribute failed\n"); grid = -1; return; }
        if (hipOccupancyMaxActiveBlocksPerMultiprocessor(&per_cu, (const void*)fwd, NTHR, LDS_BYTES) != hipSuccess || per_cu < 1)
            fprintf(stderr, "kernel_launch: note: occupancy query reports %d workgroups per CU\n", per_cu);
        (void)hipGetLastError();
        grid = cus;
    }
    if (grid < 0) return;
    if (hipMemsetAsync((char*)d_ws + WS_CTL, 0, CTL_ZERO_BYTES, stream) != hipSuccess) { fprintf(stderr, "kernel_launch: memset failed\n"); return; }
    Args a{};
    for (int i = 0; i < 16; ++i) a.in[i] = d_in[i];
    a.out = (float*)d_out; a.ws = (unsigned char*)d_ws;
    for (int li = 0; li < N_LAUNCHES; ++li) {
        a.ph_lo = (N_LAUNCHES == NPH) ? li : 0; a.ph_hi = (N_LAUNCHES == NPH) ? li + 1 : NPH; a.li = (N_LAUNCHES == NPH) ? 0 : li;
        hipLaunchKernelGGL(fwd, dim3(grid), dim3(NTHR), LDS_BYTES, stream, a);
        const hipError_t le = hipPeekAtLastError();
        if (le != hipSuccess) { fprintf(stderr, "kernel_launch: launch %d failed: %s\n", li, hipGetErrorName(le)); break; }
    }
}
```

```cpp
#include <hip/hip_runtime.h>
#include <cstdio>
#include <cstdint>
namespace pg8 {
#define PG8_LAS __attribute__((address_space(3)))
typedef unsigned short bf16_t;
typedef short bf16x8 __attribute__((ext_vector_type(8)));
typedef float f32x4 __attribute__((ext_vector_type(4)));
typedef unsigned u32x4 __attribute__((ext_vector_type(4)));
constexpr int BM = 256, BK = 64, HALF = 128, HTB = HALF * BK * 2  , STAGE_BYTES = 8 * HTB, NXCD = 8, WGM = 8;

__host__ __device__ __forceinline__ int lds_byte(int r, int c) { const int st = (r >> 4) * 2 + (c >> 5), rr = r & 15, cc = c & 31, ob = rr * 64 + cc * 2; return st * 1024 + (ob ^ (((ob >> 9) & 1) << 5)); }
__host__ __device__ __forceinline__ void stage_rc(int b, int& R, int& C) { const int st = b / 1024, sb = b % 1024, swz = sb ^ (((sb >> 9) & 1) << 5); R = (st >> 1) * 16 + swz / 64; C = (st & 1) * 32 + (swz % 64) / 2; }
__host__ __device__ __forceinline__ int perm32(int rho) { const int n = rho >> 4, i = rho & 15; return 8 * (i >> 2) + 4 * n + (i & 3); }

struct Unit { int pm, pn; };
struct Gemm { const bf16_t* A; const bf16_t* Bt; int M, N, K; };

struct StaticOrder {
    int nM, nN, nwg, G, c;
    __host__ __device__ void init(int M, int N, int G_, int c_) { nM = M / BM; nN = N / BM; nwg = nM * nN; G = G_; c = c_; }
    __host__ __device__ bool next(int i, Unit& u) const {
        const long L = (long)i * G + c; if (L >= nwg) return false;
        int wgid = (int)L; { const int q = nwg / NXCD, r = nwg % NXCD, xcd = wgid % NXCD, off = wgid / NXCD; wgid = (xcd < r ? xcd * (q + 1) : r * (q + 1) + (xcd - r) * q) + off; }
        const int nig = WGM * nN, gid = wgid / nig, fm = gid * WGM, gsz = (nM - fm) < WGM ? (nM - fm) : WGM;
        u.pm = fm + ((wgid % nig) % gsz); u.pn = (wgid % nig) / gsz; return true;
    }
    __device__ __forceinline__ void a_ready(const Unit&) const {}
    __device__ __forceinline__ void done(const Unit&) const {}
};
__device__ __forceinline__ unsigned cvt_pk_bf16(float lo, float hi) { unsigned r; asm volatile("v_cvt_pk_bf16_f32 %0, %1, %2" : "=v"(r) : "v"(lo), "v"(hi)); return r; }
template <class Epi, class Sched, bool ALIGN_EPI = false, bool SP2 = false, bool TR = true  >
__device__ __forceinline__ void gemm_phase(PG8_LAS unsigned char* lds, const Gemm g, const Sched& S, const Epi& E) {
    const int tid = threadIdx.x, wid = __builtin_amdgcn_readfirstlane(tid >> 6), lane = tid & 63, wr = wid >> 2, wc = wid & 3, fr = lane & 15, fq = lane >> 4;
    const int K = g.K, nt = K / BK;
    unsigned voffA[2], voffB[2];
#pragma unroll
    for (int i = 0; i < 2; ++i) { int R, C; stage_rc(tid * 16 + i * 8192, R, C); const int Rb = Epi::PERM ? ((R & ~31) + perm32(R & 31)) : R;
        voffA[i] = (unsigned)(R * K + C) * 2u; voffB[i] = (unsigned)(Rb * K + C) * 2u; }
    const size_t kstep = (size_t)(BK * 2);
    const size_t hstep = (size_t)HALF * K * 2;
    const size_t tstep = 2 * hstep;
    const unsigned ldsw = (unsigned)wid * 1024u;
    const int aoff = lds_byte(wr * 64 + fr, fq * 8), boff = lds_byte(wc * 32 + fr, fq * 8);
#define PG8_SA(b, h) (((b) * 2 + (h)) * HTB)
#define PG8_SB(b, h) ((4 + (b) * 2 + (h)) * HTB)
#define PG8_STAGE(bufoff, gbase, voff) do { _Pragma("unroll") for (int _i = 0; _i < 2; ++_i) \
        __builtin_amdgcn_global_load_lds((const unsigned*)((const char*)(gbase) + (voff)[_i]), (PG8_LAS unsigned*)(lds + (bufoff) + ldsw + _i * 8192), 16, 0, 0); } while (0)
#define PG8_LDA(dst, b, h) do { _Pragma("unroll") for (int m = 0; m < 4; ++m) _Pragma("unroll") for (int k = 0; k < 2; ++k) dst[m][k] = *(const PG8_LAS bf16x8*)(lds + PG8_SA(b, h) + aoff + m * 2048 + k * 1024); } while (0)
#define PG8_LDB(dst, b, h) do { _Pragma("unroll") for (int n = 0; n < 2; ++n) _Pragma("unroll") for (int k = 0; k < 2; ++k) dst[n][k] = *(const PG8_LAS bf16x8*)(lds + PG8_SB(b, h) + boff + n * 2048 + k * 1024); } while (0)
#define PG8_MMA(ai, bj, At, Bt) do { __builtin_amdgcn_s_setprio(1); _Pragma("unroll") for (int m = 0; m < 4; ++m) _Pragma("unroll") for (int n = 0; n < 2; ++n) _Pragma("unroll") for (int k = 0; k < 2; ++k) \
        acc[ai][bj][m][n] = TR ? __builtin_amdgcn_mfma_f32_16x16x32_bf16(Bt[n][k], At[m][k], acc[ai][bj][m][n], 0, 0, 0) : __builtin_amdgcn_mfma_f32_16x16x32_bf16(At[m][k], Bt[n][k], acc[ai][bj][m][n], 0, 0, 0); __builtin_amdgcn_s_setprio(0); } while (0)
#define PG8_WAIT_V(n) asm volatile("s_waitcnt vmcnt(" #n ")" ::: "memory")
#define PG8_WAIT_L(n) asm volatile("s_waitcnt lgkmcnt(" #n ")" ::: "memory")
#define PG8_BAR __builtin_amdgcn_s_barrier()
#define PG8_SCHED __builtin_amdgcn_sched_barrier(0)
    Unit cur, nxt; int ui = 0;
    if (!S.next(0, cur)) return;
    f32x4 acc[2][2][4][2];
#pragma unroll
    for (int a = 0; a < 2; ++a)
#pragma unroll
        for (int b = 0; b < 2; ++b)
#pragma unroll
            for (int m = 0; m < 4; ++m)
#pragma unroll
                for (int n = 0; n < 2; ++n) acc[a][b][m][n] = (f32x4){0.f, 0.f, 0.f, 0.f};
    bf16x8 At[4][2], B0[2][2], B1[2][2];
    const char* cA = (const char*)g.A + (size_t)cur.pm * tstep; const char* cB = (const char*)g.Bt + (size_t)cur.pn * tstep;
    S.a_ready(cur);
    if constexpr (SP2) {
        PG8_STAGE(PG8_SB(0, 0), cB, voffB); PG8_STAGE(PG8_SB(0, 1), cB + hstep, voffB); PG8_STAGE(PG8_SA(0, 0), cA, voffA); PG8_STAGE(PG8_SA(0, 1), cA + hstep, voffA);
        if (wr == 1) PG8_BAR;
        PG8_WAIT_V(2); PG8_BAR;
        PG8_STAGE(PG8_SB(1, 0), cB + kstep, voffB); PG8_STAGE(PG8_SA(1, 0), cA + kstep, voffA); PG8_STAGE(PG8_SB(1, 1), cB + hstep + kstep, voffB);
        PG8_WAIT_V(6); PG8_BAR;
    } else {
        PG8_STAGE(PG8_SB(0, 0), cB, voffB); PG8_STAGE(PG8_SA(0, 0), cA, voffA); PG8_STAGE(PG8_SB(0, 1), cB + hstep, voffB); PG8_STAGE(PG8_SA(0, 1), cA + hstep, voffA);
        if (wr == 1) PG8_BAR;
        PG8_WAIT_V(4); PG8_BAR;
        PG8_STAGE(PG8_SB(1, 0), cB + kstep, voffB); PG8_STAGE(PG8_SA(1, 0), cA + kstep, voffA); PG8_STAGE(PG8_SB(1, 1), cB + hstep + kstep, voffB);
        PG8_WAIT_V(6); PG8_BAR;
    }
    for (;;) {
        const bool has_next = S.next(ui + 1, nxt);
        const char* nA = has_next ? (const char*)g.A + (size_t)nxt.pm * tstep : cA; const char* nB = has_next ? (const char*)g.Bt + (size_t)nxt.pn * tstep : cB;
        for (int t = 0; t < nt; t += 2) {
            const bool last = (t == nt - 2);
            const char* a1 = cA + (size_t)(t + 1) * kstep;
            const char* a2 = last ? nA : cA + (size_t)(t + 2) * kstep; const char* b2 = last ? nB : cB + (size_t)(t + 2) * kstep;
            const char* a3 = a2 + kstep; const char* b3 = b2 + kstep;
            if (last && has_next) S.a_ready(nxt);
            if constexpr (SP2) {
            PG8_LDB(B0, 0, 0); PG8_LDB(B1, 0, 1); PG8_SCHED; PG8_LDA(At, 0, 0); PG8_STAGE(PG8_SA(1, 1), a1 + hstep, voffA);
            PG8_WAIT_V(8); PG8_WAIT_L(0); PG8_BAR; PG8_MMA(0, 0, At, B0); PG8_MMA(0, 1, At, B1); PG8_BAR; PG8_SCHED;
            PG8_LDA(At, 0, 1); PG8_STAGE(PG8_SB(0, 0), b2, voffB); PG8_STAGE(PG8_SB(0, 1), b2 + hstep, voffB); PG8_STAGE(PG8_SA(0, 0), a2, voffA);
            PG8_WAIT_V(8); PG8_WAIT_L(0); PG8_BAR; PG8_MMA(1, 0, At, B0); PG8_MMA(1, 1, At, B1); PG8_BAR; PG8_SCHED;
            PG8_LDB(B0, 1, 0); PG8_LDB(B1, 1, 1); PG8_SCHED; PG8_LDA(At, 1, 0); PG8_STAGE(PG8_SA(0, 1), a2 + hstep, voffA);
            PG8_WAIT_V(8); PG8_WAIT_L(0); PG8_BAR; PG8_MMA(0, 0, At, B0); PG8_MMA(0, 1, At, B1); PG8_BAR; PG8_SCHED;
            PG8_LDA(At, 1, 1); PG8_STAGE(PG8_SB(1, 0), b3, voffB); PG8_STAGE(PG8_SB(1, 1), b3 + hstep, voffB); PG8_STAGE(PG8_SA(1, 0), a3, voffA);
            PG8_WAIT_V(8); PG8_WAIT_L(0); PG8_BAR; PG8_MMA(1, 0, At, B0); PG8_MMA(1, 1, At, B1); PG8_BAR; PG8_SCHED;
            } else {
            PG8_LDB(B0, 0, 0); PG8_SCHED; PG8_LDA(At, 0, 0); PG8_STAGE(PG8_SA(1, 1), a1 + hstep, voffA);
            PG8_WAIT_L(8); PG8_BAR; PG8_WAIT_L(0); PG8_MMA(0, 0, At, B0); PG8_BAR; PG8_SCHED;
            PG8_LDB(B1, 0, 1); PG8_STAGE(PG8_SB(0, 0), b2, voffB);
            PG8_BAR; PG8_WAIT_L(0); PG8_MMA(0, 1, At, B1); PG8_BAR;
            PG8_LDA(At, 0, 1); PG8_STAGE(PG8_SA(0, 0), a2, voffA);
            PG8_BAR; PG8_WAIT_L(0); PG8_MMA(1, 0, At, B0); PG8_BAR; PG8_SCHED;
            PG8_STAGE(PG8_SB(0, 1), b2 + hstep, voffB);
            PG8_WAIT_V(6); PG8_BAR; PG8_MMA(1, 1, At, B1); PG8_BAR;
            PG8_LDB(B0, 1, 0); PG8_SCHED; PG8_LDA(At, 1, 0); PG8_STAGE(PG8_SA(0, 1), a2 + hstep, voffA);
            PG8_WAIT_L(8); PG8_BAR; PG8_WAIT_L(0); PG8_MMA(0, 0, At, B0); PG8_BAR; PG8_SCHED;
            PG8_LDB(B1, 1, 1); PG8_STAGE(PG8_SB(1, 0), b3, voffB);
            PG8_BAR; PG8_WAIT_L(0); PG8_MMA(0, 1, At, B1); PG8_BAR;
            PG8_LDA(At, 1, 1); PG8_STAGE(PG8_SA(1, 0), a3, voffA);
            PG8_BAR; PG8_WAIT_L(0); PG8_MMA(1, 0, At, B0); PG8_BAR; PG8_SCHED;
            PG8_STAGE(PG8_SB(1, 1), b3 + hstep, voffB);
            PG8_WAIT_V(6); PG8_BAR; PG8_MMA(1, 1, At, B1); PG8_BAR;
            }
        }
        if constexpr (ALIGN_EPI) { if (wr == 0) PG8_BAR; }
        if constexpr (!Epi::AFTER_DRAIN) { E(acc, cur, wr, wc, fr, fq); S.done(cur); }
        if (!has_next) break;
#pragma unroll
        for (int a = 0; a < 2; ++a)
#pragma unroll
            for (int b = 0; b < 2; ++b)
#pragma unroll
                for (int m = 0; m < 4; ++m)
#pragma unroll
                    for (int n = 0; n < 2; ++n) acc[a][b][m][n] = (f32x4){0.f, 0.f, 0.f, 0.f};
        cur = nxt; cA = nA; cB = nB; ++ui;
        if constexpr (ALIGN_EPI) { if (wr == 1) PG8_BAR; }
    }
    PG8_WAIT_V(0);
    if constexpr (!ALIGN_EPI) { if (wr == 0) PG8_BAR; }
    PG8_BAR;
    if constexpr (Epi::AFTER_DRAIN) { E.fused(acc, cur, wr, wc, fr, fq, lds, wid, lane); S.done(cur); }
#undef PG8_SA
#undef PG8_SB
#undef PG8_STAGE
#undef PG8_LDA
#undef PG8_LDB
#undef PG8_MMA
#undef PG8_WAIT_V
#undef PG8_WAIT_L
#undef PG8_BAR
#undef PG8_SCHED
}
}
#define GAS __attribute__((address_space(1)))
#define LAS __attribute__((address_space(3)))
typedef unsigned short bf16;
typedef unsigned v4u __attribute__((ext_vector_type(4)));
typedef float f32x4 __attribute__((ext_vector_type(4)));
typedef short bf16x8 __attribute__((ext_vector_type(8)));
typedef GAS unsigned gu32;
typedef GAS unsigned long long gu64;
#define RLX_AGENT __ATOMIC_RELAXED, __HIP_MEMORY_SCOPE_AGENT
#define LDS_WAIT() asm volatile("s_waitcnt lgkmcnt(0)" ::: "memory")
#define VM_WAIT() asm volatile("s_waitcnt vmcnt(0)" ::: "memory")
__device__ __forceinline__ unsigned long long rt() { return __builtin_amdgcn_s_memrealtime(); }
__device__ __forceinline__ unsigned f2bf(float f) { unsigned u = __builtin_bit_cast(unsigned, f); return (u + 0x7fffu + ((u >> 16) & 1u)) >> 16; }
__device__ __forceinline__ unsigned pk2(float lo, float hi) { return f2bf(lo) | (f2bf(hi) << 16); }
#define XB_TMO      128
#define XB_XCNT(j)  (256  + 64 * (j))
#define XB_XSUB(j)  (1280 + 64 * (j))
#define XB_XGEN(j)  (2304 + 64 * (j))
#define XB_TOP      3328
#define XB_TOPGEN   3392
#define XCD_BAR_WORDS 3456
#define XB_SPIN_CAP (1u << 18)

__device__ __forceinline__ unsigned xb_ld(unsigned* p)              { return __hip_atomic_load(p, __ATOMIC_RELAXED, __HIP_MEMORY_SCOPE_AGENT); }
__device__ __forceinline__ unsigned xb_add(unsigned* p, unsigned v) { return __hip_atomic_fetch_add(p, v, __ATOMIC_RELAXED, __HIP_MEMORY_SCOPE_AGENT); }
__device__ __forceinline__ unsigned xb_xcc_id() { return (unsigned)__builtin_amdgcn_s_getreg((3 << 11) | 20) & 0xFu; }
#define XB_SPIN(cond, bar) do { unsigned _sp = 0; while (cond) { __builtin_amdgcn_s_sleep(1); \
    if ((++_sp & 255u) == 0u) { if (xb_ld(&(bar)[XB_TMO])) break; if (_sp > XB_SPIN_CAP) { atomicAdd(&(bar)[XB_TMO], 1u); break; } } } } while (0)

struct XcdBarrier {
    unsigned* bar; unsigned x;
    volatile LAS unsigned* st;
};

__device__ __forceinline__ XcdBarrier xcd_barrier_post(unsigned* bar, volatile LAS unsigned* st) {
    XcdBarrier b; b.bar = bar; b.x = xb_xcc_id(); b.st = st;
    if (threadIdx.x == 0) (void)xb_add(&bar[XB_XCNT(b.x)], 1u);
    return b;
}
__device__ __forceinline__ void xcd_barrier_complete(unsigned* bar, unsigned x, unsigned& nloc, unsigned& nx) {
    const unsigned G = gridDim.x * gridDim.y * gridDim.z;
    unsigned sum, cnt, mine, sp = 0u;
    for (;;) {
        sum = 0u; cnt = 0u; mine = 0u;
#pragma unroll
        for (unsigned j = 0; j < 16; ++j) { const unsigned c = xb_ld(&bar[XB_XCNT(j)]); sum += c; cnt += (c > 0u) ? 1u : 0u; mine = (j == x) ? c : mine; }
        if (sum == G) break;
        __builtin_amdgcn_s_sleep(1);
        if ((++sp & 255u) == 0u) { if (xb_ld(&bar[XB_TMO])) break; if (sp > XB_SPIN_CAP) { atomicAdd(&bar[XB_TMO], 1u); break; } }
    }
    nloc = mine > 0u ? mine : 1u; nx = cnt > 0u ? cnt : 1u;
}

__device__ __forceinline__ void xcd_barrier(const XcdBarrier& b) {
    asm volatile("s_waitcnt vmcnt(0)" ::: "memory");
    __syncthreads();
    if (threadIdx.x == 0) {
        unsigned* bar = b.bar;
        __builtin_amdgcn_s_waitcnt(0);
        unsigned nloc = b.st[0], nx = b.st[1];
        if (nloc == 0u) { xcd_barrier_complete(bar, b.x, nloc, nx); b.st[0] = nloc; b.st[1] = nx; }
        const unsigned old = xb_add(&bar[XB_XSUB(b.x)], 1u);
        const unsigned gen = old / nloc;
        if (old + 1u == (gen + 1u) * nloc) {
            __builtin_amdgcn_fence(__ATOMIC_RELEASE, "agent");
            asm volatile("s_waitcnt vmcnt(0)" ::: "memory");
            const unsigned og = xb_add(&bar[XB_TOP], 1u);
            const unsigned tg = og / nx;
            if (og + 1u == (tg + 1u) * nx) xb_add(&bar[XB_TOPGEN], 1u);
            else XB_SPIN(xb_ld(&bar[XB_TOPGEN]) == tg, bar);
            __builtin_amdgcn_fence(__ATOMIC_ACQUIRE, "agent");
            xb_add(&bar[XB_XGEN(b.x)], 1u);
            asm volatile("s_waitcnt vmcnt(0)" ::: "memory");
        } else {
            XB_SPIN(xb_ld(&bar[XB_XGEN(b.x)]) == gen, bar);
            __builtin_amdgcn_fence(__ATOMIC_ACQUIRE, "agent");
            asm volatile("s_waitcnt vmcnt(0)" ::: "memory");
        }
    }
    __syncthreads();
}
#define REP_MASK 0u
#ifndef PG8_SP2
#define PG8_SP2 true
#endif
#ifndef PG8_ALIGN
#define PG8_ALIGN true
#endif
constexpr int NWAVES = 8, NTHR = NWAVES * 64;
constexpr int BATCH = 4, SEQ = 2048, DM = 4096, NMETA = 16;
constexpr int MR = BATCH * SEQ;
constexpr int MROWS = MR + NMETA;
constexpr int MT = 8448;
constexpr int NIN = 32784;
constexpr int N1 = 33024;
constexpr int DFF = 11008, NF = 2 * DFF;
constexpr int RET_H = 8, RET_DK = 256, RET_DV = 512, GLA_H = 4, GLA_DK = 512, GLA_DV = 1024, GLA_RANK = 16;
constexpr float EPS = 1e-6f;
constexpr int C_QR = 0, C_QG = 2048, C_KG = 4096, C_GR = 6144, C_GG = 14336, C_B = 22528, C_KR = 22528, C_V = 24576, C_Z = 32768, LDP = 4096, P_QG = 0, P_KG = 2048;
constexpr int NPH = 11;
#ifndef MK_N_LAUNCHES
#define MK_N_LAUNCHES 1
#endif
constexpr int N_LAUNCHES = MK_N_LAUNCHES;

constexpr size_t al256(size_t x) { return (x + 255) & ~(size_t)255; }
constexpr size_t WS_CTL = 0, CTL_ZERO_BYTES = 1u << 20;
constexpr size_t WS_W1T = WS_CTL + CTL_ZERO_BYTES;
constexpr size_t WS_WOT = WS_W1T + al256((size_t)N1 * DM * 2);
constexpr size_t WS_WFT = WS_WOT + al256((size_t)DM * DM * 2);
constexpr size_t WS_W2T = WS_WFT + al256((size_t)NF * DM * 2);
constexpr size_t WS_XB  = WS_W2T + al256((size_t)DM * DFF * 2);
constexpr size_t WS_RS1 = WS_XB + al256((size_t)MT * DM * 2);
constexpr size_t WS_RS2 = WS_RS1 + al256((size_t)MT * 4);
constexpr size_t WS_ZB  = WS_RS2 + al256((size_t)MT * 4);
constexpr size_t WS_COS = WS_ZB + al256((size_t)MT * 16 * 4);
constexpr size_t WS_SIN = WS_COS + al256((size_t)MROWS * 128 * 4);
constexpr size_t WS_COST = WS_SIN + al256((size_t)MROWS * 128 * 4);
constexpr size_t WS_SINT = WS_COST + (size_t)128 * MT * 4;
constexpr size_t WS_PROJ = WS_SINT + (size_t)128 * MT * 4;
constexpr size_t WS_UG  = WS_PROJ;
constexpr size_t WS_ACT = WS_UG + al256((size_t)MT * NF * 2);
constexpr size_t WS_YR  = WS_PROJ + al256((size_t)MT * N1 * 2);
constexpr size_t WS_YG  = WS_YR + al256((size_t)MROWS * DM * 2);
constexpr size_t WS_GR  = WS_YG + al256((size_t)MROWS * DM * 2);
constexpr size_t WS_GG  = WS_GR + al256((size_t)MT * DM * 2);
constexpr size_t WS_MRG = WS_GG + al256((size_t)MT * DM * 2);
constexpr size_t WS_H1  = WS_MRG + al256((size_t)MT * DM * 2);
constexpr size_t WS_H1B = WS_H1 + al256((size_t)MT * DM * 4);
constexpr size_t WS_QFG = WS_H1B + al256((size_t)MT * DM * 2);
constexpr size_t WS_KFG = WS_QFG + (size_t)4 * 4 * 33 * 65536;
constexpr size_t WS_QFR = WS_KFG + (size_t)4 * 4 * 33 * 65536;
constexpr size_t WS_KFR = WS_QFR + (size_t)4 * 8 * 33 * 32768;
constexpr size_t WS_VFG = WS_KFR + (size_t)4 * 8 * 33 * 32768;
constexpr size_t WS_VFR = WS_VFG + (size_t)4 * 33 * 64 * 8192;
constexpr size_t WS_PFG = WS_VFR + (size_t)4 * 33 * 64 * 8192;
constexpr size_t WS_PFR = WS_PFG + (size_t)4 * 4 * 33 * 8192;
constexpr size_t WS_DECG = WS_PFR + (size_t)4 * 8 * 33 * 8192;
constexpr size_t WS_UPH = WS_DECG + (size_t)4 * 4 * 33 * 512 * 4;
constexpr size_t WS_PARTC = WS_UPH + (size_t)32 * 2 * DFF * 4;
constexpr size_t WS_PARTG = WS_PARTC + (size_t)32 * 2 * DFF * 4;
constexpr size_t WS_UPM = WS_PARTG + (size_t)32 * 2 * DFF * 4;
constexpr size_t WS_END = WS_UPM + (size_t)2 * DFF * 4;
static_assert(WS_ACT + (size_t)MR * DFF * 2 <= WS_YR, "UG | ACT overlay fits inside PROJ");
static_assert(WS_END <= (size_t)4 * 4096 * NIN * 4, "workspace map fits 4 x the largest tensor");
constexpr int CW_TMO = 0, CW_CODE = 1, CW_BAR = 4096, CW_SS2 = 8192;

constexpr int RING_OFF = 0, RING_BYTES = 131072;
constexpr int LDS_BYTES = 163840;
constexpr int LDSCTL_OFF = LDS_BYTES - 1024, MISC_OFF = LDSCTL_OFF + 320;
static_assert(MISC_OFF + 128 <= LDS_BYTES, "LDS map");

__device__ __forceinline__ float bf2f(bf16 v) { return __builtin_bit_cast(float, (unsigned)v << 16); }
__device__ __forceinline__ float wave_sum(float v) {
#pragma unroll
    for (int o = 1; o < 64; o <<= 1) v += __shfl_xor(v, o);
    return v;
}
__device__ __forceinline__ float sigm(float x) { return 1.f / (1.f + __expf(-x)); }
__device__ __forceinline__ float silu(float x) { return x / (1.f + __expf(-x)); }
__device__ __forceinline__ float logsig(float x) { return fminf(x, 0.f) - __logf(1.0f + __expf(-fabsf(x))); }

typedef float f32x16 __attribute__((ext_vector_type(16)));
#define MFMA32(a, b, c) __builtin_amdgcn_mfma_f32_32x32x16_bf16((a), (b), (c), 0, 0, 0)
__device__ __forceinline__ unsigned pkbf(float lo, float hi) { typedef __bf16 b2 __attribute__((ext_vector_type(2))); typedef float f2 __attribute__((ext_vector_type(2))); return __builtin_bit_cast(unsigned, __builtin_convertvector((f2){lo, hi}, b2)); }
__device__ __forceinline__ bf16 f2b(float x) { return (bf16)(pkbf(x, 0.f) & 0xffffu); }
__device__ __forceinline__ int chunk_row(int b, int n, int i) { return n == 0 ? (i < 48 ? -1 : MR + i - 48) : b * SEQ + 64 * (n - 1) + i; }

struct Frame {
    LAS unsigned char* lds;
    volatile LAS unsigned* MISC;
    gu32* ctl;
    int tid, lane, wave, G;
    const float *x, *meta, *attn_norm, *w_in, *w_gate_up, *b_gate, *ret_norm, *gla_norm, *w_out, *ffn_norm, *w_ffn_in, *conv_w, *conv_b, *w_ffn_out, *final_norm;
    const int* positions;
    float* out;
    bf16 *W1t, *Wot, *Wft, *W2t, *XB, *PROJ, *UG, *ACT, *MRG, *H1B;
    float *RS1, *SS2, *ZB, *COS, *SIN, *COST, *SINT, *H1, *DECG, *UPH, *PARTC, *PARTG, *UPM;
    bf16 *YR, *YG, *GR, *GG, *QFG, *KFG, *QFR, *KFR, *VFG, *VFR, *PFG, *PFR;
};

namespace pg8 {
__device__ __forceinline__ float gate2(float o, float m) { return o * __builtin_amdgcn_rcpf((1.0f + __expf(-o)) * (1.0f + __expf(-m))); }
typedef unsigned long long u64_t;
__device__ __forceinline__ u64_t pk4(const f32x4& v) { return (u64_t)cvt_pk_bf16(v[0], v[1]) | ((u64_t)cvt_pk_bf16(v[2], v[3]) << 32); }
struct EpiA {
    static constexpr bool PERM = true, AFTER_DRAIN = false;
    bf16_t* O; const float* rs; const float* cs; const float* sn; unsigned char* QFR; bf16_t* GR; bf16_t* GG;
    __device__ __forceinline__ void operator()(const f32x4 (&acc)[2][2][4][2], const Unit& u, int wr, int wc, int fr, int fq) const {
        const int row0 = u.pm * BM + wr * 64 + fr;
        if (u.pn < 8) {
            const int h = u.pn, b = u.pm >> 3; const float l2g = __log2f(1.0f - exp2f(-5.0f - (float)h));
#pragma unroll
            for (int ai = 0; ai < 2; ++ai) { const size_t cb = (size_t)(b * 8 + h) * 33 + 1 + 4 * (u.pm & 7) + 2 * ai + wr;
                unsigned char* qb = QFR + (cb * 8 + wc) * 4096 + (fq >> 1) * 2048 + fr * 16 + 8 * (fq & 1);
#pragma unroll
                for (int m = 0; m < 4; ++m) { const int row = row0 + ai * HALF + m * 16; const float dq = exp2f((float)(16 * m + fr + 1) * l2g) * rs[row];
                    const float* cp = cs + (size_t)row * 128 + wc * 32 + 8 * fq; const float* sp = sn + (size_t)row * 128 + wc * 32 + 8 * fq;
#pragma unroll
                    for (int n = 0; n < 2; ++n) { const f32x4 c = *(const f32x4*)(cp + 4 * n), s4 = *(const f32x4*)(sp + 4 * n), x1 = acc[ai][0][m][n], x2 = acc[ai][1][m][n];
                        const f32x4 o1 = (x1 * c - x2 * s4) * dq, o2 = (x2 * c + x1 * s4) * dq;
                        unsigned char* d = qb + (m >> 1) * 1024 + (16 * (m & 1) + 32 * n) * 16;
                        *(u64_t*)d = pk4(o1); *(u64_t*)(d + 4 * 4096) = pk4(o2); }
                    asm volatile("" ::: "memory"); } }
        } else if (u.pn < 24) {
            const int col0 = (u.pn - 8) * BM + wc * 32 + 8 * fq;
#pragma unroll
            for (int ai = 0; ai < 2; ++ai)
#pragma unroll
                for (int m = 0; m < 4; ++m) { const int row = row0 + ai * HALF + m * 16; const float s = rs[row]; bf16_t* rowp = O + (size_t)row * LDP + col0;
#pragma unroll
                    for (int bj = 0; bj < 2; ++bj) { const f32x4 v0 = acc[ai][bj][m][0] * s, v1 = acc[ai][bj][m][1] * s;
                        u32x4 w; w.x = cvt_pk_bf16(v0[0], v0[1]); w.y = cvt_pk_bf16(v0[2], v0[3]); w.z = cvt_pk_bf16(v1[0], v1[1]); w.w = cvt_pk_bf16(v1[2], v1[3]);
                        *(u32x4*)(rowp + bj * HALF) = w; } }
        } else {
            bf16_t* G = u.pn < 56 ? GR : GG; const int col0 = 128 * ((u.pn - 24) & 31) + wc * 32 + 8 * fq;
#pragma unroll
            for (int ai = 0; ai < 2; ++ai)
#pragma unroll
                for (int m = 0; m < 4; ++m) { const int row = row0 + ai * HALF + m * 16; const float s = rs[row];
                    const f32x4 o0 = acc[ai][0][m][0] * s, o1 = acc[ai][0][m][1] * s, m0 = acc[ai][1][m][0] * s, m1 = acc[ai][1][m][1] * s;
                    u32x4 w; w.x = cvt_pk_bf16(gate2(o0[0], m0[0]), gate2(o0[1], m0[1])); w.y = cvt_pk_bf16(gate2(o0[2], m0[2]), gate2(o0[3], m0[3]));
                    w.z = cvt_pk_bf16(gate2(o1[0], m1[0]), gate2(o1[1], m1[1])); w.w = cvt_pk_bf16(gate2(o1[2], m1[2]), gate2(o1[3], m1[3]));
                    *(u32x4*)(G + (size_t)row * DM + col0) = w; }
        }
    }
};
struct EpiB {
    static constexpr bool PERM = false, AFTER_DRAIN = false;
    unsigned char* VFR; unsigned char* VFG; unsigned char* KFR; const float* rs; const float* cst; const float* snt;
    __device__ __forceinline__ void operator()(const f32x4 (&acc)[2][2][4][2], const Unit& u, int wr, int wc, int fr, int fq) const {
        const int b = u.pm >> 3;
        if (u.pn < 8) {
            const int h = u.pn; const float l2g = __log2f(1.0f - exp2f(-5.0f - (float)h));
#pragma unroll
            for (int ai = 0; ai < 2; ++ai) { const size_t cb = (size_t)(b * 8 + h) * 33 + 1 + 4 * (u.pm & 7) + 2 * ai + wr;
                unsigned char* kb = KFR + (cb * 8 + wc) * 4096 + (fr + 32 * (fq & 1)) * 16 + 8 * (fq >> 1);
#pragma unroll
                for (int m = 0; m < 4; ++m) { const int rowb = u.pm * BM + ai * HALF + wr * 64 + m * 16 + 4 * fq; const f32x4 s4 = *(const f32x4*)(rs + rowb); f32x4 dk4;
#pragma unroll
                    for (int e = 0; e < 4; ++e) dk4[e] = exp2f(-(float)(16 * m + 4 * fq + e + 1) * l2g) * 0.0625f * s4[e];
#pragma unroll
                    for (int n = 0; n < 2; ++n) { const int idx = wc * 32 + n * 16 + fr;
                        const f32x4 c = *(const f32x4*)(cst + (size_t)idx * MT + rowb), sn4 = *(const f32x4*)(snt + (size_t)idx * MT + rowb), x1 = acc[ai][0][m][n], x2 = acc[ai][1][m][n];
                        const f32x4 o1 = (x1 * c - x2 * sn4) * dk4, o2 = (x2 * c + x1 * sn4) * dk4;
                        unsigned char* d = kb + m * 1024 + n * 256;
                        *(u64_t*)d = pk4(o1); *(u64_t*)(d + 4 * 4096) = pk4(o2); }
                    asm volatile("" ::: "memory"); } }
        } else {
            const int pv = u.pn - 8; unsigned char* VF = pv < 16 ? VFR : VFG;
#pragma unroll
            for (int ai = 0; ai < 2; ++ai) { const int nc = 1 + 4 * (u.pm & 7) + 2 * ai + wr;
#pragma unroll
                for (int m = 0; m < 4; ++m) { const f32x4 s4 = *(const f32x4*)(rs + u.pm * BM + ai * HALF + wr * 64 + m * 16 + 4 * fq);
#pragma unroll
                    for (int bj = 0; bj < 2; ++bj) { const int slg = 4 * (pv & 15) + 2 * bj + (wc >> 1);
                        unsigned char* fb = VF + ((((size_t)b * 33 + nc) * 64 + slg) * 8 + (wc & 1) * 4 + m) * 1024 + (fr + 32 * (fq & 1)) * 16 + 8 * (fq >> 1);
#pragma unroll
                        for (int n = 0; n < 2; ++n) { const f32x4 v = acc[ai][bj][m][n] * s4; *(u64_t*)(fb + n * 256) = pk4(v); } } } }
        }
    }
};
struct EpiScaleBf16 {
    static constexpr bool PERM = true, AFTER_DRAIN = false;
    bf16_t* O; int ldc; const float* ss;
    __device__ __forceinline__ void operator()(const f32x4 (&acc)[2][2][4][2], const Unit& u, int wr, int wc, int fr, int fq) const {
        const int row0 = u.pm * BM + wr * 64 + fr, col0 = u.pn * BM + wc * 32 + 8 * fq;
#pragma unroll
        for (int ai = 0; ai < 2; ++ai)
#pragma unroll
            for (int m = 0; m < 4; ++m) { const int row = row0 + ai * HALF + m * 16; const float s = 1.0f / sqrtf(ss[row] * (1.0f / 4096.0f) + 1e-6f); bf16_t* rowp = O + (size_t)row * ldc + col0;
#pragma unroll
                for (int bj = 0; bj < 2; ++bj) { const f32x4 v0 = acc[ai][bj][m][0] * s, v1 = acc[ai][bj][m][1] * s;
                    u32x4 w; w.x = cvt_pk_bf16(v0[0], v0[1]); w.y = cvt_pk_bf16(v0[2], v0[3]); w.z = cvt_pk_bf16(v1[0], v1[1]); w.w = cvt_pk_bf16(v1[2], v1[3]);
                    *(u32x4*)(rowp + bj * HALF) = w; } }
    }
};
struct EpiFfn {
    static constexpr bool PERM = true, AFTER_DRAIN = false;
    bf16_t* ACT; const float* ss; const float* cw; const float* cbias; float* UPH; float* PARTC; float* PARTG; PG8_LAS float* hl;
    __device__ __forceinline__ void operator()(const f32x4 (&acc)[2][2][4][2], const Unit& u, int wr, int wc, int fr, int fq) const {
        const int ch0 = wc * 32 + 8 * fq, cg = 128 * u.pn + ch0;
        f32x4 w0[2], w1[2], w2[2], cb[2];
#pragma unroll
        for (int n = 0; n < 2; ++n) { w0[n] = *(const f32x4*)(cw + cg + 4 * n); w1[n] = *(const f32x4*)(cw + DFF + cg + 4 * n); w2[n] = *(const f32x4*)(cw + 2 * DFF + cg + 4 * n); cb[n] = *(const f32x4*)(cbias + cg + 4 * n); }
        float rsv[2][4];
#pragma unroll
        for (int ai = 0; ai < 2; ++ai)
#pragma unroll
            for (int m = 0; m < 4; ++m) rsv[ai][m] = 1.0f / sqrtf(ss[u.pm * BM + ai * HALF + wr * 64 + m * 16 + fr] * (1.0f / 4096.0f) + 1e-6f);
        if (fr >= 14) {
#pragma unroll
            for (int ai = 0; ai < 2; ++ai)
#pragma unroll
                for (int n = 0; n < 2; ++n) { const f32x4 v = acc[ai][0][3][n] * rsv[ai][3];
                    *(PG8_LAS f32x4*)(hl + ((2 * ai + wr) * 2 + (fr - 14)) * 128 + ch0 + 4 * n) = v;
                    if (ai == 1 && wr == 1) *(f32x4*)(UPH + ((size_t)u.pm * 2 + (fr - 14)) * DFF + cg + 4 * n) = v; }
        }
        asm volatile("s_waitcnt lgkmcnt(0)" ::: "memory"); __builtin_amdgcn_s_barrier(); asm volatile("" ::: "memory");
#pragma unroll
        for (int ai = 0; ai < 2; ++ai) { const int bl = 2 * ai + wr;
            f32x4 p1[2], p2[2];
#pragma unroll
            for (int n = 0; n < 2; ++n) { p1[n] = (f32x4){0.f, 0.f, 0.f, 0.f}; p2[n] = p1[n];
                if (bl > 0) { const f32x4 r62 = *(const PG8_LAS f32x4*)(hl + ((bl - 1) * 2 + 0) * 128 + ch0 + 4 * n), r63 = *(const PG8_LAS f32x4*)(hl + ((bl - 1) * 2 + 1) * 128 + ch0 + 4 * n);
                    p1[n] = r63; p2[n] = fr == 0 ? r62 : r63; } }
#pragma unroll
            for (int m = 0; m < 4; ++m) { const int row = u.pm * BM + ai * HALF + wr * 64 + m * 16 + fr; float res[8];
#pragma unroll
                for (int n = 0; n < 2; ++n) { const f32x4 up0 = acc[ai][0][m][n] * rsv[ai][m], gt = acc[ai][1][m][n] * rsv[ai][m]; f32x4 c1, c2, l15, l14;
#pragma unroll
                    for (int j = 0; j < 4; ++j) { c1[j] = __shfl_up(up0[j], 1, 16); c2[j] = __shfl_up(up0[j], 2, 16); l15[j] = __shfl(up0[j], 15, 16); l14[j] = __shfl(up0[j], 14, 16); }
                    const f32x4 up1 = fr >= 1 ? c1 : p1[n], up2 = fr >= 2 ? c2 : p2[n];
                    const f32x4 cc = cb[n] + w0[n] * up2 + w1[n] * up1 + w2[n] * up0;
                    if (bl == 0 && m == 0 && fr < 2) {
                        *(f32x4*)(PARTC + ((size_t)u.pm * 2 + fr) * DFF + cg + 4 * n) = cc; *(f32x4*)(PARTG + ((size_t)u.pm * 2 + fr) * DFF + cg + 4 * n) = gt; }
#pragma unroll
                    for (int j = 0; j < 4; ++j) res[4 * n + j] = cc[j] * __builtin_amdgcn_rcpf(1.0f + __expf(-cc[j])) * gt[j];
                    p1[n] = l15; p2[n] = fr == 0 ? l14 : l15; }
                u32x4 w; w.x = cvt_pk_bf16(res[0], res[1]); w.y = cvt_pk_bf16(res[2], res[3]); w.z = cvt_pk_bf16(res[4], res[5]); w.w = cvt_pk_bf16(res[6], res[7]);
                *(u32x4*)(ACT + (size_t)row * DFF + cg) = w; } }
    }
};
struct EpiResX {
    static constexpr bool PERM = true, AFTER_DRAIN = false;
    const float* x; const float* meta; float* out; bf16_t* outb; float* ss; int ldc; int nreal, nmeta;
    __device__ __forceinline__ void operator()(const f32x4 (&acc)[2][2][4][2], const Unit& u, int wr, int wc, int fr, int fq) const {
        const int row0 = u.pm * BM + wr * 64 + fr, col0 = u.pn * BM + wc * 32 + 8 * fq;
#pragma unroll
        for (int ai = 0; ai < 2; ++ai)
#pragma unroll
            for (int m = 0; m < 4; ++m) { const int row = row0 + ai * HALF + m * 16;
                const float* bp = row < nreal ? x + (size_t)row * ldc : (row < nreal + nmeta ? meta + (size_t)(row - nreal) * ldc : nullptr);
                float* rowp = out + (size_t)row * ldc + col0; bf16_t* rowb = outb + (size_t)row * ldc + col0; float q = 0.f;
#pragma unroll
                for (int bj = 0; bj < 2; ++bj) { f32x4 o0 = (f32x4){0.f, 0.f, 0.f, 0.f}, o1 = o0;
                    if (bp) { o0 = *(const f32x4*)(bp + col0 + bj * HALF) + acc[ai][bj][m][0]; o1 = *(const f32x4*)(bp + col0 + bj * HALF + 4) + acc[ai][bj][m][1]; }
                    *(f32x4*)(rowp + bj * HALF) = o0; *(f32x4*)(rowp + bj * HALF + 4) = o1;
                    u32x4 w; w.x = cvt_pk_bf16(o0[0], o0[1]); w.y = cvt_pk_bf16(o0[2], o0[3]); w.z = cvt_pk_bf16(o1[0], o1[1]); w.w = cvt_pk_bf16(o1[2], o1[3]);
                    *(u32x4*)(rowb + bj * HALF) = w;
                    q += (o0[0] * o0[0] + o0[1] * o0[1]) + (o0[2] * o0[2] + o0[3] * o0[3]) + (o1[0] * o1[0] + o1[1] * o1[1]) + (o1[2] * o1[2] + o1[3] * o1[3]); }
                q += __shfl_xor(q, 16); q += __shfl_xor(q, 32);
                if (fq == 0 && bp) atomicAdd(ss + row, q); }
    }
};
struct EpiResF32 {
    static constexpr bool PERM = false, AFTER_DRAIN = false;
    const float* base; float* out; int ldc;
    __device__ __forceinline__ void operator()(const f32x4 (&acc)[2][2][4][2], const Unit& u, int wr, int wc, int fr, int fq) const {
        const int row0 = u.pm * BM + wr * 64 + fr, col0 = u.pn * BM + wc * 32 + 4 * fq;
#pragma unroll
        for (int ai = 0; ai < 2; ++ai)
#pragma unroll
            for (int m = 0; m < 4; ++m) { const size_t off = (size_t)(row0 + ai * HALF + m * 16) * ldc + col0;
#pragma unroll
                for (int bj = 0; bj < 2; ++bj)
#pragma unroll
                    for (int n = 0; n < 2; ++n) *(f32x4*)(out + off + bj * HALF + n * 16) = *(const f32x4*)(base + off + bj * HALF + n * 16) + acc[ai][bj][m][n]; }
    }
};
}

struct TItem { const float* W; int K, ldw, c0, nc; bf16* WT; int row_off; const float* kscale; int item; int blk, bstride; };
__device__ __forceinline__ void titem_load(const TItem& t, f32x4 (&v)[16], int lane) {
    const int nblk = (t.nc + 63) / 64, kb = t.item / nblk, nb = t.item % nblk, k0 = 64 * kb, n = 64 * nb + 4 * (lane & 15);
    const bool ok = n < t.nc;
    const float* p = t.W + (size_t)(k0 + (lane >> 4)) * t.ldw + t.c0 + n;
#pragma unroll
    for (int i = 0; i < 16; ++i) v[i] = ok ? *(const f32x4*)(p + (size_t)(4 * i) * t.ldw) : (f32x4){0.f, 0.f, 0.f, 0.f};
}
__device__ __forceinline__ void titem_store(const TItem& t, const f32x4 (&v)[16], LAS float* scr, int lane) {
    const int nblk = (t.nc + 63) / 64, kb = t.item / nblk, nb = t.item % nblk, k0 = 64 * kb, n0 = 64 * nb;
#pragma unroll
    for (int i = 0; i < 16; ++i) { LAS float* d = scr + (4 * i + (lane >> 4)) * 65 + 4 * (lane & 15); d[0] = v[i].x; d[1] = v[i].y; d[2] = v[i].z; d[3] = v[i].w; }
    LDS_WAIT(); asm volatile("" ::: "memory");
    const int c = lane & 7;
    f32x4 s0 = (f32x4){1.f, 1.f, 1.f, 1.f}, s1 = s0;
    if (t.kscale) { s0 = *(const f32x4*)(t.kscale + k0 + 8 * c); s1 = *(const f32x4*)(t.kscale + k0 + 8 * c + 4); }
#pragma unroll
    for (int j = 0; j < 8; ++j) { const int nn = (lane >> 3) + 8 * j; const LAS float* s = scr + (8 * c) * 65 + nn;
        v4u o; o.x = pk2(s[0 * 65] * s0.x, s[1 * 65] * s0.y); o.y = pk2(s[2 * 65] * s0.z, s[3 * 65] * s0.w); o.z = pk2(s[4 * 65] * s1.x, s[5 * 65] * s1.y); o.w = pk2(s[6 * 65] * s1.z, s[7 * 65] * s1.w);
        const int nd = n0 + nn; *(GAS v4u*)(t.WT + (size_t)(t.row_off + (nd / t.blk) * t.bstride + nd % t.blk) * t.K + k0 + 8 * c) = o; }
    LDS_WAIT(); asm volatile("" ::: "memory");
}
__device__ __forceinline__ void p0_prologue(Frame& F) {
    LAS float* scr = (LAS float*)(F.lds + RING_OFF + F.wave * 17408);
    const int gw = blockIdx.x * NWAVES + F.wave, NGW = F.G * NWAVES;
    constexpr int BIG = 1 << 30;
    constexpr int I_2K = 64 * (2048 / 64), I_4K = 64 * (4096 / 64), I_Z = 64;
    constexpr int I_O = 64 * (DM / 64), I_F = 64 * (NF / 64), I_2 = (DFF / 64) * (DM / 64);
    constexpr int NITEMS = 4 * I_2K + 6 * I_4K + I_Z + I_O + I_F + I_2;
    auto mk = [&](int it) { TItem t; int r = it;
        if (r < I_2K) { t = TItem{F.w_in, DM, NIN, 0, 2048, F.W1t, C_QR, F.attn_norm, r, BIG, 0}; return t; } r -= I_2K;
        if (r < I_2K) { t = TItem{F.w_in, DM, NIN, 2048, 2048, F.W1t, C_KR, F.attn_norm, r, BIG, 0}; return t; } r -= I_2K;
        if (r < I_4K) { t = TItem{F.w_in, DM, NIN, 4096, 4096, F.W1t, C_V, F.attn_norm, r, BIG, 0}; return t; } r -= I_4K;
        if (r < I_4K) { t = TItem{F.w_in, DM, NIN, 8192, 4096, F.W1t, C_GR, F.attn_norm, r, 128, 256}; return t; } r -= I_4K;
        if (r < I_2K) { t = TItem{F.w_in, DM, NIN, 12288, 2048, F.W1t, C_QG, F.attn_norm, r, BIG, 0}; return t; } r -= I_2K;
        if (r < I_2K) { t = TItem{F.w_in, DM, NIN, 14336, 2048, F.W1t, C_KG, F.attn_norm, r, BIG, 0}; return t; } r -= I_2K;
        if (r < I_4K) { t = TItem{F.w_in, DM, NIN, 16384, 4096, F.W1t, C_V + 4096, F.attn_norm, r, BIG, 0}; return t; } r -= I_4K;
        if (r < I_4K) { t = TItem{F.w_in, DM, NIN, 20480, 4096, F.W1t, C_GG, F.attn_norm, r, 128, 256}; return t; } r -= I_4K;
        if (r < I_Z) { t = TItem{F.w_in, DM, NIN, 24576, 16, F.W1t, C_Z, F.attn_norm, r, BIG, 0}; return t; } r -= I_Z;
        if (r < I_4K) { t = TItem{F.w_in, DM, NIN, 24592, 4096, F.W1t, C_GR + 128, F.attn_norm, r, 128, 256}; return t; } r -= I_4K;
        if (r < I_4K) { t = TItem{F.w_in, DM, NIN, 28688, 4096, F.W1t, C_GG + 128, F.attn_norm, r, 128, 256}; return t; } r -= I_4K;
        if (r < I_O) { t = TItem{F.w_out, DM, DM, 0, DM, F.Wot, 0, nullptr, r, BIG, 0}; return t; } r -= I_O;
        if (r < I_F / 2) { t = TItem{F.w_ffn_in, DM, NF, 0, DFF, F.Wft, 0, F.ffn_norm, r, 128, 256}; return t; } r -= I_F / 2;
        if (r < I_F / 2) { t = TItem{F.w_ffn_in, DM, NF, DFF, DFF, F.Wft, 128, F.ffn_norm, r, 128, 256}; return t; } r -= I_F / 2;
        t = TItem{F.w_ffn_out, DFF, DM, 0, DM, F.W2t, 0, nullptr, r, BIG, 0}; return t; };
    if (gw < NITEMS) {
        f32x4 cur[16], nxt[16]; TItem tc = mk(gw); titem_load(tc, cur, F.lane);
        for (int it = gw; it < NITEMS; it += NGW) {
            const bool more = it + NGW < NITEMS; TItem tn = tc;
            if (more) { tn = mk(it + NGW); titem_load(tn, nxt, F.lane); }
            titem_store(tc, cur, scr, F.lane);
            if (more) {
#pragma unroll
                for (int i = 0; i < 16; ++i) cur[i] = nxt[i];
                tc = tn; }
        }
    }
    { const size_t n16 = (size_t)(N1 - C_Z - 64) * DM * 2 / 16; GAS v4u* p = (GAS v4u*)(F.W1t + (size_t)(C_Z + 64) * DM);
      for (size_t i = (size_t)blockIdx.x * NTHR + F.tid; i < n16; i += (size_t)F.G * NTHR) p[i] = (v4u){0u, 0u, 0u, 0u}; }
    { const size_t n16 = (size_t)64 * 8 * 1024 / 16;
      for (size_t i = (size_t)blockIdx.x * NTHR + F.tid; i < 2 * n16; i += (size_t)F.G * NTHR) ((GAS v4u*)(i < n16 ? F.VFR : F.VFG))[i < n16 ? i : i - n16] = (v4u){0u, 0u, 0u, 0u}; }
    for (int i = blockIdx.x * NTHR + F.tid; i < 2 * 8 * 2048; i += F.G * NTHR) {
        const int which = i >> 14, h = (i >> 11) & 7, o = i & 2047; ((GAS v4u*)((unsigned char*)(which ? F.KFR : F.QFR) + (size_t)h * 33 * 32768))[o] = (v4u){0u, 0u, 0u, 0u}; }
    for (int m = gw; m < MT; m += NGW) {
        GAS unsigned long long* o8 = (GAS unsigned long long*)(F.XB + (size_t)m * DM) + F.lane;
        if (m < MROWS) {
            const float* xrow = m < MR ? F.x + (size_t)m * DM : F.meta + (size_t)(m - MR) * DM;
            const GAS f32x4* xr = (const GAS f32x4*)xrow + F.lane; float ss = 0.f;
#pragma unroll
            for (int j = 0; j < 16; ++j) { const f32x4 v = xr[64 * j]; ss += (v.x * v.x + v.y * v.y) + (v.z * v.z + v.w * v.w);
                o8[64 * j] = (unsigned long long)pk2(v.x, v.y) | ((unsigned long long)pk2(v.z, v.w) << 32); }
            ss = wave_sum(ss);
            if (F.lane == 0) F.RS1[m] = 1.0f / sqrtf(ss * (1.0f / DM) + EPS);
        } else {
            GAS unsigned long long* o2 = (GAS unsigned long long*)(F.MRG + (size_t)m * DM) + F.lane;
            GAS unsigned long long* o3 = (GAS unsigned long long*)(F.H1B + (size_t)m * DM) + F.lane;
#pragma unroll
            for (int j = 0; j < 16; ++j) { o8[64 * j] = 0ull; o2[64 * j] = 0ull; o3[64 * j] = 0ull; }
            if (F.lane == 0) F.RS1[m] = 0.f;
        }
    }
    for (int i = blockIdx.x * NTHR + F.tid; i < MROWS * 128; i += F.G * NTHR) {
        const int m = i >> 7, j = i & 127;
        const int pos = m < MR ? F.positions[m] + NMETA : m - MR;
        const float inv_freq = powf(10000.0f, -(float)j * (1.0f / 128.0f));
        const float ang = (float)pos * inv_freq; float s, c; sincosf(ang, &s, &c);
        F.COS[i] = c; F.SIN[i] = s; F.COST[(size_t)j * MT + m] = c; F.SINT[(size_t)j * MT + m] = s;
    }
}

typedef float f32x4v __attribute__((ext_vector_type(4)));
#define MFMA16(a, b, c) __builtin_amdgcn_mfma_f32_16x16x32_bf16((a), (b), (c), 0, 0, 0)
__device__ __forceinline__ f32x4v skinny_dot(const bf16* A, const bf16* Bt, int n0, int k0, int nks, int lane) {
    const int fr = lane & 15, fq = lane >> 4;
    const bf16* ap = A + (size_t)fr * DM + k0 + 8 * fq; const bf16* bp = Bt + (size_t)(n0 + fr) * DM + k0 + 8 * fq;
    f32x4v acc = (f32x4v){0.f, 0.f, 0.f, 0.f};
#pragma unroll 8
    for (int ks = 0; ks < nks; ++ks) acc = MFMA16(*(const bf16x8*)(ap + 32 * ks), *(const bf16x8*)(bp + 32 * ks), acc);
    return acc;
}
__device__ __forceinline__ void meta_proj(Frame& F) {
    const int lane = F.lane, fr = lane & 15, fq = lane >> 4, w8 = F.wave; LAS float* ex = (LAS float*)F.lds;
    const bf16* A = F.XB + (size_t)MR * DM;
    for (int it = blockIdx.x; it < 256; it += F.G) {
        if (it < 32) {
            const bool isk = it >= 16; const int h = (it & 15) >> 1, s2 = it & 1, idx = 64 * s2 + 16 * (w8 & 3) + fr, dk = idx + (w8 >= 4 ? 128 : 0);
            const f32x4v acc = skinny_dot(A, F.W1t, (isk ? C_KR : C_QR) + 256 * h + dk - fr, 0, DM / 32, lane);
#pragma unroll
            for (int e = 0; e < 4; ++e) ex[(w8 * 4 + e) * 64 + lane] = acc[e] * F.RS1[MR + 4 * fq + e];
            __syncthreads();
            const float l2g = __log2f(1.0f - exp2f(-5.0f - (float)h)); float o[4];
#pragma unroll
            for (int e = 0; e < 4; ++e) { const int mrow = 4 * fq + e; const float mine = ex[(w8 * 4 + e) * 64 + lane], other = ex[((w8 ^ 4) * 4 + e) * 64 + lane];
                const float c = F.COS[(MR + mrow) * 128 + idx], sn = F.SIN[(MR + mrow) * 128 + idx];
                const float rot = w8 < 4 ? mine * c - other * sn : mine * c + other * sn;
                const float dec = exp2f((float)(48 + mrow + 1) * l2g); o[e] = isk ? rot * 0.0625f / dec : rot * dec; }
            if (isk) *(unsigned long long*)((unsigned char*)F.KFR + (((size_t)h * 33 * 8 + (dk >> 5)) * 4 + 3) * 1024 + ((dk & 31) + 32 * (fq & 1)) * 16 + 8 * (fq >> 1)) = (unsigned long long)pkbf(o[0], o[1]) | ((unsigned long long)pkbf(o[2], o[3]) << 32);
            else {
#pragma unroll
                for (int e = 0; e < 4; ++e) { const int mrow = 4 * fq + e;
                    *(bf16*)((unsigned char*)F.QFR + (((size_t)h * 33 * 8 + (dk >> 5)) * 4 + ((dk >> 4) & 1) * 2 + 1) * 1024 + (16 + mrow + 32 * ((dk >> 2) & 1)) * 16 + 2 * (4 * ((dk >> 3) & 1) + (dk & 3))) = f2b(o[e]); } }
            __syncthreads();
        } else if (it < 64) {
            const int n0 = 128 * (it - 32) + 16 * w8; const f32x4v acc = skinny_dot(A, F.W1t, C_QG + n0, 0, DM / 32, lane);
#pragma unroll
            for (int e = 0; e < 4; ++e) { const int row = MR + 4 * fq + e; F.PROJ[(size_t)row * LDP + n0 + fr] = f2b(acc[e] * F.RS1[row]); }
        } else if (it >= 192) {
            const int cvv = 128 * (it - 192) + 16 * w8 + fr; const f32x4v acc = skinny_dot(A, F.W1t, C_V + 128 * (it - 192) + 16 * w8, 0, DM / 32, lane);
            const int cv = cvv & 4095, slg = cv >> 6, wt = (cv >> 5) & 1, rp = cv & 31; unsigned char* VF = (unsigned char*)(cvv < 4096 ? F.VFR : F.VFG);
            const f32x4v sc = *(const f32x4v*)(F.RS1 + MR + 4 * fq);
            *(unsigned long long*)(VF + ((size_t)slg * 8 + wt * 4 + 3) * 1024 + (rp + 32 * (fq & 1)) * 16 + 8 * (fq >> 1)) = (unsigned long long)pkbf(acc[0] * sc[0], acc[1] * sc[1]) | ((unsigned long long)pkbf(acc[2] * sc[2], acc[3] * sc[3]) << 32);
        } else {
            const int t = (it - 64) >> 1, sp = (it - 64) & 1;
            const int n0 = C_GR + 256 * t + (w8 >= 4 ? 128 : 0) + 64 * sp + 16 * (w8 & 3);
            const f32x4v acc = skinny_dot(A, F.W1t, n0, 0, DM / 32, lane);
#pragma unroll
            for (int e = 0; e < 4; ++e) ex[(w8 * 4 + e) * 64 + lane] = acc[e] * F.RS1[MR + 4 * fq + e];
            __syncthreads();
            if (w8 < 4) { bf16* G = t < 32 ? F.GR : F.GG; const int ch = 128 * (t & 31) + 64 * sp + 16 * w8 + fr;
#pragma unroll
                for (int e = 0; e < 4; ++e) { const int row = MR + 4 * fq + e; G[(size_t)row * DM + ch] = f2b(pg8::gate2(ex[(w8 * 4 + e) * 64 + lane], ex[((w8 + 4) * 4 + e) * 64 + lane])); } }
            __syncthreads();
        }
    }
    __syncthreads();
}
__device__ __forceinline__ void z_proj(Frame& F) {
    const int lane = F.lane, fr = lane & 15, fq = lane >> 4;
    for (int g = blockIdx.x * NWAVES + F.wave; g < MROWS / 16; g += F.G * NWAVES) {
        const f32x4v acc = skinny_dot(F.XB + (size_t)(16 * g) * DM, F.W1t, C_Z, 0, DM / 32, lane);
#pragma unroll
        for (int e = 0; e < 4; ++e) { const int row = 16 * g + 4 * fq + e; F.ZB[(size_t)row * 16 + fr] = acc[e] * F.RS1[row]; }
    }
}
__device__ __forceinline__ void meta_wout(Frame& F) {
    const int lane = F.lane, fr = lane & 15, fq = lane >> 4, w8 = F.wave; LAS float* ex = (LAS float*)F.lds;
    for (int it = blockIdx.x; it < DM / 16; it += F.G) {
        const int n0 = 16 * it; const f32x4v acc = skinny_dot(F.MRG + (size_t)MR * DM, F.Wot, n0, 512 * w8, 16, lane);
#pragma unroll
        for (int e = 0; e < 4; ++e) ex[(w8 * 4 + e) * 64 + lane] = acc[e];
        __syncthreads();
        if (w8 == 0) {
#pragma unroll
            for (int e = 2; e < 4; ++e) { float v = 0.f;
#pragma unroll
                for (int w = 0; w < 8; ++w) v += ex[(w * 4 + e) * 64 + lane];
                const int mrow = 4 * fq + e;
                const float hv = F.meta[(size_t)(mrow & 15) * DM + n0 + fr] + v; float q = hv * hv;
                q += __shfl_xor(q, 1); q += __shfl_xor(q, 2); q += __shfl_xor(q, 4); q += __shfl_xor(q, 8);
                if (fq == 3) { F.H1[(size_t)(MR + mrow) * DM + n0 + fr] = hv; F.H1B[(size_t)(MR + mrow) * DM + n0 + fr] = f2b(hv); if (fr == 0) atomicAdd(F.SS2 + MR + mrow, q); } }
        }
        __syncthreads();
    }
}
__device__ __forceinline__ void meta_up(Frame& F) {
    const int lane = F.lane, fr = lane & 15, fq = lane >> 4;
    for (int g = blockIdx.x * NWAVES + F.wave; g < DFF / 16; g += F.G * NWAVES) {
        const int c0 = 16 * g; const f32x4v acc = skinny_dot(F.H1B + (size_t)MR * DM, F.Wft, 256 * (c0 >> 7) + (c0 & 127), 0, DM / 32, lane);
        if (fq == 3) {
#pragma unroll
            for (int e = 2; e < 4; ++e) { const float rs = 1.0f / sqrtf(F.SS2[MR + 12 + e] * (1.0f / 4096.0f) + EPS); F.UPM[(size_t)(e - 2) * DFF + c0 + fr] = acc[e] * rs; } }
    }
}

template <bool GLA> __device__ __forceinline__ void prep_qkp(Frame& F, int u) {
    constexpr int DK = GLA ? GLA_DK : RET_DK, NH = GLA ? GLA_H : RET_H, LDQ = DK + 8, DKW = DK / 8, NKS = DKW / 16, NDT = DKW / 32;
    const int n = u % 33, h = (u / 33) % NH, b = u / (33 * NH);
    LAS bf16* Qs = (LAS bf16*)F.lds; LAS bf16* Ks = Qs + 64 * LDQ; LAS float* zs = (LAS float*)(Ks + 64 * LDQ);
    const int tid = F.tid, lane = F.lane, w8 = F.wave, r = lane & 31, hh = lane >> 5;
    if (GLA) {
        for (int e = tid; e < 64 * 16; e += NTHR) { const int row = chunk_row(b, n, e >> 4); zs[e] = row >= 0 ? F.ZB[(size_t)row * 16 + (e & 15)] : 0.f; }
        __syncthreads();
        const int d = tid, ch = h * GLA_DK + d; float wg[GLA_RANK];
#pragma unroll
        for (int q = 0; q < GLA_RANK; ++q) wg[q] = F.w_gate_up[q * 2048 + ch];
        const float bg = F.b_gate[ch]; float bc = 0.f;
#pragma unroll 1
        for (int i0 = 0; i0 < 64; i0 += 16) {
            unsigned qr[16], kr[16];
#pragma unroll
            for (int ii = 0; ii < 16; ++ii) { const int row = chunk_row(b, n, i0 + ii); qr[ii] = 0u; kr[ii] = 0u;
                if (row >= 0) { const bf16* pr = F.PROJ + (size_t)row * LDP; qr[ii] = pr[P_QG + ch]; kr[ii] = pr[P_KG + ch]; } }
#pragma unroll
            for (int ii = 0; ii < 16; ++ii) { const int i = i0 + ii, row = chunk_row(b, n, i); float qv = 0.f, kv = 0.f;
                if (row >= 0) { float lg = bg;
#pragma unroll
                    for (int q = 0; q < GLA_RANK; ++q) lg += zs[i * 16 + q] * wg[q];
                    bc += logsig(lg) * (1.0f / 16.0f);
                    qv = bf2f((bf16)qr[ii]) * 0.04419417382415922f * __expf(bc); kv = bf2f((bf16)kr[ii]) * __expf(-bc); }
                Qs[i * LDQ + d] = f2b(qv); Ks[i * LDQ + d] = f2b(kv); }
        }
        F.DECG[((size_t)(b * GLA_H + h) * 33 + n) * GLA_DK + d] = __expf(bc);
    } else {
        const int p = tid & 127, tg = tid >> 7; const float l2g = log2f(1.0f - exp2f(-5.0f - (float)h));
#pragma unroll 1
        for (int i8 = 0; i8 < 16; i8 += 8) {
            unsigned q1r[8], q2r[8], k1r[8], k2r[8]; float cr[8], sr[8];
#pragma unroll
            for (int ii = 0; ii < 8; ++ii) { const int row = chunk_row(b, n, tg * 16 + i8 + ii); q1r[ii] = q2r[ii] = k1r[ii] = k2r[ii] = 0u; cr[ii] = 0.f; sr[ii] = 0.f;
                if (row >= 0) { const bf16* pr = F.PROJ + (size_t)row * LDP; cr[ii] = F.COS[row * 128 + p]; sr[ii] = F.SIN[row * 128 + p];
                    q1r[ii] = pr[C_QR + h * 256 + p]; q2r[ii] = pr[C_QR + h * 256 + 128 + p]; k1r[ii] = pr[C_KR + h * 256 + p]; k2r[ii] = pr[C_KR + h * 256 + 128 + p]; } }
#pragma unroll
            for (int ii = 0; ii < 8; ++ii) { const int i = tg * 16 + i8 + ii; const float c = cr[ii], sn = sr[ii];
                const float q1 = bf2f((bf16)q1r[ii]), q2 = bf2f((bf16)q2r[ii]), k1 = bf2f((bf16)k1r[ii]), k2 = bf2f((bf16)k2r[ii]);
                const float dq = exp2f((float)(i + 1) * l2g), dkk = 0.0625f / dq;
                Qs[i * LDQ + p] = f2b((q1 * c - q2 * sn) * dq); Qs[i * LDQ + p + 128] = f2b((q2 * c + q1 * sn) * dq);
                Ks[i * LDQ + p] = f2b((k1 * c - k2 * sn) * dkk); Ks[i * LDQ + p + 128] = f2b((k2 * c + k1 * sn) * dkk); }
        }
    }
    __syncthreads();
    const size_t cb = (size_t)(b * NH + h) * 33 + n;
    {
        char* qdst = (char*)(GLA ? F.QFG : F.QFR) + ((cb * 8 + w8) * (NKS * 2)) * 1024 + lane * 16;
#pragma unroll
        for (int ks = 0; ks < NKS; ++ks)
#pragma unroll
            for (int qt = 0; qt < 2; ++qt) { const LAS bf16* src = Qs + (32 * qt + r) * LDQ + DKW * w8 + 16 * ks + 4 * hh;
                const unsigned long long lo = *(const LAS unsigned long long*)src, hi = *(const LAS unsigned long long*)(src + 8);
                *(v4u*)(qdst + (ks * 2 + qt) * 1024) = (v4u){(unsigned)lo, (unsigned)(lo >> 32), (unsigned)hi, (unsigned)(hi >> 32)}; }
        char* kdst = (char*)(GLA ? F.KFG : F.KFR) + ((cb * 8 + w8) * (NDT * 4)) * 1024 + lane * 16;
#pragma unroll
        for (int dkt = 0; dkt < NDT; ++dkt)
#pragma unroll
            for (int ks = 0; ks < 4; ++ks) { unsigned w[4];
#pragma unroll
                for (int jj = 0; jj < 4; ++jj) { const int j0 = 2 * jj, t0 = 16 * ks + 8 * (j0 >> 2) + 4 * hh + (j0 & 3);
                    const unsigned e0 = Ks[t0 * LDQ + DKW * w8 + 32 * dkt + r], e1 = Ks[(t0 + 1) * LDQ + DKW * w8 + 32 * dkt + r]; w[jj] = e0 | (e1 << 16); }
                *(v4u*)(kdst + (dkt * 4 + ks) * 1024) = (v4u){w[0], w[1], w[2], w[3]}; }
    }
    if (w8 < 4) {
        const int kt = w8 >> 1, qt = w8 & 1; f32x16 acc;
#pragma unroll
        for (int i = 0; i < 16; ++i) acc[i] = 0.f;
        if (!(kt == 1 && qt == 0)) {
            const LAS bf16* ap = Ks + (32 * kt + r) * LDQ + 8 * hh; const LAS bf16* bp = Qs + (32 * qt + r) * LDQ + 8 * hh;
#pragma unroll 8
            for (int s = 0; s < DK / 16; ++s) acc = MFMA32(*(const LAS bf16x8*)(ap + 16 * s), *(const LAS bf16x8*)(bp + 16 * s), acc);
        }
        char* pdst = (char*)(GLA ? F.PFG : F.PFR) + (cb * 8) * 1024 + lane * 16;
#pragma unroll
        for (int s2 = 0; s2 < 2; ++s2) { unsigned w[4];
#pragma unroll
            for (int jj = 0; jj < 4; ++jj) { const int i0 = 8 * s2 + 2 * jj, i1 = i0 + 1;
                const int k0 = 32 * kt + (i0 & 3) + 8 * (i0 >> 2) + 4 * hh, k1 = 32 * kt + (i1 & 3) + 8 * (i1 >> 2) + 4 * hh, qc = 32 * qt + r;
                w[jj] = pkbf(k0 <= qc ? acc[i0] : 0.f, k1 <= qc ? acc[i1] : 0.f); }
            *(v4u*)(pdst + ((2 * kt + s2) * 2 + qt) * 1024) = (v4u){w[0], w[1], w[2], w[3]}; }
    }
    __syncthreads();
}
__device__ __forceinline__ void prep_p_ret(Frame& F, int u) {
    const int n = u % 33, h = (u / 33) % 8, b = u / (33 * 8);
    if (n == 0 && b != 0) return;
    constexpr int LDK = 264;
    LAS bf16* Ks = (LAS bf16*)F.lds;
    const int lane = F.lane, w8 = F.wave, r = lane & 31, hh = lane >> 5;
    const size_t cb = (size_t)(b * 8 + h) * 33 + n;
    { const unsigned char* kp = (const unsigned char*)F.KFR + (cb * 8 + w8) * 4096 + lane * 16;
#pragma unroll
      for (int ks = 0; ks < 4; ++ks) { const v4u w = *(const v4u*)(kp + ks * 1024);
#pragma unroll
          for (int j = 0; j < 8; ++j) { const int tok = 16 * ks + 8 * (j >> 2) + 4 * hh + (j & 3); Ks[tok * LDK + 32 * w8 + r] = (bf16)(w[j >> 1] >> (16 * (j & 1))); } } }
    __syncthreads();
    if (w8 < 3) {
        const int kt = w8 >> 1, qt = w8 == 0 ? 0 : 1; f32x16 acc;
#pragma unroll
        for (int i = 0; i < 16; ++i) acc[i] = 0.f;
        const unsigned char* qp = (const unsigned char*)F.QFR + (cb * 8) * 4096 + qt * 1024 + lane * 16;
        const LAS bf16* ap = Ks + (32 * kt + r) * LDK + 4 * hh;
#pragma unroll 4
        for (int s = 0; s < 16; ++s) {
            const unsigned long long lo = *(const LAS unsigned long long*)(ap + 16 * s), hi = *(const LAS unsigned long long*)(ap + 16 * s + 8);
            const v4u av = (v4u){(unsigned)lo, (unsigned)(lo >> 32), (unsigned)hi, (unsigned)(hi >> 32)};
            acc = MFMA32(__builtin_bit_cast(bf16x8, av), *(const bf16x8*)(qp + (s >> 1) * 4096 + (s & 1) * 2048), acc); }
        unsigned char* pdst = (unsigned char*)F.PFR + (cb * 8) * 1024 + lane * 16;
#pragma unroll
        for (int s2 = 0; s2 < 2; ++s2) { unsigned w[4];
#pragma unroll
            for (int jj = 0; jj < 4; ++jj) { const int i0 = 8 * s2 + 2 * jj, i1 = i0 + 1;
                const int k0 = 32 * kt + (i0 & 3) + 8 * (i0 >> 2) + 4 * hh, k1 = 32 * kt + (i1 & 3) + 8 * (i1 >> 2) + 4 * hh, qc = 32 * qt + r;
                w[jj] = pkbf(k0 <= qc ? acc[i0] : 0.f, k1 <= qc ? acc[i1] : 0.f); }
            *(v4u*)(pdst + ((2 * kt + s2) * 2 + qt) * 1024) = (v4u){w[0], w[1], w[2], w[3]}; }
    } else if (w8 == 3) {
        unsigned char* pdst = (unsigned char*)F.PFR + (cb * 8) * 1024 + lane * 16;
        *(v4u*)(pdst + (2 * 2 + 0) * 1024) = (v4u){0u, 0u, 0u, 0u}; *(v4u*)(pdst + (3 * 2 + 0) * 1024) = (v4u){0u, 0u, 0u, 0u};
    }
    __syncthreads();
}
#ifndef PREP_REP
#define PREP_REP 0
#endif
__device__ __forceinline__ void p2_prep(Frame& F) {
    constexpr int U_R = 4 * 8 * 33, U_G = 4 * 4 * 33;
    for (int u = blockIdx.x; u < U_G + U_R; u += F.G) {
        if (u < U_G) { prep_qkp<true>(F, u); if (PREP_REP & 1) prep_qkp<true>(F, u); }
        else { prep_p_ret(F, u - U_G); if (PREP_REP & 2) prep_p_ret(F, u - U_G); }
    }
}

__device__ __forceinline__ bf16x8 pack8(const f32x16& x, int s) { v4u w;
    if (s == 0) { w.x = pkbf(x[0], x[1]); w.y = pkbf(x[2], x[3]); w.z = pkbf(x[4], x[5]); w.w = pkbf(x[6], x[7]); }
    else { w.x = pkbf(x[8], x[9]); w.y = pkbf(x[10], x[11]); w.z = pkbf(x[12], x[13]); w.w = pkbf(x[14], x[15]); }
    return __builtin_bit_cast(bf16x8, w); }
#define LDS_BAR() do { asm volatile("s_waitcnt lgkmcnt(0)" ::: "memory"); __builtin_amdgcn_s_barrier(); asm volatile("" ::: "memory"); } while (0)
template <bool GLA> __device__ __forceinline__ void scan_unit(Frame& F, int u) {
    constexpr int DK = GLA ? GLA_DK : RET_DK, DV = GLA ? GLA_DV : RET_DV, NH = GLA ? GLA_H : RET_H, NSL = DV / 64, DKW = DK / 8, NKS = DKW / 16, NDT = DKW / 32;
    const int b = u / (NH * NSL), h = (u / NSL) % NH, sl = u % NSL, slg = h * NSL + sl;
    const int lane = F.lane, r = lane & 31, hh = lane >> 5, w8 = F.wave;
    LAS float* RED = (LAS float*)F.lds;
    LAS unsigned char* VL = F.lds + 131072;
    f32x16 S[NDT][2];
#pragma unroll
    for (int a = 0; a < NDT; ++a)
#pragma unroll
        for (int c = 0; c < 2; ++c)
#pragma unroll
            for (int i = 0; i < 16; ++i) S[a][c][i] = 0.f;
    const int b0 = GLA ? b : 0;
    const char* QFb = (const char*)(GLA ? F.QFG : F.QFR) + (((size_t)(b * NH + h) * 33 * 8 + w8) * (NKS * 2)) * 1024 + lane * 16;
    const char* QF0 = (const char*)(GLA ? F.QFG : F.QFR) + (((size_t)(b0 * NH + h) * 33 * 8 + w8) * (NKS * 2)) * 1024 + lane * 16;
    const char* KF0 = (const char*)(GLA ? F.KFG : F.KFR) + (((size_t)(b0 * NH + h) * 33 * 8 + w8) * (NDT * 4)) * 1024 + lane * 16;
    const char* PF0 = (const char*)(GLA ? F.PFG : F.PFR) + ((size_t)(b0 * NH + h) * 33 * 8 + w8) * 1024 + lane * 16;
    const char* KFb = (const char*)(GLA ? F.KFG : F.KFR) + (((size_t)(b * NH + h) * 33 * 8 + w8) * (NDT * 4)) * 1024 + lane * 16;
    const char* VF0 = (const char*)(GLA ? F.VFG : F.VFR) + ((size_t)slg * 8 + w8) * 1024 + lane * 16;
    const char* VFb = VF0 + (size_t)b * 33 * 64 * 8 * 1024;
    const char* PFb = (const char*)(GLA ? F.PFG : F.PFR) + ((size_t)(b * NH + h) * 33 * 8 + w8) * 1024 + lane * 16;
    bf16* Y = GLA ? F.YG : F.YR;
    const float gam64 = exp2f(64.0f * log2f(1.0f - exp2f(-5.0f - (float)h)));
    bf16x8 qf[NKS * 2];
#pragma unroll
    for (int f = 0; f < NKS * 2; ++f) qf[f] = *(const bf16x8*)(QF0 + f * 1024);
    *(LAS bf16x8*)(VL + w8 * 1024 + lane * 16) = *(const bf16x8*)VF0;
    __syncthreads();
#pragma unroll 1
    for (int n = 0; n < 33; ++n) {
        const size_t cb = (size_t)(b * NH + h) * 33 + n;
        const char* kp = n ? KFb + (size_t)n * (8 * NDT * 4 * 1024) : KF0;
        const LAS unsigned char* vl = VL + (n & 1) * 8192 + lane * 16;
        const int nn = n < 32 ? n + 1 : n;
        bf16x8 kf[NDT * 4];
#pragma unroll
        for (int f = 0; f < NDT * 4; ++f) kf[f] = *(const bf16x8*)(kp + f * 1024);
        const bf16x8 bp = *(const bf16x8*)(n ? PFb + (size_t)n * 8192 : PF0);
        const bf16x8 vnext = *(const bf16x8*)(VFb + (size_t)nn * (64 * 8 * 1024));
        { const int ks2 = w8 >> 1, qt2 = w8 & 1;
#pragma unroll
          for (int wt = 0; wt < 2; ++wt) { f32x16 o0, o1;
#pragma unroll
            for (int i = 0; i < 16; ++i) { o0[i] = 0.f; o1[i] = 0.f; }
#pragma unroll
            for (int ks = 0; ks < NKS; ++ks) { const bf16x8 a = pack8(S[ks >> 1][wt], ks & 1); o0 = MFMA32(a, qf[ks * 2], o0); o1 = MFMA32(a, qf[ks * 2 + 1], o1); }
            const bf16x8 av = *(const LAS bf16x8*)(vl + (wt * 4 + ks2) * 1024);
            if (qt2 == 0) o0 = MFMA32(av, bp, o0); else o1 = MFMA32(av, bp, o1);
#pragma unroll
            for (int i = 0; i < 16; ++i) { RED[((w8 * 4 + wt * 2) * 16 + i) * 64 + lane] = o0[i]; RED[((w8 * 4 + wt * 2 + 1) * 16 + i) * 64 + lane] = o1[i]; } } }
        { const char* qn = QFb + (size_t)nn * (8 * NKS * 2 * 1024);
#pragma unroll
          for (int f = 0; f < NKS * 2; ++f) qf[f] = *(const bf16x8*)(qn + f * 1024); }
#pragma unroll
        for (int ks = 0; ks < 4; ++ks) { bf16x8 bv[2];
#pragma unroll
            for (int wt = 0; wt < 2; ++wt) bv[wt] = *(const LAS bf16x8*)(vl + (wt * 4 + ks) * 1024);
#pragma unroll
            for (int dkt = 0; dkt < NDT; ++dkt)
#pragma unroll
                for (int wt = 0; wt < 2; ++wt) S[dkt][wt] = MFMA32(kf[dkt * 4 + ks], bv[wt], S[dkt][wt]); }
        if (GLA) {
#pragma unroll
            for (int dkt = 0; dkt < NDT; ++dkt) { const float* dp = F.DECG + cb * GLA_DK + DKW * w8 + 32 * dkt + 4 * hh;
#pragma unroll
                for (int g4 = 0; g4 < 4; ++g4) { const f32x4 dv = *(const f32x4*)(dp + 8 * g4);
#pragma unroll
                    for (int e = 0; e < 4; ++e) { S[dkt][0][4 * g4 + e] *= dv[e]; S[dkt][1][4 * g4 + e] *= dv[e]; } } }
        } else {
#pragma unroll
            for (int wt = 0; wt < 2; ++wt)
#pragma unroll
                for (int i = 0; i < 16; ++i) S[0][wt][i] *= gam64;
        }
        *(LAS bf16x8*)(VL + ((n + 1) & 1) * 8192 + w8 * 1024 + lane * 16) = vnext;
        LDS_BAR();
        {
            const int t = w8 >> 1, i0 = 8 * (w8 & 1), wt = t >> 1, qt = t & 1; float val[8];
#pragma unroll
            for (int ii = 0; ii < 8; ++ii) { float sum = 0.f;
#pragma unroll
                for (int src = 0; src < 8; ++src) sum += RED[((src * 4 + t) * 16 + i0 + ii) * 64 + lane];
                val[ii] = sum; }
            const int row = chunk_row(b, n, 32 * qt + r);
            if (row >= 0 && (n > 0 || b == 0)) {
#pragma unroll
                for (int g = 0; g < 2; ++g) { const int w0 = 32 * wt + 8 * (2 * (w8 & 1) + g) + 4 * hh;
                    *(unsigned long long*)(Y + (size_t)row * DM + h * DV + 64 * sl + w0) = (unsigned long long)pkbf(val[4 * g], val[4 * g + 1]) | ((unsigned long long)pkbf(val[4 * g + 2], val[4 * g + 3]) << 32); } }
        }
        LDS_BAR();
    }
    __syncthreads();
}
__device__ __forceinline__ void p3_scan(Frame& F) {
    for (int i = blockIdx.x; i < 512; i += F.G) {
        const int w = i & 255, x = w & 7, idx = w >> 3;
        if (i < 256) scan_unit<true>(F, (2 * x + (idx >> 4)) * 16 + (idx & 15)); else scan_unit<false>(F, (4 * x + (idx >> 3)) * 8 + (idx & 7));
    }
}

__device__ __forceinline__ f32x4 ld4bf(const bf16* p) { const unsigned long long w = *(const unsigned long long*)p; return (f32x4){bf2f((bf16)w), bf2f((bf16)(w >> 16)), bf2f((bf16)(w >> 32)), bf2f((bf16)(w >> 48))}; }
__device__ __forceinline__ void p4_merge(Frame& F) {
    const int gw = blockIdx.x * NWAVES + F.wave, NGW = F.G * NWAVES, lane = F.lane;
    for (int m = gw; m < MROWS; m += NGW) {
#pragma unroll 1
        for (int hg = 0; hg < 4; ++hg) {
            f32x4 yr[4], yg[4];
#pragma unroll
            for (int j = 0; j < 4; ++j) { const int c = hg * 1024 + j * 256 + lane * 4; yr[j] = ld4bf(F.YR + (size_t)m * DM + c); yg[j] = ld4bf(F.YG + (size_t)m * DM + c); }
            float sg = 0.f, sa = 0.f, sb = 0.f;
#pragma unroll
            for (int j = 0; j < 4; ++j) { sg += (yg[j].x * yg[j].x + yg[j].y * yg[j].y) + (yg[j].z * yg[j].z + yg[j].w * yg[j].w);
                const float t = (yr[j].x + yr[j].y) + (yr[j].z + yr[j].w); if (j < 2) sa += t; else sb += t; }
            sg = wave_sum(sg); sa = wave_sum(sa); sb = wave_sum(sb);
            const float rg = 1.0f / sqrtf(sg * (1.0f / 1024.0f) + EPS), ma = sa * (1.0f / 512.0f), mb = sb * (1.0f / 512.0f);
            float qa = 0.f, qb = 0.f;
#pragma unroll
            for (int j = 0; j < 4; ++j) { const float mu = j < 2 ? ma : mb; yr[j] = yr[j] - mu;
                const float t = (yr[j].x * yr[j].x + yr[j].y * yr[j].y) + (yr[j].z * yr[j].z + yr[j].w * yr[j].w); if (j < 2) qa += t; else qb += t; }
            qa = wave_sum(qa); qb = wave_sum(qb);
            const float ra = 1.0f / sqrtf(qa * (1.0f / 512.0f) + EPS), rb = 1.0f / sqrtf(qb * (1.0f / 512.0f) + EPS);
#pragma unroll
            for (int j = 0; j < 4; ++j) { const int c = hg * 1024 + j * 256 + lane * 4; const float rr = j < 2 ? ra : rb;
                const f32x4 gr = *(const f32x4*)(F.ret_norm + c), gg = *(const f32x4*)(F.gla_norm + c);
                const f32x4 tr = ld4bf(F.GR + (size_t)m * DM + c), tg = ld4bf(F.GG + (size_t)m * DM + c);
                const f32x4 res = tr * (yr[j] * rr * gr) + tg * (yg[j] * rg * gg);
                *(unsigned long long*)(F.MRG + (size_t)m * DM + c) = (unsigned long long)pk2(res[0], res[1]) | ((unsigned long long)pk2(res[2], res[3]) << 32); }
        }
    }
}

__device__ __forceinline__ void p8_act(Frame& F) {
    for (int i = blockIdx.x * NTHR + F.tid; i < 32 * DFF; i += F.G * NTHR) {
        const int pm = i / DFF, c = i % DFF;
        const float* prev = (pm & 7) ? F.UPH + (size_t)(pm - 1) * 2 * DFF : F.UPM;
        const float p0 = prev[c], p1 = prev[DFF + c], w0 = F.conv_w[c], w1 = F.conv_w[DFF + c];
        const float c0 = F.PARTC[(size_t)pm * 2 * DFF + c] + w1 * p1 + w0 * p0, c1 = F.PARTC[(size_t)pm * 2 * DFF + DFF + c] + w0 * p1;
        F.ACT[(size_t)(256 * pm) * DFF + c] = f2b(silu(c0) * F.PARTG[(size_t)pm * 2 * DFF + c]);
        F.ACT[(size_t)(256 * pm + 1) * DFF + c] = f2b(silu(c1) * F.PARTG[(size_t)pm * 2 * DFF + DFF + c]);
    }
}

__device__ __forceinline__ void p10_final(Frame& F) {
    const int gw = blockIdx.x * NWAVES + F.wave, NGW = F.G * NWAVES;
    for (int m = gw; m < MR; m += NGW) {
        GAS f32x4* xr = (GAS f32x4*)(F.out + (size_t)m * DM) + F.lane; f32x4 v[16]; float ss = 0.f;
#pragma unroll
        for (int j = 0; j < 16; ++j) { v[j] = xr[64 * j]; ss += (v[j].x * v[j].x + v[j].y * v[j].y) + (v[j].z * v[j].z + v[j].w * v[j].w); }
        ss = wave_sum(ss); const float r = 1.0f / sqrtf(ss * (1.0f / DM) + EPS);
#pragma unroll
        for (int j = 0; j < 16; ++j) { const f32x4 g = *((const GAS f32x4*)F.final_norm + F.lane + 64 * j); xr[64 * j] = v[j] * r * g; }
    }
}

#ifndef REP_MASK
#define REP_MASK 0u
#endif
#define REPS(k) (((REP_MASK >> (k)) & 1u) ? 2 : 1)
struct Args { const void* in[16]; float* out; unsigned char* ws; int ph_lo, ph_hi, li, pad; };
__global__ void __launch_bounds__(NTHR, 2) fwd(Args args) {
    extern __shared__ __attribute__((aligned(16))) unsigned char lds[];
    Frame F;
    F.lds = (LAS unsigned char*)lds;
    F.MISC = (volatile LAS unsigned*)(F.lds + MISC_OFF);
    F.tid = threadIdx.x; F.lane = F.tid & 63; F.wave = __builtin_amdgcn_readfirstlane(F.tid >> 6); F.G = gridDim.x;
    unsigned char* ws = args.ws;
    F.ctl = (gu32*)(ws + WS_CTL);
    F.x = (const float*)args.in[0]; F.positions = (const int*)args.in[1]; F.meta = (const float*)args.in[2]; F.attn_norm = (const float*)args.in[3]; F.w_in = (const float*)args.in[4];
    F.w_gate_up = (const float*)args.in[5]; F.b_gate = (const float*)args.in[6]; F.ret_norm = (const float*)args.in[7]; F.gla_norm = (const float*)args.in[8]; F.w_out = (const float*)args.in[9];
    F.ffn_norm = (const float*)args.in[10]; F.w_ffn_in = (const float*)args.in[11]; F.conv_w = (const float*)args.in[12]; F.conv_b = (const float*)args.in[13]; F.w_ffn_out = (const float*)args.in[14];
    F.final_norm = (const float*)args.in[15]; F.out = args.out;
    F.W1t = (bf16*)(ws + WS_W1T); F.Wot = (bf16*)(ws + WS_WOT); F.Wft = (bf16*)(ws + WS_WFT); F.W2t = (bf16*)(ws + WS_W2T); F.XB = (bf16*)(ws + WS_XB);
    F.PROJ = (bf16*)(ws + WS_PROJ); F.UG = (bf16*)(ws + WS_UG); F.ACT = (bf16*)(ws + WS_ACT); F.MRG = (bf16*)(ws + WS_MRG); F.H1B = (bf16*)(ws + WS_H1B);
    F.RS1 = (float*)(ws + WS_RS1); F.SS2 = (float*)(F.ctl + CW_SS2); F.ZB = (float*)(ws + WS_ZB); F.COS = (float*)(ws + WS_COS); F.SIN = (float*)(ws + WS_SIN); F.COST = (float*)(ws + WS_COST); F.SINT = (float*)(ws + WS_SINT);
    F.YR = (bf16*)(ws + WS_YR); F.YG = (bf16*)(ws + WS_YG); F.GR = (bf16*)(ws + WS_GR); F.GG = (bf16*)(ws + WS_GG); F.H1 = (float*)(ws + WS_H1); F.DECG = (float*)(ws + WS_DECG); F.UPH = (float*)(ws + WS_UPH); F.PARTC = (float*)(ws + WS_PARTC); F.PARTG = (float*)(ws + WS_PARTG); F.UPM = (float*)(ws + WS_UPM);
    F.QFG = (bf16*)(ws + WS_QFG); F.KFG = (bf16*)(ws + WS_KFG); F.QFR = (bf16*)(ws + WS_QFR); F.KFR = (bf16*)(ws + WS_KFR);
    F.VFG = (bf16*)(ws + WS_VFG); F.VFR = (bf16*)(ws + WS_VFR); F.PFG = (bf16*)(ws + WS_PFG); F.PFR = (bf16*)(ws + WS_PFR);
    for (int u = F.tid; u < (LDS_BYTES - LDSCTL_OFF) / 4; u += NTHR) ((LAS unsigned*)(F.lds + LDSCTL_OFF))[u] = 0u;
    __syncthreads();
    XcdBarrier bar; bar.bar = (unsigned*)(F.ctl + CW_BAR); bar.x = 0; bar.st = nullptr;
    if (N_LAUNCHES != NPH) bar = xcd_barrier_post((unsigned*)(F.ctl + CW_BAR) + args.li * XCD_BAR_WORDS, F.MISC + 8);
#define GRID_BAR(seam) do { if (N_LAUNCHES == NPH) { if (F.tid == 0) __hip_atomic_store(F.ctl + CW_TMO, 0xBADBA0u | (unsigned)(seam), RLX_AGENT); } else { xcd_barrier(bar); } } while (0)
    const int lo = args.ph_lo, hi = args.ph_hi;
#define IN(k) (lo <= (k) && (k) < hi)
#define BOTH(k) (IN(k) && IN((k) + 1))
#ifndef SKINNY_REP
#define SKINNY_REP 0
#endif
#define PH1() do { z_proj(F); if (SKINNY_REP & 1) z_proj(F); meta_proj(F); if (SKINNY_REP & 2) meta_proj(F); \
        { pg8::Gemm g{F.XB, F.W1t, MR, C_B, DM}; pg8::StaticOrder S; S.init(MR, C_B, F.G, (int)blockIdx.x); pg8::EpiA E{F.PROJ, F.RS1, F.COS, F.SIN, (unsigned char*)F.QFR, F.GR, F.GG}; \
          pg8::gemm_phase<pg8::EpiA, pg8::StaticOrder, PG8_ALIGN, PG8_SP2>(F.lds + RING_OFF, g, S, E); } \
        { pg8::Gemm g{F.XB, F.W1t + (size_t)C_B * DM, MR, 32768 - C_B, DM}; pg8::StaticOrder S; S.init(MR, 32768 - C_B, F.G, (int)blockIdx.x); pg8::EpiB E{(unsigned char*)F.VFR, (unsigned char*)F.VFG, (unsigned char*)F.KFR, F.RS1, F.COST, F.SINT}; \
          pg8::gemm_phase<pg8::EpiB, pg8::StaticOrder, PG8_ALIGN, PG8_SP2, false>(F.lds + RING_OFF, g, S, E); } } while (0)
#define PH5() do { meta_wout(F); pg8::Gemm g{F.MRG, F.Wot, MR, DM, DM}; pg8::StaticOrder S; S.init(MR, DM, F.G, (int)blockIdx.x); pg8::EpiResX E{F.x, F.meta, F.H1, F.H1B, F.SS2, DM, MR, NMETA}; \
        pg8::gemm_phase<pg8::EpiResX, pg8::StaticOrder, PG8_ALIGN, PG8_SP2>(F.lds + RING_OFF, g, S, E); } while (0)
#define PH7() do { meta_up(F); pg8::Gemm g{F.H1B, F.Wft, MR, NF, DM}; pg8::StaticOrder S; S.init(MR, NF, F.G, (int)blockIdx.x); pg8::EpiFfn E{F.ACT, F.SS2, F.conv_w, F.conv_b, F.UPH, F.PARTC, F.PARTG, (LAS float*)(F.lds + 131072)}; \
        pg8::gemm_phase<pg8::EpiFfn, pg8::StaticOrder, true, PG8_SP2>(F.lds + RING_OFF, g, S, E); } while (0)
#define PH9() do { pg8::Gemm g{F.ACT, F.W2t, MR, DM, DFF}; pg8::StaticOrder S; S.init(MR, DM, F.G, (int)blockIdx.x); pg8::EpiResF32 E{F.H1, F.out, DM}; \
        pg8::gemm_phase<pg8::EpiResF32, pg8::StaticOrder, PG8_ALIGN, PG8_SP2>(F.lds + RING_OFF, g, S, E); } while (0)
#define REIDX() do { int tz = threadIdx.x; asm volatile("" : "+v"(tz)); F.tid = tz; F.lane = tz & 63; F.wave = __builtin_amdgcn_readfirstlane(tz >> 6); } while (0)
#define RUN(k, body) do { if (IN(k)) { REIDX(); body; if (REPS(k) == 2) { __syncthreads(); body; } if (BOTH(k)) GRID_BAR(k); } } while (0)
    RUN(0, p0_prologue(F));
    RUN(1, PH1());
    RUN(2, p2_prep(F));
    RUN(3, p3_scan(F));
    RUN(4, p4_merge(F));
    RUN(5, PH5());
    RUN(7, PH7());
    RUN(8, p8_act(F));
    RUN(9, PH9());
    if (IN(10)) { REIDX(); p10_final(F); }
#undef IN
#undef BOTH
}

extern "C" void kernel_launch(void* const* d_in, const int* in_sizes, int n_in, void* d_out, int out_size, void* d_ws, size_t ws_size, hipStream_t stream) {
    static int grid = 0;
    if (grid == 0) {
        if (n_in != 16 || in_sizes[0] != MR * DM || out_size != MR * DM || ws_size < WS_END) {
            fprintf(stderr, "kernel_launch: shape/workspace mismatch: n_in %d in0 %d out %d ws %zu (need %zu); nothing launched\n", n_in, n_in > 0 ? in_sizes[0] : -1, out_size, ws_size, (size_t)WS_END); grid = -1; return; }
        int dev = 0, cus = 0, per_cu = 0;
        if (hipGetDevice(&dev) != hipSuccess || hipDeviceGetAttribute(&cus, hipDeviceAttributeMultiprocessorCount, dev) != hipSuccess) { fprintf(stderr, "kernel_launch: device query failed\n"); grid = -1; return; }
        if (hipFuncSetAttribute((const void*)fwd, hipFuncAttributeMaxDynamicSharedMemorySize, LDS_BYTES) != hipSuccess) { fprintf(stderr, "kernel_launch: hipFuncSetAttribute failed\n"); grid = -1; return; }
        if (hipOccupancyMaxActiveBlocksPerMultiprocessor(&per_cu, (const void*)fwd, NTHR, LDS_BYTES) != hipSuccess || per_cu < 1)
            fprintf(stderr, "kernel_launch: note: occupancy query reports %d workgroups per CU\n", per_cu);
        (void)hipGetLastError();
        grid = cus;
    }
    if (grid < 0) return;
    if (hipMemsetAsync((char*)d_ws + WS_CTL, 0, CTL_ZERO_BYTES, stream) != hipSuccess) { fprintf(stderr, "kernel_launch: memset failed\n"); return; }
    Args a{};
    for (int i = 0; i < 16; ++i) a.in[i] = d_in[i];
    a.out = (float*)d_out; a.ws = (unsigned char*)d_ws;
    for (int li = 0; li < N_LAUNCHES; ++li) {
        a.ph_lo = (N_LAUNCHES == NPH) ? li : 0; a.ph_hi = (N_LAUNCHES == NPH) ? li + 1 : NPH; a.li = (N_LAUNCHES == NPH) ? 0 : li;
        hipLaunchKernelGGL(fwd, dim3(grid), dim3(NTHR), LDS_BYTES, stream, a);
        const hipError_t le = hipPeekAtLastError();
        if (le != hipSuccess) { fprintf(stderr, "kernel_launch: launch %d failed: %s\n", li, hipGetErrorName(le)); break; }
    }
}
```

```cpp
#include <hip/hip_runtime.h>
#include <cstdio>
#include <cstdint>
namespace pg8 {
#define PG8_LAS __attribute__((address_space(3)))
typedef unsigned short bf16_t;
typedef short bf16x8 __attribute__((ext_vector_type(8)));
typedef float f32x4 __attribute__((ext_vector_type(4)));
typedef unsigned u32x4 __attribute__((ext_vector_type(4)));
constexpr int BM = 256, BK = 64, HALF = 128, HTB = HALF * BK * 2  , STAGE_BYTES = 8 * HTB, NXCD = 8, WGM = 4;

__host__ __device__ __forceinline__ int lds_byte(int r, int c) { const int st = (r >> 4) * 2 + (c >> 5), rr = r & 15, cc = c & 31, ob = rr * 64 + cc * 2; return st * 1024 + (ob ^ (((ob >> 9) & 1) << 5)); }
__host__ __device__ __forceinline__ void stage_rc(int b, int& R, int& C) { const int st = b / 1024, sb = b % 1024, swz = sb ^ (((sb >> 9) & 1) << 5); R = (st >> 1) * 16 + swz / 64; C = (st & 1) * 32 + (swz % 64) / 2; }
__host__ __device__ __forceinline__ int perm32(int rho) { const int n = rho >> 4, i = rho & 15; return 8 * (i >> 2) + 4 * n + (i & 3); }

struct Unit { int pm, pn; };
struct Gemm { const bf16_t* A; const bf16_t* Bt; int M, N, K; };

struct StaticOrder {
    int nM, nN, nwg, G, c;
    __host__ __device__ void init(int M, int N, int G_, int c_) { nM = M / BM; nN = N / BM; nwg = nM * nN; G = G_; c = c_; }
    __host__ __device__ bool next(int i, Unit& u) const {
        const long L = (long)i * G + c; if (L >= nwg) return false;
        int wgid = (int)L; { const int q = nwg / NXCD, r = nwg % NXCD, xcd = wgid % NXCD, off = wgid / NXCD; wgid = (xcd < r ? xcd * (q + 1) : r * (q + 1) + (xcd - r) * q) + off; }
        const int nig = WGM * nN, gid = wgid / nig, fm = gid * WGM, gsz = (nM - fm) < WGM ? (nM - fm) : WGM;
        u.pm = fm + ((wgid % nig) % gsz); u.pn = (wgid % nig) / gsz; return true;
    }
    __device__ __forceinline__ void a_ready(const Unit&) const {}
    __device__ __forceinline__ void done(const Unit&) const {}
};
__device__ __forceinline__ unsigned cvt_pk_bf16(float lo, float hi) { unsigned r; asm volatile("v_cvt_pk_bf16_f32 %0, %1, %2" : "=v"(r) : "v"(lo), "v"(hi)); return r; }
template <class Epi, class Sched, bool ALIGN_EPI = false, bool SP2 = false, bool TR = true  >
__device__ __forceinline__ void gemm_phase(PG8_LAS unsigned char* lds, const Gemm g, const Sched& S, const Epi& E) {
    const int tid = threadIdx.x, wid = __builtin_amdgcn_readfirstlane(tid >> 6), lane = tid & 63, wr = wid >> 2, wc = wid & 3, fr = lane & 15, fq = lane >> 4;
    const int K = g.K, nt = K / BK;
    unsigned voffA[2], voffB[2];
#pragma unroll
    for (int i = 0; i < 2; ++i) { int R, C; stage_rc(tid * 16 + i * 8192, R, C); const int Rb = Epi::PERM ? ((R & ~31) + perm32(R & 31)) : R;
        voffA[i] = (unsigned)(R * K + C) * 2u; voffB[i] = (unsigned)(Rb * K + C) * 2u; }
    const size_t kstep = (size_t)(BK * 2);
    const size_t hstep = (size_t)HALF * K * 2;
    const size_t tstep = 2 * hstep;
    const unsigned ldsw = (unsigned)wid * 1024u;
    const int aoff = lds_byte(wr * 64 + fr, fq * 8), boff = lds_byte(wc * 32 + fr, fq * 8);
#define PG8_SA(b, h) (((b) * 2 + (h)) * HTB)
#define PG8_SB(b, h) ((4 + (b) * 2 + (h)) * HTB)
#define PG8_STAGE(bufoff, gbase, voff) do { _Pragma("unroll") for (int _i = 0; _i < 2; ++_i) \
        __builtin_amdgcn_global_load_lds((const unsigned*)((const char*)(gbase) + (voff)[_i]), (PG8_LAS unsigned*)(lds + (bufoff) + ldsw + _i * 8192), 16, 0, 0); } while (0)
#define PG8_LDA(dst, b, h) do { _Pragma("unroll") for (int m = 0; m < 4; ++m) _Pragma("unroll") for (int k = 0; k < 2; ++k) dst[m][k] = *(const PG8_LAS bf16x8*)(lds + PG8_SA(b, h) + aoff + m * 2048 + k * 1024); } while (0)
#define PG8_LDB(dst, b, h) do { _Pragma("unroll") for (int n = 0; n < 2; ++n) _Pragma("unroll") for (int k = 0; k < 2; ++k) dst[n][k] = *(const PG8_LAS bf16x8*)(lds + PG8_SB(b, h) + boff + n * 2048 + k * 1024); } while (0)
#define PG8_MMA(ai, bj, At, Bt) do { __builtin_amdgcn_s_setprio(1); _Pragma("unroll") for (int m = 0; m < 4; ++m) _Pragma("unroll") for (int n = 0; n < 2; ++n) _Pragma("unroll") for (int k = 0; k < 2; ++k) \
        acc[ai][bj][m][n] = TR ? __builtin_amdgcn_mfma_f32_16x16x32_bf16(Bt[n][k], At[m][k], acc[ai][bj][m][n], 0, 0, 0) : __builtin_amdgcn_mfma_f32_16x16x32_bf16(At[m][k], Bt[n][k], acc[ai][bj][m][n], 0, 0, 0); __builtin_amdgcn_s_setprio(0); } while (0)
#define PG8_WAIT_V(n) asm volatile("s_waitcnt vmcnt(" #n ")" ::: "memory")
#define PG8_WAIT_L(n) asm volatile("s_waitcnt lgkmcnt(" #n ")" ::: "memory")
#define PG8_BAR __builtin_amdgcn_s_barrier()
#define PG8_SCHED __builtin_amdgcn_sched_barrier(0)
    Unit cur, nxt; int ui = 0;
    if (!S.next(0, cur)) return;
    f32x4 acc[2][2][4][2];
#pragma unroll
    for (int a = 0; a < 2; ++a)
#pragma unroll
        for (int b = 0; b < 2; ++b)
#pragma unroll
            for (int m = 0; m < 4; ++m)
#pragma unroll
                for (int n = 0; n < 2; ++n) acc[a][b][m][n] = (f32x4){0.f, 0.f, 0.f, 0.f};
    bf16x8 At[4][2], B0[2][2], B1[2][2];
    const char* cA = (const char*)g.A + (size_t)cur.pm * tstep; const char* cB = (const char*)g.Bt + (size_t)cur.pn * tstep;
    S.a_ready(cur);
    if constexpr (SP2) {
        PG8_STAGE(PG8_SB(0, 0), cB, voffB); PG8_STAGE(PG8_SB(0, 1), cB + hstep, voffB); PG8_STAGE(PG8_SA(0, 0), cA, voffA); PG8_STAGE(PG8_SA(0, 1), cA + hstep, voffA);
        if (wr == 1) PG8_BAR;
        PG8_WAIT_V(2); PG8_BAR;
        PG8_STAGE(PG8_SB(1, 0), cB + kstep, voffB); PG8_STAGE(PG8_SA(1, 0), cA + kstep, voffA); PG8_STAGE(PG8_SB(1, 1), cB + hstep + kstep, voffB);
        PG8_WAIT_V(6); PG8_BAR;
    } else {
        PG8_STAGE(PG8_SB(0, 0), cB, voffB); PG8_STAGE(PG8_SA(0, 0), cA, voffA); PG8_STAGE(PG8_SB(0, 1), cB + hstep, voffB); PG8_STAGE(PG8_SA(0, 1), cA + hstep, voffA);
        if (wr == 1) PG8_BAR;
        PG8_WAIT_V(4); PG8_BAR;
        PG8_STAGE(PG8_SB(1, 0), cB + kstep, voffB); PG8_STAGE(PG8_SA(1, 0), cA + kstep, voffA); PG8_STAGE(PG8_SB(1, 1), cB + hstep + kstep, voffB);
        PG8_WAIT_V(6); PG8_BAR;
    }
    for (;;) {
        const bool has_next = S.next(ui + 1, nxt);
        const char* nA = has_next ? (const char*)g.A + (size_t)nxt.pm * tstep : cA; const char* nB = has_next ? (const char*)g.Bt + (size_t)nxt.pn * tstep : cB;
        for (int t = 0; t < nt; t += 2) {
            const bool last = (t == nt - 2);
            const char* a1 = cA + (size_t)(t + 1) * kstep;
            const char* a2 = last ? nA : cA + (size_t)(t + 2) * kstep; const char* b2 = last ? nB : cB + (size_t)(t + 2) * kstep;
            const char* a3 = a2 + kstep; const char* b3 = b2 + kstep;
            if (last && has_next) S.a_ready(nxt);
            if constexpr (SP2) {
            PG8_LDB(B0, 0, 0); PG8_LDB(B1, 0, 1); PG8_SCHED; PG8_LDA(At, 0, 0); PG8_STAGE(PG8_SA(1, 1), a1 + hstep, voffA);
            PG8_WAIT_V(8); PG8_WAIT_L(0); PG8_BAR; PG8_MMA(0, 0, At, B0); PG8_MMA(0, 1, At, B1); PG8_BAR; PG8_SCHED;
            PG8_LDA(At, 0, 1); PG8_STAGE(PG8_SB(0, 0), b2, voffB); PG8_STAGE(PG8_SB(0, 1), b2 + hstep, voffB); PG8_STAGE(PG8_SA(0, 0), a2, voffA);
            PG8_WAIT_V(8); PG8_WAIT_L(0); PG8_BAR; PG8_MMA(1, 0, At, B0); PG8_MMA(1, 1, At, B1); PG8_BAR; PG8_SCHED;
            PG8_LDB(B0, 1, 0); PG8_LDB(B1, 1, 1); PG8_SCHED; PG8_LDA(At, 1, 0); PG8_STAGE(PG8_SA(0, 1), a2 + hstep, voffA);
            PG8_WAIT_V(8); PG8_WAIT_L(0); PG8_BAR; PG8_MMA(0, 0, At, B0); PG8_MMA(0, 1, At, B1); PG8_BAR; PG8_SCHED;
            PG8_LDA(At, 1, 1); PG8_STAGE(PG8_SB(1, 0), b3, voffB); PG8_STAGE(PG8_SB(1, 1), b3 + hstep, voffB); PG8_STAGE(PG8_SA(1, 0), a3, voffA);
            PG8_WAIT_V(8); PG8_WAIT_L(0); PG8_BAR; PG8_MMA(1, 0, At, B0); PG8_MMA(1, 1, At, B1); PG8_BAR; PG8_SCHED;
            } else {
            PG8_LDB(B0, 0, 0); PG8_SCHED; PG8_LDA(At, 0, 0); PG8_STAGE(PG8_SA(1, 1), a1 + hstep, voffA);
            PG8_WAIT_L(8); PG8_BAR; PG8_WAIT_L(0); PG8_MMA(0, 0, At, B0); PG8_BAR; PG8_SCHED;
            PG8_LDB(B1, 0, 1); PG8_STAGE(PG8_SB(0, 0), b2, voffB);
            PG8_BAR; PG8_WAIT_L(0); PG8_MMA(0, 1, At, B1); PG8_BAR;
            PG8_LDA(At, 0, 1); PG8_STAGE(PG8_SA(0, 0), a2, voffA);
            PG8_BAR; PG8_WAIT_L(0); PG8_MMA(1, 0, At, B0); PG8_BAR; PG8_SCHED;
            PG8_STAGE(PG8_SB(0, 1), b2 + hstep, voffB);
            PG8_WAIT_V(6); PG8_BAR; PG8_MMA(1, 1, At, B1); PG8_BAR;
            PG8_LDB(B0, 1, 0); PG8_SCHED; PG8_LDA(At, 1, 0); PG8_STAGE(PG8_SA(0, 1), a2 + hstep, voffA);
            PG8_WAIT_L(8); PG8_BAR; PG8_WAIT_L(0); PG8_MMA(0, 0, At, B0); PG8_BAR; PG8_SCHED;
            PG8_LDB(B1, 1, 1); PG8_STAGE(PG8_SB(1, 0), b3, voffB);
            PG8_BAR; PG8_WAIT_L(0); PG8_MMA(0, 1, At, B1); PG8_BAR;
            PG8_LDA(At, 1, 1); PG8_STAGE(PG8_SA(1, 0), a3, voffA);
            PG8_BAR; PG8_WAIT_L(0); PG8_MMA(1, 0, At, B0); PG8_BAR; PG8_SCHED;
            PG8_STAGE(PG8_SB(1, 1), b3 + hstep, voffB);
            PG8_WAIT_V(6); PG8_BAR; PG8_MMA(1, 1, At, B1); PG8_BAR;
            }
        }
        if constexpr (ALIGN_EPI) { if (wr == 0) PG8_BAR; }
        if constexpr (!Epi::AFTER_DRAIN) { E(acc, cur, wr, wc, fr, fq); S.done(cur); }
        if (!has_next) break;
#pragma unroll
        for (int a = 0; a < 2; ++a)
#pragma unroll
            for (int b = 0; b < 2; ++b)
#pragma unroll
                for (int m = 0; m < 4; ++m)
#pragma unroll
                    for (int n = 0; n < 2; ++n) acc[a][b][m][n] = (f32x4){0.f, 0.f, 0.f, 0.f};
        cur = nxt; cA = nA; cB = nB; ++ui;
        if constexpr (ALIGN_EPI) { if (wr == 1) PG8_BAR; }
    }
    PG8_WAIT_V(0);
    if constexpr (!ALIGN_EPI) { if (wr == 0) PG8_BAR; }
    PG8_BAR;
    if constexpr (Epi::AFTER_DRAIN) { E.fused(acc, cur, wr, wc, fr, fq, lds, wid, lane); S.done(cur); }
#undef PG8_SA
#undef PG8_SB
#undef PG8_STAGE
#undef PG8_LDA
#undef PG8_LDB
#undef PG8_MMA
#undef PG8_WAIT_V
#undef PG8_WAIT_L
#undef PG8_BAR
#undef PG8_SCHED
}
}
#define GAS __attribute__((address_space(1)))
#define LAS __attribute__((address_space(3)))
typedef unsigned short bf16;
typedef unsigned v4u __attribute__((ext_vector_type(4)));
typedef float f32x4 __attribute__((ext_vector_type(4)));
typedef short bf16x8 __attribute__((ext_vector_type(8)));
typedef GAS unsigned gu32;
typedef GAS unsigned long long gu64;
#define RLX_AGENT __ATOMIC_RELAXED, __HIP_MEMORY_SCOPE_AGENT
#define LDS_WAIT() asm volatile("s_waitcnt lgkmcnt(0)" ::: "memory")
#define VM_WAIT() asm volatile("s_waitcnt vmcnt(0)" ::: "memory")
__device__ __forceinline__ unsigned long long rt() { return __builtin_amdgcn_s_memrealtime(); }
__device__ __forceinline__ unsigned f2bf(float f) { unsigned u = __builtin_bit_cast(unsigned, f); return (u + 0x7fffu + ((u >> 16) & 1u)) >> 16; }
__device__ __forceinline__ unsigned pk2(float lo, float hi) { return f2bf(lo) | (f2bf(hi) << 16); }
#define XB_TMO      128
#define XB_XCNT(j)  (256  + 64 * (j))
#define XB_XSUB(j)  (1280 + 64 * (j))
#define XB_XGEN(j)  (2304 + 64 * (j))
#define XB_TOP      3328
#define XB_TOPGEN   3392
#define XCD_BAR_WORDS 3456
#define XB_SPIN_CAP (1u << 18)

__device__ __forceinline__ unsigned xb_ld(unsigned* p)              { return __hip_atomic_load(p, __ATOMIC_RELAXED, __HIP_MEMORY_SCOPE_AGENT); }
__device__ __forceinline__ unsigned xb_add(unsigned* p, unsigned v) { return __hip_atomic_fetch_add(p, v, __ATOMIC_RELAXED, __HIP_MEMORY_SCOPE_AGENT); }
__device__ __forceinline__ unsigned xb_xcc_id() { return (unsigned)__builtin_amdgcn_s_getreg((3 << 11) | 20) & 0xFu; }
#define XB_SPIN(cond, bar) do { unsigned _sp = 0; while (cond) { __builtin_amdgcn_s_sleep(1); \
    if ((++_sp & 255u) == 0u) { if (xb_ld(&(bar)[XB_TMO])) break; if (_sp > XB_SPIN_CAP) { atomicAdd(&(bar)[XB_TMO], 1u); break; } } } } while (0)

struct XcdBarrier {
    unsigned* bar; unsigned x;
    volatile LAS unsigned* st;
};

__device__ __forceinline__ XcdBarrier xcd_barrier_post(unsigned* bar, volatile LAS unsigned* st) {
    XcdBarrier b; b.bar = bar; b.x = xb_xcc_id(); b.st = st;
    if (threadIdx.x == 0) (void)xb_add(&bar[XB_XCNT(b.x)], 1u);
    return b;
}
__device__ __forceinline__ void xcd_barrier_complete(unsigned* bar, unsigned x, unsigned& nloc, unsigned& nx) {
    const unsigned G = gridDim.x * gridDim.y * gridDim.z;
    unsigned sum, cnt, mine, sp = 0u;
    for (;;) {
        sum = 0u; cnt = 0u; mine = 0u;
#pragma unroll
        for (unsigned j = 0; j < 16; ++j) { const unsigned c = xb_ld(&bar[XB_XCNT(j)]); sum += c; cnt += (c > 0u) ? 1u : 0u; mine = (j == x) ? c : mine; }
        if (sum == G) break;
        __builtin_amdgcn_s_sleep(1);
        if ((++sp & 255u) == 0u) { if (xb_ld(&bar[XB_TMO])) break; if (sp > XB_SPIN_CAP) { atomicAdd(&bar[XB_TMO], 1u); break; } }
    }
    nloc = mine > 0u ? mine : 1u; nx = cnt > 0u ? cnt : 1u;
}

__device__ __forceinline__ void xcd_barrier(const XcdBarrier& b) {
    asm volatile("s_waitcnt vmcnt(0)" ::: "memory");
    __syncthreads();
    if (threadIdx.x == 0) {
        unsigned* bar = b.bar;
        __builtin_amdgcn_s_waitcnt(0);
        unsigned nloc = b.st[0], nx = b.st[1];
        if (nloc == 0u) { xcd_barrier_complete(bar, b.x, nloc, nx); b.st[0] = nloc; b.st[1] = nx; }
        const unsigned old = xb_add(&bar[XB_XSUB(b.x)], 1u);
        const unsigned gen = old / nloc;
        if (old + 1u == (gen + 1u) * nloc) {
            __builtin_amdgcn_fence(__ATOMIC_RELEASE, "agent");
            asm volatile("s_waitcnt vmcnt(0)" ::: "memory");
            const unsigned og = xb_add(&bar[XB_TOP], 1u);
            const unsigned tg = og / nx;
            if (og + 1u == (tg + 1u) * nx) xb_add(&bar[XB_TOPGEN], 1u);
            else XB_SPIN(xb_ld(&bar[XB_TOPGEN]) == tg, bar);
            __builtin_amdgcn_fence(__ATOMIC_ACQUIRE, "agent");
            xb_add(&bar[XB_XGEN(b.x)], 1u);
            asm volatile("s_waitcnt vmcnt(0)" ::: "memory");
        } else {
            XB_SPIN(xb_ld(&bar[XB_XGEN(b.x)]) == gen, bar);
            __builtin_amdgcn_fence(__ATOMIC_ACQUIRE, "agent");
            asm volatile("s_waitcnt vmcnt(0)" ::: "memory");
        }
    }
    __syncthreads();
}
#define REP_MASK 0u
#ifndef PG8_SP2
#define PG8_SP2 true
#endif
#ifndef PG8_ALIGN
#define PG8_ALIGN true
#endif
constexpr int NWAVES = 8, NTHR = NWAVES * 64;
constexpr int BATCH = 4, SEQ = 2048, DM = 4096, NMETA = 16;
constexpr int MR = BATCH * SEQ;
constexpr int MROWS = MR + NMETA;
constexpr int MT = 8448;
constexpr int NIN = 32784;
constexpr int N1 = 33024;
constexpr int DFF = 11008, NF = 2 * DFF;
constexpr int RET_H = 8, RET_DK = 256, RET_DV = 512, GLA_H = 4, GLA_DK = 512, GLA_DV = 1024, GLA_RANK = 16;
constexpr float EPS = 1e-6f;
constexpr int C_QR = 0, C_QG = 2048, C_KG = 4096, C_GR = 6144, C_GG = 14336, C_B = 22528, C_KR = 22528, C_V = 24576, C_Z = 32768, LDP = 4096, P_QG = 0, P_KG = 2048;
constexpr int NPH = 11;
#ifndef MK_N_LAUNCHES
#define MK_N_LAUNCHES 1
#endif
constexpr int N_LAUNCHES = MK_N_LAUNCHES;

constexpr size_t al256(size_t x) { return (x + 255) & ~(size_t)255; }
constexpr size_t WS_CTL = 0, CTL_ZERO_BYTES = 1u << 20;
constexpr size_t WS_W1T = WS_CTL + CTL_ZERO_BYTES;
constexpr size_t WS_WOT = WS_W1T + al256((size_t)N1 * DM * 2);
constexpr size_t WS_WFT = WS_WOT + al256((size_t)DM * DM * 2);
constexpr size_t WS_W2T = WS_WFT + al256((size_t)NF * DM * 2);
constexpr size_t WS_XB  = WS_W2T + al256((size_t)DM * DFF * 2);
constexpr size_t WS_RS1 = WS_XB + al256((size_t)MT * DM * 2);
constexpr size_t WS_RS2 = WS_RS1 + al256((size_t)MT * 4);
constexpr size_t WS_ZB  = WS_RS2 + al256((size_t)MT * 4);
constexpr size_t WS_COS = WS_ZB + al256((size_t)MT * 16 * 4);
constexpr size_t WS_SIN = WS_COS + al256((size_t)MROWS * 128 * 4);
constexpr size_t WS_COST = WS_SIN + al256((size_t)MROWS * 128 * 4);
constexpr size_t WS_SINT = WS_COST + (size_t)128 * MT * 4;
constexpr size_t WS_PROJ = WS_SINT + (size_t)128 * MT * 4;
constexpr size_t WS_UG  = WS_PROJ;
constexpr size_t WS_ACT = WS_UG + al256((size_t)MT * NF * 2);
constexpr size_t WS_YR  = WS_PROJ + al256((size_t)MT * N1 * 2);
constexpr size_t WS_YG  = WS_YR + al256((size_t)MROWS * DM * 2);
constexpr size_t WS_GR  = WS_YG + al256((size_t)MROWS * DM * 2);
constexpr size_t WS_GG  = WS_GR + al256((size_t)MT * DM * 2);
constexpr size_t WS_MRG = WS_GG + al256((size_t)MT * DM * 2);
constexpr size_t WS_H1  = WS_MRG + al256((size_t)MT * DM * 2);
constexpr size_t WS_H1B = WS_H1 + al256((size_t)MT * DM * 4);
constexpr size_t WS_QFG = WS_H1B + al256((size_t)MT * DM * 2);
constexpr size_t WS_KFG = WS_QFG + (size_t)4 * 4 * 33 * 65536;
constexpr size_t WS_QFR = WS_KFG + (size_t)4 * 4 * 33 * 65536;
constexpr size_t WS_KFR = WS_QFR + (size_t)4 * 8 * 33 * 32768;
constexpr size_t WS_VFG = WS_KFR + (size_t)4 * 8 * 33 * 32768;
constexpr size_t WS_VFR = WS_VFG + (size_t)4 * 33 * 64 * 8192;
constexpr size_t WS_PFG = WS_VFR + (size_t)4 * 33 * 64 * 8192;
constexpr size_t WS_PFR = WS_PFG + (size_t)4 * 4 * 33 * 8192;
constexpr size_t WS_DECG = WS_PFR + (size_t)4 * 8 * 33 * 8192;
constexpr size_t WS_UPH = WS_DECG + (size_t)4 * 4 * 33 * 512 * 4;
constexpr size_t WS_PARTC = WS_UPH + (size_t)32 * 2 * DFF * 4;
constexpr size_t WS_PARTG = WS_PARTC + (size_t)32 * 2 * DFF * 4;
constexpr size_t WS_UPM = WS_PARTG + (size_t)32 * 2 * DFF * 4;
constexpr size_t WS_END = WS_UPM + (size_t)2 * DFF * 4;
static_assert(WS_ACT + (size_t)MR * DFF * 2 <= WS_YR, "UG | ACT overlay fits inside PROJ");
static_assert(WS_END <= (size_t)4 * 4096 * NIN * 4, "workspace map fits 4 x the largest tensor");
constexpr int CW_TMO = 0, CW_CODE = 1, CW_BAR = 4096, CW_SS2 = 8192;

constexpr int RING_OFF = 0, RING_BYTES = 131072;
constexpr int LDS_BYTES = 163840;
constexpr int LDSCTL_OFF = LDS_BYTES - 1024, MISC_OFF = LDSCTL_OFF + 320;
static_assert(MISC_OFF + 128 <= LDS_BYTES, "LDS map");

__device__ __forceinline__ float bf2f(bf16 v) { return __builtin_bit_cast(float, (unsigned)v << 16); }
__device__ __forceinline__ float wave_sum(float v) {
#pragma unroll
    for (int o = 1; o < 64; o <<= 1) v += __shfl_xor(v, o);
    return v;
}
__device__ __forceinline__ float sigm(float x) { return 1.f / (1.f + __expf(-x)); }
__device__ __forceinline__ float silu(float x) { return x / (1.f + __expf(-x)); }
__device__ __forceinline__ float logsig(float x) { return fminf(x, 0.f) - __logf(1.0f + __expf(-fabsf(x))); }

typedef float f32x16 __attribute__((ext_vector_type(16)));
#define MFMA32(a, b, c) __builtin_amdgcn_mfma_f32_32x32x16_bf16((a), (b), (c), 0, 0, 0)
__device__ __forceinline__ unsigned pkbf(float lo, float hi) { typedef __bf16 b2 __attribute__((ext_vector_type(2))); typedef float f2 __attribute__((ext_vector_type(2))); return __builtin_bit_cast(unsigned, __builtin_convertvector((f2){lo, hi}, b2)); }
__device__ __forceinline__ bf16 f2b(float x) { return (bf16)(pkbf(x, 0.f) & 0xffffu); }
__device__ __forceinline__ int chunk_row(int b, int n, int i) { return n == 0 ? (i < 48 ? -1 : MR + i - 48) : b * SEQ + 64 * (n - 1) + i; }

struct Frame {
    LAS unsigned char* lds;
    volatile LAS unsigned* MISC;
    gu32* ctl;
    int tid, lane, wave, G;
    const float *x, *meta, *attn_norm, *w_in, *w_gate_up, *b_gate, *ret_norm, *gla_norm, *w_out, *ffn_norm, *w_ffn_in, *conv_w, *conv_b, *w_ffn_out, *final_norm;
    const int* positions;
    float* out;
    bf16 *W1t, *Wot, *Wft, *W2t, *XB, *PROJ, *UG, *ACT, *MRG, *H1B;
    float *RS1, *SS2, *ZB, *COS, *SIN, *COST, *SINT, *H1, *DECG, *UPH, *PARTC, *PARTG, *UPM;
    bf16 *YR, *YG, *GR, *GG, *QFG, *KFG, *QFR, *KFR, *VFG, *VFR, *PFG, *PFR;
};

namespace pg8 {
__device__ __forceinline__ float gate2(float o, float m) { return o * __builtin_amdgcn_rcpf((1.0f + __expf(-o)) * (1.0f + __expf(-m))); }
typedef unsigned long long u64_t;
__device__ __forceinline__ u64_t pk4(const f32x4& v) { return (u64_t)cvt_pk_bf16(v[0], v[1]) | ((u64_t)cvt_pk_bf16(v[2], v[3]) << 32); }
struct EpiA {
    static constexpr bool PERM = true, AFTER_DRAIN = false;
    bf16_t* O; const float* rs; const float* cs; const float* sn; unsigned char* QFR; bf16_t* GR; bf16_t* GG;
    __device__ __forceinline__ void operator()(const f32x4 (&acc)[2][2][4][2], const Unit& u, int wr, int wc, int fr, int fq) const {
        const int row0 = u.pm * BM + wr * 64 + fr;
        if (u.pn < 8) {
            const int h = u.pn, b = u.pm >> 3; const float l2g = __log2f(1.0f - exp2f(-5.0f - (float)h));
#pragma unroll
            for (int ai = 0; ai < 2; ++ai) { const size_t cb = (size_t)(b * 8 + h) * 33 + 1 + 4 * (u.pm & 7) + 2 * ai + wr;
                unsigned char* qb = QFR + (cb * 8 + wc) * 4096 + (fq >> 1) * 2048 + fr * 16 + 8 * (fq & 1);
#pragma unroll
                for (int m = 0; m < 4; ++m) { const int row = row0 + ai * HALF + m * 16; const float dq = exp2f((float)(16 * m + fr + 1) * l2g) * rs[row];
                    const float* cp = cs + (size_t)row * 128 + wc * 32 + 8 * fq; const float* sp = sn + (size_t)row * 128 + wc * 32 + 8 * fq;
#pragma unroll
                    for (int n = 0; n < 2; ++n) { const f32x4 c = *(const f32x4*)(cp + 4 * n), s4 = *(const f32x4*)(sp + 4 * n), x1 = acc[ai][0][m][n], x2 = acc[ai][1][m][n];
                        const f32x4 o1 = (x1 * c - x2 * s4) * dq, o2 = (x2 * c + x1 * s4) * dq;
                        unsigned char* d = qb + (m >> 1) * 1024 + (16 * (m & 1) + 32 * n) * 16;
                        *(u64_t*)d = pk4(o1); *(u64_t*)(d + 4 * 4096) = pk4(o2); }
                    asm volatile("" ::: "memory"); } }
        } else if (u.pn < 24) {
            const int col0 = (u.pn - 8) * BM + wc * 32 + 8 * fq;
#pragma unroll
            for (int ai = 0; ai < 2; ++ai)
#pragma unroll
                for (int m = 0; m < 4; ++m) { const int row = row0 + ai * HALF + m * 16; const float s = rs[row]; bf16_t* rowp = O + (size_t)row * LDP + col0;
#pragma unroll
                    for (int bj = 0; bj < 2; ++bj) { const f32x4 v0 = acc[ai][bj][m][0] * s, v1 = acc[ai][bj][m][1] * s;
                        u32x4 w; w.x = cvt_pk_bf16(v0[0], v0[1]); w.y = cvt_pk_bf16(v0[2], v0[3]); w.z = cvt_pk_bf16(v1[0], v1[1]); w.w = cvt_pk_bf16(v1[2], v1[3]);
                        *(u32x4*)(rowp + bj * HALF) = w; } }
        } else {
            bf16_t* G = u.pn < 56 ? GR : GG; const int col0 = 128 * ((u.pn - 24) & 31) + wc * 32 + 8 * fq;
#pragma unroll
            for (int ai = 0; ai < 2; ++ai)
#pragma unroll
                for (int m = 0; m < 4; ++m) { const int row = row0 + ai * HALF + m * 16; const float s = rs[row];
                    const f32x4 o0 = acc[ai][0][m][0] * s, o1 = acc[ai][0][m][1] * s, m0 = acc[ai][1][m][0] * s, m1 = acc[ai][1][m][1] * s;
                    u32x4 w; w.x = cvt_pk_bf16(gate2(o0[0], m0[0]), gate2(o0[1], m0[1])); w.y = cvt_pk_bf16(gate2(o0[2], m0[2]), gate2(o0[3], m0[3]));
                    w.z = cvt_pk_bf16(gate2(o1[0], m1[0]), gate2(o1[1], m1[1])); w.w = cvt_pk_bf16(gate2(o1[2], m1[2]), gate2(o1[3], m1[3]));
                    *(u32x4*)(G + (size_t)row * DM + col0) = w; }
        }
    }
};
struct EpiB {
    static constexpr bool PERM = false, AFTER_DRAIN = false;
    unsigned char* VFR; unsigned char* VFG; unsigned char* KFR; const float* rs; const float* cst; const float* snt;
    __device__ __forceinline__ void operator()(const f32x4 (&acc)[2][2][4][2], const Unit& u, int wr, int wc, int fr, int fq) const {
        const int b = u.pm >> 3;
        if (u.pn < 8) {
            const int h = u.pn; const float l2g = __log2f(1.0f - exp2f(-5.0f - (float)h));
#pragma unroll
            for (int ai = 0; ai < 2; ++ai) { const size_t cb = (size_t)(b * 8 + h) * 33 + 1 + 4 * (u.pm & 7) + 2 * ai + wr;
                unsigned char* kb = KFR + (cb * 8 + wc) * 4096 + (fr + 32 * (fq & 1)) * 16 + 8 * (fq >> 1);
#pragma unroll
                for (int m = 0; m < 4; ++m) { const int rowb = u.pm * BM + ai * HALF + wr * 64 + m * 16 + 4 * fq; const f32x4 s4 = *(const f32x4*)(rs + rowb); f32x4 dk4;
#pragma unroll
                    for (int e = 0; e < 4; ++e) dk4[e] = exp2f(-(float)(16 * m + 4 * fq + e + 1) * l2g) * 0.0625f * s4[e];
#pragma unroll
                    for (int n = 0; n < 2; ++n) { const int idx = wc * 32 + n * 16 + fr;
                        const f32x4 c = *(const f32x4*)(cst + (size_t)idx * MT + rowb), sn4 = *(const f32x4*)(snt + (size_t)idx * MT + rowb), x1 = acc[ai][0][m][n], x2 = acc[ai][1][m][n];
                        const f32x4 o1 = (x1 * c - x2 * sn4) * dk4, o2 = (x2 * c + x1 * sn4) * dk4;
                        unsigned char* d = kb + m * 1024 + n * 256;
                        *(u64_t*)d = pk4(o1); *(u64_t*)(d + 4 * 4096) = pk4(o2); }
                    asm volatile("" ::: "memory"); } }
        } else {
            const int pv = u.pn - 8; unsigned char* VF = pv < 16 ? VFR : VFG;
#pragma unroll
            for (int ai = 0; ai < 2; ++ai) { const int nc = 1 + 4 * (u.pm & 7) + 2 * ai + wr;
#pragma unroll
                for (int m = 0; m < 4; ++m) { const f32x4 s4 = *(const f32x4*)(rs + u.pm * BM + ai * HALF + wr * 64 + m * 16 + 4 * fq);
#pragma unroll
                    for (int bj = 0; bj < 2; ++bj) { const int slg = 4 * (pv & 15) + 2 * bj + (wc >> 1);
                        unsigned char* fb = VF + ((((size_t)b * 33 + nc) * 64 + slg) * 8 + (wc & 1) * 4 + m) * 1024 + (fr + 32 * (fq & 1)) * 16 + 8 * (fq >> 1);
#pragma unroll
                        for (int n = 0; n < 2; ++n) { const f32x4 v = acc[ai][bj][m][n] * s4; *(u64_t*)(fb + n * 256) = pk4(v); } } } }
        }
    }
};
struct EpiScaleBf16 {
    static constexpr bool PERM = true, AFTER_DRAIN = false;
    bf16_t* O; int ldc; const float* ss;
    __device__ __forceinline__ void operator()(const f32x4 (&acc)[2][2][4][2], const Unit& u, int wr, int wc, int fr, int fq) const {
        const int row0 = u.pm * BM + wr * 64 + fr, col0 = u.pn * BM + wc * 32 + 8 * fq;
#pragma unroll
        for (int ai = 0; ai < 2; ++ai)
#pragma unroll
            for (int m = 0; m < 4; ++m) { const int row = row0 + ai * HALF + m * 16; const float s = 1.0f / sqrtf(ss[row] * (1.0f / 4096.0f) + 1e-6f); bf16_t* rowp = O + (size_t)row * ldc + col0;
#pragma unroll
                for (int bj = 0; bj < 2; ++bj) { const f32x4 v0 = acc[ai][bj][m][0] * s, v1 = acc[ai][bj][m][1] * s;
                    u32x4 w; w.x = cvt_pk_bf16(v0[0], v0[1]); w.y = cvt_pk_bf16(v0[2], v0[3]); w.z = cvt_pk_bf16(v1[0], v1[1]); w.w = cvt_pk_bf16(v1[2], v1[3]);
                    *(u32x4*)(rowp + bj * HALF) = w; } }
    }
};
struct EpiFfn {
    static constexpr bool PERM = true, AFTER_DRAIN = false;
    bf16_t* ACT; const float* ss; const float* cw; const float* cbias; float* UPH; float* PARTC; float* PARTG; PG8_LAS float* hl;
    __device__ __forceinline__ void operator()(const f32x4 (&acc)[2][2][4][2], const Unit& u, int wr, int wc, int fr, int fq) const {
        const int ch0 = wc * 32 + 8 * fq, cg = 128 * u.pn + ch0;
        f32x4 w0[2], w1[2], w2[2], cb[2];
#pragma unroll
        for (int n = 0; n < 2; ++n) { w0[n] = *(const f32x4*)(cw + cg + 4 * n); w1[n] = *(const f32x4*)(cw + DFF + cg + 4 * n); w2[n] = *(const f32x4*)(cw + 2 * DFF + cg + 4 * n); cb[n] = *(const f32x4*)(cbias + cg + 4 * n); }
        float rsv[2][4];
#pragma unroll
        for (int ai = 0; ai < 2; ++ai)
#pragma unroll
            for (int m = 0; m < 4; ++m) rsv[ai][m] = 1.0f / sqrtf(ss[u.pm * BM + ai * HALF + wr * 64 + m * 16 + fr] * (1.0f / 4096.0f) + 1e-6f);
        if (fr >= 14) {
#pragma unroll
            for (int ai = 0; ai < 2; ++ai)
#pragma unroll
                for (int n = 0; n < 2; ++n) { const f32x4 v = acc[ai][0][3][n] * rsv[ai][3];
                    *(PG8_LAS f32x4*)(hl + ((2 * ai + wr) * 2 + (fr - 14)) * 128 + ch0 + 4 * n) = v;
                    if (ai == 1 && wr == 1) *(f32x4*)(UPH + ((size_t)u.pm * 2 + (fr - 14)) * DFF + cg + 4 * n) = v; }
        }
        asm volatile("s_waitcnt lgkmcnt(0)" ::: "memory"); __builtin_amdgcn_s_barrier(); asm volatile("" ::: "memory");
#pragma unroll
        for (int ai = 0; ai < 2; ++ai) { const int bl = 2 * ai + wr;
            f32x4 p1[2], p2[2];
#pragma unroll
            for (int n = 0; n < 2; ++n) { p1[n] = (f32x4){0.f, 0.f, 0.f, 0.f}; p2[n] = p1[n];
                if (bl > 0) { const f32x4 r62 = *(const PG8_LAS f32x4*)(hl + ((bl - 1) * 2 + 0) * 128 + ch0 + 4 * n), r63 = *(const PG8_LAS f32x4*)(hl + ((bl - 1) * 2 + 1) * 128 + ch0 + 4 * n);
                    p1[n] = r63; p2[n] = fr == 0 ? r62 : r63; } }
#pragma unroll
            for (int m = 0; m < 4; ++m) { const int row = u.pm * BM + ai * HALF + wr * 64 + m * 16 + fr; float res[8];
#pragma unroll
                for (int n = 0; n < 2; ++n) { const f32x4 up0 = acc[ai][0][m][n] * rsv[ai][m], gt = acc[ai][1][m][n] * rsv[ai][m]; f32x4 c1, c2, l15, l14;
#pragma unroll
                    for (int j = 0; j < 4; ++j) { c1[j] = __shfl_up(up0[j], 1, 16); c2[j] = __shfl_up(up0[j], 2, 16); l15[j] = __shfl(up0[j], 15, 16); l14[j] = __shfl(up0[j], 14, 16); }
                    const f32x4 up1 = fr >= 1 ? c1 : p1[n], up2 = fr >= 2 ? c2 : p2[n];
                    const f32x4 cc = cb[n] + w0[n] * up2 + w1[n] * up1 + w2[n] * up0;
                    if (bl == 0 && m == 0 && fr < 2) {
                        *(f32x4*)(PARTC + ((size_t)u.pm * 2 + fr) * DFF + cg + 4 * n) = cc; *(f32x4*)(PARTG + ((size_t)u.pm * 2 + fr) * DFF + cg + 4 * n) = gt; }
#pragma unroll
                    for (int j = 0; j < 4; ++j) res[4 * n + j] = cc[j] * __builtin_amdgcn_rcpf(1.0f + __expf(-cc[j])) * gt[j];
                    p1[n] = l15; p2[n] = fr == 0 ? l14 : l15; }
                u32x4 w; w.x = cvt_pk_bf16(res[0], res[1]); w.y = cvt_pk_bf16(res[2], res[3]); w.z = cvt_pk_bf16(res[4], res[5]); w.w = cvt_pk_bf16(res[6], res[7]);
                *(u32x4*)(ACT + (size_t)row * DFF + cg) = w; } }
    }
};
struct EpiResX {
    static constexpr bool PERM = true, AFTER_DRAIN = false;
    const float* x; const float* meta; float* out; bf16_t* outb; float* ss; int ldc; int nreal, nmeta;
    __device__ __forceinline__ void operator()(const f32x4 (&acc)[2][2][4][2], const Unit& u, int wr, int wc, int fr, int fq) const {
        const int row0 = u.pm * BM + wr * 64 + fr, col0 = u.pn * BM + wc * 32 + 8 * fq;
#pragma unroll
        for (int ai = 0; ai < 2; ++ai)
#pragma unroll
            for (int m = 0; m < 4; ++m) { const int row = row0 + ai * HALF + m * 16;
                const float* bp = row < nreal ? x + (size_t)row * ldc : (row < nreal + nmeta ? meta + (size_t)(row - nreal) * ldc : nullptr);
                float* rowp = out + (size_t)row * ldc + col0; bf16_t* rowb = outb + (size_t)row * ldc + col0; float q = 0.f;
#pragma unroll
                for (int bj = 0; bj < 2; ++bj) { f32x4 o0 = (f32x4){0.f, 0.f, 0.f, 0.f}, o1 = o0;
                    if (bp) { o0 = *(const f32x4*)(bp + col0 + bj * HALF) + acc[ai][bj][m][0]; o1 = *(const f32x4*)(bp + col0 + bj * HALF + 4) + acc[ai][bj][m][1]; }
                    *(f32x4*)(rowp + bj * HALF) = o0; *(f32x4*)(rowp + bj * HALF + 4) = o1;
                    u32x4 w; w.x = cvt_pk_bf16(o0[0], o0[1]); w.y = cvt_pk_bf16(o0[2], o0[3]); w.z = cvt_pk_bf16(o1[0], o1[1]); w.w = cvt_pk_bf16(o1[2], o1[3]);
                    *(u32x4*)(rowb + bj * HALF) = w;
                    q += (o0[0] * o0[0] + o0[1] * o0[1]) + (o0[2] * o0[2] + o0[3] * o0[3]) + (o1[0] * o1[0] + o1[1] * o1[1]) + (o1[2] * o1[2] + o1[3] * o1[3]); }
                q += __shfl_xor(q, 16); q += __shfl_xor(q, 32);
                if (fq == 0 && bp) atomicAdd(ss + row, q); }
    }
};
struct EpiResF32 {
    static constexpr bool PERM = false, AFTER_DRAIN = false;
    const float* base; float* out; int ldc;
    __device__ __forceinline__ void operator()(const f32x4 (&acc)[2][2][4][2], const Unit& u, int wr, int wc, int fr, int fq) const {
        const int row0 = u.pm * BM + wr * 64 + fr, col0 = u.pn * BM + wc * 32 + 4 * fq;
#pragma unroll
        for (int ai = 0; ai < 2; ++ai)
#pragma unroll
            for (int m = 0; m < 4; ++m) { const size_t off = (size_t)(row0 + ai * HALF + m * 16) * ldc + col0;
#pragma unroll
                for (int bj = 0; bj < 2; ++bj)
#pragma unroll
                    for (int n = 0; n < 2; ++n) *(f32x4*)(out + off + bj * HALF + n * 16) = *(const f32x4*)(base + off + bj * HALF + n * 16) + acc[ai][bj][m][n]; }
    }
};
}

struct TItem { const float* W; int K, ldw, c0, nc; bf16* WT; int row_off; const float* kscale; int item; int blk, bstride; };
__device__ __forceinline__ void titem_load(const TItem& t, f32x4 (&v)[16], int lane) {
    const int nblk = (t.nc + 63) / 64, kb = t.item / nblk, nb = t.item % nblk, k0 = 64 * kb, n = 64 * nb + 4 * (lane & 15);
    const bool ok = n < t.nc;
    const float* p = t.W + (size_t)(k0 + (lane >> 4)) * t.ldw + t.c0 + n;
#pragma unroll
    for (int i = 0; i < 16; ++i) v[i] = ok ? *(const f32x4*)(p + (size_t)(4 * i) * t.ldw) : (f32x4){0.f, 0.f, 0.f, 0.f};
}
__device__ __forceinline__ void titem_store(const TItem& t, const f32x4 (&v)[16], LAS float* scr, int lane) {
    const int nblk = (t.nc + 63) / 64, kb = t.item / nblk, nb = t.item % nblk, k0 = 64 * kb, n0 = 64 * nb;
#pragma unroll
    for (int i = 0; i < 16; ++i) { LAS float* d = scr + (4 * i + (lane >> 4)) * 65 + 4 * (lane & 15); d[0] = v[i].x; d[1] = v[i].y; d[2] = v[i].z; d[3] = v[i].w; }
    LDS_WAIT(); asm volatile("" ::: "memory");
    const int c = lane & 7;
    f32x4 s0 = (f32x4){1.f, 1.f, 1.f, 1.f}, s1 = s0;
    if (t.kscale) { s0 = *(const f32x4*)(t.kscale + k0 + 8 * c); s1 = *(const f32x4*)(t.kscale + k0 + 8 * c + 4); }
#pragma unroll
    for (int j = 0; j < 8; ++j) { const int nn = (lane >> 3) + 8 * j; const LAS float* s = scr + (8 * c) * 65 + nn;
        v4u o; o.x = pk2(s[0 * 65] * s0.x, s[1 * 65] * s0.y); o.y = pk2(s[2 * 65] * s0.z, s[3 * 65] * s0.w); o.z = pk2(s[4 * 65] * s1.x, s[5 * 65] * s1.y); o.w = pk2(s[6 * 65] * s1.z, s[7 * 65] * s1.w);
        const int nd = n0 + nn; *(GAS v4u*)(t.WT + (size_t)(t.row_off + (nd / t.blk) * t.bstride + nd % t.blk) * t.K + k0 + 8 * c) = o; }
    LDS_WAIT(); asm volatile("" ::: "memory");
}
__device__ __forceinline__ void p0_prologue(Frame& F) {
    LAS float* scr = (LAS float*)(F.lds + RING_OFF + F.wave * 17408);
    const int gw = blockIdx.x * NWAVES + F.wave, NGW = F.G * NWAVES;
    constexpr int BIG = 1 << 30;
    constexpr int I_2K = 64 * (2048 / 64), I_4K = 64 * (4096 / 64), I_Z = 64;
    constexpr int I_O = 64 * (DM / 64), I_F = 64 * (NF / 64), I_2 = (DFF / 64) * (DM / 64);
    constexpr int NITEMS = 4 * I_2K + 6 * I_4K + I_Z + I_O + I_F + I_2;
    auto mk = [&](int it) { TItem t; int r = it;
        if (r < I_2K) { t = TItem{F.w_in, DM, NIN, 0, 2048, F.W1t, C_QR, F.attn_norm, r, BIG, 0}; return t; } r -= I_2K;
        if (r < I_2K) { t = TItem{F.w_in, DM, NIN, 2048, 2048, F.W1t, C_KR, F.attn_norm, r, BIG, 0}; return t; } r -= I_2K;
        if (r < I_4K) { t = TItem{F.w_in, DM, NIN, 4096, 4096, F.W1t, C_V, F.attn_norm, r, BIG, 0}; return t; } r -= I_4K;
        if (r < I_4K) { t = TItem{F.w_in, DM, NIN, 8192, 4096, F.W1t, C_GR, F.attn_norm, r, 128, 256}; return t; } r -= I_4K;
        if (r < I_2K) { t = TItem{F.w_in, DM, NIN, 12288, 2048, F.W1t, C_QG, F.attn_norm, r, BIG, 0}; return t; } r -= I_2K;
        if (r < I_2K) { t = TItem{F.w_in, DM, NIN, 14336, 2048, F.W1t, C_KG, F.attn_norm, r, BIG, 0}; return t; } r -= I_2K;
        if (r < I_4K) { t = TItem{F.w_in, DM, NIN, 16384, 4096, F.W1t, C_V + 4096, F.attn_norm, r, BIG, 0}; return t; } r -= I_4K;
        if (r < I_4K) { t = TItem{F.w_in, DM, NIN, 20480, 4096, F.W1t, C_GG, F.attn_norm, r, 128, 256}; return t; } r -= I_4K;
        if (r < I_Z) { t = TItem{F.w_in, DM, NIN, 24576, 16, F.W1t, C_Z, F.attn_norm, r, BIG, 0}; return t; } r -= I_Z;
        if (r < I_4K) { t = TItem{F.w_in, DM, NIN, 24592, 4096, F.W1t, C_GR + 128, F.attn_norm, r, 128, 256}; return t; } r -= I_4K;
        if (r < I_4K) { t = TItem{F.w_in, DM, NIN, 28688, 4096, F.W1t, C_GG + 128, F.attn_norm, r, 128, 256}; return t; } r -= I_4K;
        if (r < I_O) { t = TItem{F.w_out, DM, DM, 0, DM, F.Wot, 0, nullptr, r, BIG, 0}; return t; } r -= I_O;
        if (r < I_F / 2) { t = TItem{F.w_ffn_in, DM, NF, 0, DFF, F.Wft, 0, F.ffn_norm, r, 128, 256}; return t; } r -= I_F / 2;
        if (r < I_F / 2) { t = TItem{F.w_ffn_in, DM, NF, DFF, DFF, F.Wft, 128, F.ffn_norm, r, 128, 256}; return t; } r -= I_F / 2;
        t = TItem{F.w_ffn_out, DFF, DM, 0, DM, F.W2t, 0, nullptr, r, BIG, 0}; return t; };
    if (gw < NITEMS) {
        f32x4 cur[16], nxt[16]; TItem tc = mk(gw); titem_load(tc, cur, F.lane);
        for (int it = gw; it < NITEMS; it += NGW) {
            const bool more = it + NGW < NITEMS; TItem tn = tc;
            if (more) { tn = mk(it + NGW); titem_load(tn, nxt, F.lane); }
            titem_store(tc, cur, scr, F.lane);
            if (more) {
#pragma unroll
                for (int i = 0; i < 16; ++i) cur[i] = nxt[i];
                tc = tn; }
        }
    }
    { const size_t n16 = (size_t)(N1 - C_Z - 64) * DM * 2 / 16; GAS v4u* p = (GAS v4u*)(F.W1t + (size_t)(C_Z + 64) * DM);
      for (size_t i = (size_t)blockIdx.x * NTHR + F.tid; i < n16; i += (size_t)F.G * NTHR) p[i] = (v4u){0u, 0u, 0u, 0u}; }
    { const size_t n16 = (size_t)64 * 8 * 1024 / 16;
      for (size_t i = (size_t)blockIdx.x * NTHR + F.tid; i < 2 * n16; i += (size_t)F.G * NTHR) ((GAS v4u*)(i < n16 ? F.VFR : F.VFG))[i < n16 ? i : i - n16] = (v4u){0u, 0u, 0u, 0u}; }
    for (int i = blockIdx.x * NTHR + F.tid; i < 2 * 8 * 2048; i += F.G * NTHR) {
        const int which = i >> 14, h = (i >> 11) & 7, o = i & 2047; ((GAS v4u*)((unsigned char*)(which ? F.KFR : F.QFR) + (size_t)h * 33 * 32768))[o] = (v4u){0u, 0u, 0u, 0u}; }
    for (int m = gw; m < MT; m += NGW) {
        GAS unsigned long long* o8 = (GAS unsigned long long*)(F.XB + (size_t)m * DM) + F.lane;
        if (m < MROWS) {
            const float* xrow = m < MR ? F.x + (size_t)m * DM : F.meta + (size_t)(m - MR) * DM;
            const GAS f32x4* xr = (const GAS f32x4*)xrow + F.lane; float ss = 0.f;
#pragma unroll
            for (int j = 0; j < 16; ++j) { const f32x4 v = xr[64 * j]; ss += (v.x * v.x + v.y * v.y) + (v.z * v.z + v.w * v.w);
                o8[64 * j] = (unsigned long long)pk2(v.x, v.y) | ((unsigned long long)pk2(v.z, v.w) << 32); }
            ss = wave_sum(ss);
            if (F.lane == 0) F.RS1[m] = 1.0f / sqrtf(ss * (1.0f / DM) + EPS);
        } else {
            GAS unsigned long long* o2 = (GAS unsigned long long*)(F.MRG + (size_t)m * DM) + F.lane;
            GAS unsigned long long* o3 = (GAS unsigned long long*)(F.H1B + (size_t)m * DM) + F.lane;
#pragma unroll
            for (int j = 0; j < 16; ++j) { o8[64 * j] = 0ull; o2[64 * j] = 0ull; o3[64 * j] = 0ull; }
            if (F.lane == 0) F.RS1[m] = 0.f;
        }
    }
    for (int i = blockIdx.x * NTHR + F.tid; i < MROWS * 128; i += F.G * NTHR) {
        const int m = i >> 7, j = i & 127;
        const int pos = m < MR ? F.positions[m] + NMETA : m - MR;
        const float inv_freq = powf(10000.0f, -(float)j * (1.0f / 128.0f));
        const float ang = (float)pos * inv_freq; float s, c; sincosf(ang, &s, &c);
        F.COS[i] = c; F.SIN[i] = s; F.COST[(size_t)j * MT + m] = c; F.SINT[(size_t)j * MT + m] = s;
    }
}

typedef float f32x4v __attribute__((ext_vector_type(4)));
#define MFMA16(a, b, c) __builtin_amdgcn_mfma_f32_16x16x32_bf16((a), (b), (c), 0, 0, 0)
__device__ __forceinline__ f32x4v skinny_dot(const bf16* A, const bf16* Bt, int n0, int k0, int nks, int lane) {
    const int fr = lane & 15, fq = lane >> 4;
    const bf16* ap = A + (size_t)fr * DM + k0 + 8 * fq; const bf16* bp = Bt + (size_t)(n0 + fr) * DM + k0 + 8 * fq;
    f32x4v acc = (f32x4v){0.f, 0.f, 0.f, 0.f};
#pragma unroll 8
    for (int ks = 0; ks < nks; ++ks) acc = MFMA16(*(const bf16x8*)(ap + 32 * ks), *(const bf16x8*)(bp + 32 * ks), acc);
    return acc;
}
__device__ __forceinline__ void meta_proj(Frame& F) {
    const int lane = F.lane, fr = lane & 15, fq = lane >> 4, w8 = F.wave; LAS float* ex = (LAS float*)F.lds;
    const bf16* A = F.XB + (size_t)MR * DM;
    for (int it = blockIdx.x; it < 256; it += F.G) {
        if (it < 32) {
            const bool isk = it >= 16; const int h = (it & 15) >> 1, s2 = it & 1, idx = 64 * s2 + 16 * (w8 & 3) + fr, dk = idx + (w8 >= 4 ? 128 : 0);
            const f32x4v acc = skinny_dot(A, F.W1t, (isk ? C_KR : C_QR) + 256 * h + dk - fr, 0, DM / 32, lane);
#pragma unroll
            for (int e = 0; e < 4; ++e) ex[(w8 * 4 + e) * 64 + lane] = acc[e] * F.RS1[MR + 4 * fq + e];
            __syncthreads();
            const float l2g = __log2f(1.0f - exp2f(-5.0f - (float)h)); float o[4];
#pragma unroll
            for (int e = 0; e < 4; ++e) { const int mrow = 4 * fq + e; const float mine = ex[(w8 * 4 + e) * 64 + lane], other = ex[((w8 ^ 4) * 4 + e) * 64 + lane];
                const float c = F.COS[(MR + mrow) * 128 + idx], sn = F.SIN[(MR + mrow) * 128 + idx];
                const float rot = w8 < 4 ? mine * c - other * sn : mine * c + other * sn;
                const float dec = exp2f((float)(48 + mrow + 1) * l2g); o[e] = isk ? rot * 0.0625f / dec : rot * dec; }
            if (isk) *(unsigned long long*)((unsigned char*)F.KFR + (((size_t)h * 33 * 8 + (dk >> 5)) * 4 + 3) * 1024 + ((dk & 31) + 32 * (fq & 1)) * 16 + 8 * (fq >> 1)) = (unsigned long long)pkbf(o[0], o[1]) | ((unsigned long long)pkbf(o[2], o[3]) << 32);
            else {
#pragma unroll
                for (int e = 0; e < 4; ++e) { const int mrow = 4 * fq + e;
                    *(bf16*)((unsigned char*)F.QFR + (((size_t)h * 33 * 8 + (dk >> 5)) * 4 + ((dk >> 4) & 1) * 2 + 1) * 1024 + (16 + mrow + 32 * ((dk >> 2) & 1)) * 16 + 2 * (4 * ((dk >> 3) & 1) + (dk & 3))) = f2b(o[e]); } }
            __syncthreads();
        } else if (it < 64) {
            const int n0 = 128 * (it - 32) + 16 * w8; const f32x4v acc = skinny_dot(A, F.W1t, C_QG + n0, 0, DM / 32, lane);
#pragma unroll
            for (int e = 0; e < 4; ++e) { const int row = MR + 4 * fq + e; F.PROJ[(size_t)row * LDP + n0 + fr] = f2b(acc[e] * F.RS1[row]); }
        } else if (it >= 192) {
            const int cvv = 128 * (it - 192) + 16 * w8 + fr; const f32x4v acc = skinny_dot(A, F.W1t, C_V + 128 * (it - 192) + 16 * w8, 0, DM / 32, lane);
            const int cv = cvv & 4095, slg = cv >> 6, wt = (cv >> 5) & 1, rp = cv & 31; unsigned char* VF = (unsigned char*)(cvv < 4096 ? F.VFR : F.VFG);
            const f32x4v sc = *(const f32x4v*)(F.RS1 + MR + 4 * fq);
            *(unsigned long long*)(VF + ((size_t)slg * 8 + wt * 4 + 3) * 1024 + (rp + 32 * (fq & 1)) * 16 + 8 * (fq >> 1)) = (unsigned long long)pkbf(acc[0] * sc[0], acc[1] * sc[1]) | ((unsigned long long)pkbf(acc[2] * sc[2], acc[3] * sc[3]) << 32);
        } else {
            const int t = (it - 64) >> 1, sp = (it - 64) & 1;
            const int n0 = C_GR + 256 * t + (w8 >= 4 ? 128 : 0) + 64 * sp + 16 * (w8 & 3);
            const f32x4v acc = skinny_dot(A, F.W1t, n0, 0, DM / 32, lane);
#pragma unroll
            for (int e = 0; e < 4; ++e) ex[(w8 * 4 + e) * 64 + lane] = acc[e] * F.RS1[MR + 4 * fq + e];
            __syncthreads();
            if (w8 < 4) { bf16* G = t < 32 ? F.GR : F.GG; const int ch = 128 * (t & 31) + 64 * sp + 16 * w8 + fr;
#pragma unroll
                for (int e = 0; e < 4; ++e) { const int row = MR + 4 * fq + e; G[(size_t)row * DM + ch] = f2b(pg8::gate2(ex[(w8 * 4 + e) * 64 + lane], ex[((w8 + 4) * 4 + e) * 64 + lane])); } }
            __syncthreads();
        }
    }
    __syncthreads();
}
__device__ __forceinline__ void z_proj(Frame& F) {
    const int lane = F.lane, fr = lane & 15, fq = lane >> 4;
    for (int g = blockIdx.x * NWAVES + F.wave; g < MROWS / 16; g += F.G * NWAVES) {
        const f32x4v acc = skinny_dot(F.XB + (size_t)(16 * g) * DM, F.W1t, C_Z, 0, DM / 32, lane);
#pragma unroll
        for (int e = 0; e < 4; ++e) { const int row = 16 * g + 4 * fq + e; F.ZB[(size_t)row * 16 + fr] = acc[e] * F.RS1[row]; }
    }
}
__device__ __forceinline__ void meta_wout(Frame& F) {
    const int lane = F.lane, fr = lane & 15, fq = lane >> 4, w8 = F.wave; LAS float* ex = (LAS float*)F.lds;
    for (int it = blockIdx.x; it < DM / 16; it += F.G) {
        const int n0 = 16 * it; const f32x4v acc = skinny_dot(F.MRG + (size_t)MR * DM, F.Wot, n0, 512 * w8, 16, lane);
#pragma unroll
        for (int e = 0; e < 4; ++e) ex[(w8 * 4 + e) * 64 + lane] = acc[e];
        __syncthreads();
        if (w8 == 0) {
#pragma unroll
            for (int e = 2; e < 4; ++e) { float v = 0.f;
#pragma unroll
                for (int w = 0; w < 8; ++w) v += ex[(w * 4 + e) * 64 + lane];
                const int mrow = 4 * fq + e;
                const float hv = F.meta[(size_t)(mrow & 15) * DM + n0 + fr] + v; float q = hv * hv;
                q += __shfl_xor(q, 1); q += __shfl_xor(q, 2); q += __shfl_xor(q, 4); q += __shfl_xor(q, 8);
                if (fq == 3) { F.H1[(size_t)(MR + mrow) * DM + n0 + fr] = hv; F.H1B[(size_t)(MR + mrow) * DM + n0 + fr] = f2b(hv); if (fr == 0) atomicAdd(F.SS2 + MR + mrow, q); } }
        }
        __syncthreads();
    }
}
__device__ __forceinline__ void meta_up(Frame& F) {
    const int lane = F.lane, fr = lane & 15, fq = lane >> 4;
    for (int g = blockIdx.x * NWAVES + F.wave; g < DFF / 16; g += F.G * NWAVES) {
        const int c0 = 16 * g; const f32x4v acc = skinny_dot(F.H1B + (size_t)MR * DM, F.Wft, 256 * (c0 >> 7) + (c0 & 127), 0, DM / 32, lane);
        if (fq == 3) {
#pragma unroll
            for (int e = 2; e < 4; ++e) { const float rs = 1.0f / sqrtf(F.SS2[MR + 12 + e] * (1.0f / 4096.0f) + EPS); F.UPM[(size_t)(e - 2) * DFF + c0 + fr] = acc[e] * rs; } }
    }
}

template <bool GLA> __device__ __forceinline__ void prep_qkp(Frame& F, int u) {
    constexpr int DK = GLA ? GLA_DK : RET_DK, NH = GLA ? GLA_H : RET_H, LDQ = DK + 8, DKW = DK / 8, NKS = DKW / 16, NDT = DKW / 32;
    const int n = u % 33, h = (u / 33) % NH, b = u / (33 * NH);
    LAS bf16* Qs = (LAS bf16*)F.lds; LAS bf16* Ks = Qs + 64 * LDQ; LAS float* zs = (LAS float*)(Ks + 64 * LDQ);
    const int tid = F.tid, lane = F.lane, w8 = F.wave, r = lane & 31, hh = lane >> 5;
    if (GLA) {
        for (int e = tid; e < 64 * 16; e += NTHR) { const int row = chunk_row(b, n, e >> 4); zs[e] = row >= 0 ? F.ZB[(size_t)row * 16 + (e & 15)] : 0.f; }
        __syncthreads();
        const int d = tid, ch = h * GLA_DK + d; float wg[GLA_RANK];
#pragma unroll
        for (int q = 0; q < GLA_RANK; ++q) wg[q] = F.w_gate_up[q * 2048 + ch];
        const float bg = F.b_gate[ch]; float bc = 0.f;
#pragma unroll 1
        for (int i0 = 0; i0 < 64; i0 += 16) {
            unsigned qr[16], kr[16];
#pragma unroll
            for (int ii = 0; ii < 16; ++ii) { const int row = chunk_row(b, n, i0 + ii); qr[ii] = 0u; kr[ii] = 0u;
                if (row >= 0) { const bf16* pr = F.PROJ + (size_t)row * LDP; qr[ii] = pr[P_QG + ch]; kr[ii] = pr[P_KG + ch]; } }
#pragma unroll
            for (int ii = 0; ii < 16; ++ii) { const int i = i0 + ii, row = chunk_row(b, n, i); float qv = 0.f, kv = 0.f;
                if (row >= 0) { float lg = bg;
#pragma unroll
                    for (int q = 0; q < GLA_RANK; ++q) lg += zs[i * 16 + q] * wg[q];
                    bc += logsig(lg) * (1.0f / 16.0f);
                    qv = bf2f((bf16)qr[ii]) * 0.04419417382415922f * __expf(bc); kv = bf2f((bf16)kr[ii]) * __expf(-bc); }
                Qs[i * LDQ + d] = f2b(qv); Ks[i * LDQ + d] = f2b(kv); }
        }
        F.DECG[((size_t)(b * GLA_H + h) * 33 + n) * GLA_DK + d] = __expf(bc);
    } else {
        const int p = tid & 127, tg = tid >> 7; const float l2g = log2f(1.0f - exp2f(-5.0f - (float)h));
#pragma unroll 1
        for (int i8 = 0; i8 < 16; i8 += 8) {
            unsigned q1r[8], q2r[8], k1r[8], k2r[8]; float cr[8], sr[8];
#pragma unroll
            for (int ii = 0; ii < 8; ++ii) { const int row = chunk_row(b, n, tg * 16 + i8 + ii); q1r[ii] = q2r[ii] = k1r[ii] = k2r[ii] = 0u; cr[ii] = 0.f; sr[ii] = 0.f;
                if (row >= 0) { const bf16* pr = F.PROJ + (size_t)row * LDP; cr[ii] = F.COS[row * 128 + p]; sr[ii] = F.SIN[row * 128 + p];
                    q1r[ii] = pr[C_QR + h * 256 + p]; q2r[ii] = pr[C_QR + h * 256 + 128 + p]; k1r[ii] = pr[C_KR + h * 256 + p]; k2r[ii] = pr[C_KR + h * 256 + 128 + p]; } }
#pragma unroll
            for (int ii = 0; ii < 8; ++ii) { const int i = tg * 16 + i8 + ii; const float c = cr[ii], sn = sr[ii];
                const float q1 = bf2f((bf16)q1r[ii]), q2 = bf2f((bf16)q2r[ii]), k1 = bf2f((bf16)k1r[ii]), k2 = bf2f((bf16)k2r[ii]);
                const float dq = exp2f((float)(i + 1) * l2g), dkk = 0.0625f / dq;
                Qs[i * LDQ + p] = f2b((q1 * c - q2 * sn) * dq); Qs[i * LDQ + p + 128] = f2b((q2 * c + q1 * sn) * dq);
                Ks[i * LDQ + p] = f2b((k1 * c - k2 * sn) * dkk); Ks[i * LDQ + p + 128] = f2b((k2 * c + k1 * sn) * dkk); }
        }
    }
    __syncthreads();
    const size_t cb = (size_t)(b * NH + h) * 33 + n;
    {
        char* qdst = (char*)(GLA ? F.QFG : F.QFR) + ((cb * 8 + w8) * (NKS * 2)) * 1024 + lane * 16;
#pragma unroll
        for (int ks = 0; ks < NKS; ++ks)
#pragma unroll
            for (int qt = 0; qt < 2; ++qt) { const LAS bf16* src = Qs + (32 * qt + r) * LDQ + DKW * w8 + 16 * ks + 4 * hh;
                const unsigned long long lo = *(const LAS unsigned long long*)src, hi = *(const LAS unsigned long long*)(src + 8);
                *(v4u*)(qdst + (ks * 2 + qt) * 1024) = (v4u){(unsigned)lo, (unsigned)(lo >> 32), (unsigned)hi, (unsigned)(hi >> 32)}; }
        char* kdst = (char*)(GLA ? F.KFG : F.KFR) + ((cb * 8 + w8) * (NDT * 4)) * 1024 + lane * 16;
#pragma unroll
        for (int dkt = 0; dkt < NDT; ++dkt)
#pragma unroll
            for (int ks = 0; ks < 4; ++ks) { unsigned w[4];
#pragma unroll
                for (int jj = 0; jj < 4; ++jj) { const int j0 = 2 * jj, t0 = 16 * ks + 8 * (j0 >> 2) + 4 * hh + (j0 & 3);
                    const unsigned e0 = Ks[t0 * LDQ + DKW * w8 + 32 * dkt + r], e1 = Ks[(t0 + 1) * LDQ + DKW * w8 + 32 * dkt + r]; w[jj] = e0 | (e1 << 16); }
                *(v4u*)(kdst + (dkt * 4 + ks) * 1024) = (v4u){w[0], w[1], w[2], w[3]}; }
    }
    if (w8 < 4) {
        const int kt = w8 >> 1, qt = w8 & 1; f32x16 acc;
#pragma unroll
        for (int i = 0; i < 16; ++i) acc[i] = 0.f;
        if (!(kt == 1 && qt == 0)) {
            const LAS bf16* ap = Ks + (32 * kt + r) * LDQ + 8 * hh; const LAS bf16* bp = Qs + (32 * qt + r) * LDQ + 8 * hh;
#pragma unroll 8
            for (int s = 0; s < DK / 16; ++s) acc = MFMA32(*(const LAS bf16x8*)(ap + 16 * s), *(const LAS bf16x8*)(bp + 16 * s), acc);
        }
        char* pdst = (char*)(GLA ? F.PFG : F.PFR) + (cb * 8) * 1024 + lane * 16;
#pragma unroll
        for (int s2 = 0; s2 < 2; ++s2) { unsigned w[4];
#pragma unroll
            for (int jj = 0; jj < 4; ++jj) { const int i0 = 8 * s2 + 2 * jj, i1 = i0 + 1;
                const int k0 = 32 * kt + (i0 & 3) + 8 * (i0 >> 2) + 4 * hh, k1 = 32 * kt + (i1 & 3) + 8 * (i1 >> 2) + 4 * hh, qc = 32 * qt + r;
                w[jj] = pkbf(k0 <= qc ? acc[i0] : 0.f, k1 <= qc ? acc[i1] : 0.f); }
            *(v4u*)(pdst + ((2 * kt + s2) * 2 + qt) * 1024) = (v4u){w[0], w[1], w[2], w[3]}; }
    }
    __syncthreads();
}
__device__ __forceinline__ void prep_p_ret(Frame& F, int u) {
    const int n = u % 33, h = (u / 33) % 8, b = u / (33 * 8);
    if (n == 0 && b != 0) return;
    constexpr int LDK = 264;
    LAS bf16* Ks = (LAS bf16*)F.lds;
    const int lane = F.lane, w8 = F.wave, r = lane & 31, hh = lane >> 5;
    const size_t cb = (size_t)(b * 8 + h) * 33 + n;
    { const unsigned char* kp = (const unsigned char*)F.KFR + (cb * 8 + w8) * 4096 + lane * 16;
#pragma unroll
      for (int ks = 0; ks < 4; ++ks) { const v4u w = *(const v4u*)(kp + ks * 1024);
#pragma unroll
          for (int j = 0; j < 8; ++j) { const int tok = 16 * ks + 8 * (j >> 2) + 4 * hh + (j & 3); Ks[tok * LDK + 32 * w8 + r] = (bf16)(w[j >> 1] >> (16 * (j & 1))); } } }
    __syncthreads();
    if (w8 < 3) {
        const int kt = w8 >> 1, qt = w8 == 0 ? 0 : 1; f32x16 acc;
#pragma unroll
        for (int i = 0; i < 16; ++i) acc[i] = 0.f;
        const unsigned char* qp = (const unsigned char*)F.QFR + (cb * 8) * 4096 + qt * 1024 + lane * 16;
        const LAS bf16* ap = Ks + (32 * kt + r) * LDK + 4 * hh;
#pragma unroll 4
        for (int s = 0; s < 16; ++s) {
            const unsigned long long lo = *(const LAS unsigned long long*)(ap + 16 * s), hi = *(const LAS unsigned long long*)(ap + 16 * s + 8);
            const v4u av = (v4u){(unsigned)lo, (unsigned)(lo >> 32), (unsigned)hi, (unsigned)(hi >> 32)};
            acc = MFMA32(__builtin_bit_cast(bf16x8, av), *(const bf16x8*)(qp + (s >> 1) * 4096 + (s & 1) * 2048), acc); }
        unsigned char* pdst = (unsigned char*)F.PFR + (cb * 8) * 1024 + lane * 16;
#pragma unroll
        for (int s2 = 0; s2 < 2; ++s2) { unsigned w[4];
#pragma unroll
            for (int jj = 0; jj < 4; ++jj) { const int i0 = 8 * s2 + 2 * jj, i1 = i0 + 1;
                const int k0 = 32 * kt + (i0 & 3) + 8 * (i0 >> 2) + 4 * hh, k1 = 32 * kt + (i1 & 3) + 8 * (i1 >> 2) + 4 * hh, qc = 32 * qt + r;
                w[jj] = pkbf(k0 <= qc ? acc[i0] : 0.f, k1 <= qc ? acc[i1] : 0.f); }
            *(v4u*)(pdst + ((2 * kt + s2) * 2 + qt) * 1024) = (v4u){w[0], w[1], w[2], w[3]}; }
    } else if (w8 == 3) {
        unsigned char* pdst = (unsigned char*)F.PFR + (cb * 8) * 1024 + lane * 16;
        *(v4u*)(pdst + (2 * 2 + 0) * 1024) = (v4u){0u, 0u, 0u, 0u}; *(v4u*)(pdst + (3 * 2 + 0) * 1024) = (v4u){0u, 0u, 0u, 0u};
    }
    __syncthreads();
}
#ifndef PREP_REP
#define PREP_REP 0
#endif
__device__ __forceinline__ void p2_prep(Frame& F) {
    constexpr int U_R = 4 * 8 * 33, U_G = 4 * 4 * 33;
    for (int u = blockIdx.x; u < U_G + U_R; u += F.G) {
        if (u < U_G) { prep_qkp<true>(F, u); if (PREP_REP & 1) prep_qkp<true>(F, u); }
        else { prep_p_ret(F, u - U_G); if (PREP_REP & 2) prep_p_ret(F, u - U_G); }
    }
}

__device__ __forceinline__ bf16x8 pack8(const f32x16& x, int s) { v4u w;
    if (s == 0) { w.x = pkbf(x[0], x[1]); w.y = pkbf(x[2], x[3]); w.z = pkbf(x[4], x[5]); w.w = pkbf(x[6], x[7]); }
    else { w.x = pkbf(x[8], x[9]); w.y = pkbf(x[10], x[11]); w.z = pkbf(x[12], x[13]); w.w = pkbf(x[14], x[15]); }
    return __builtin_bit_cast(bf16x8, w); }
#define LDS_BAR() do { asm volatile("s_waitcnt lgkmcnt(0)" ::: "memory"); __builtin_amdgcn_s_barrier(); asm volatile("" ::: "memory"); } while (0)
template <bool GLA, int ABL = 0> __device__ __forceinline__ void scan_unit(Frame& F, int u) {
    constexpr int DK = GLA ? GLA_DK : RET_DK, DV = GLA ? GLA_DV : RET_DV, NH = GLA ? GLA_H : RET_H, NSL = DV / 64, DKW = DK / 8, NKS = DKW / 16, NDT = DKW / 32;
    const int b = u / (NH * NSL), h = (u / NSL) % NH, sl = u % NSL, slg = h * NSL + sl;
    const int lane = F.lane, r = lane & 31, hh = lane >> 5, w8 = F.wave;
#define SMFMA(a, b, c) (ABL == 4 ? (c) : MFMA32((a), (b), (c)))
    LAS unsigned char* RED = F.lds;
    LAS unsigned char* VL = F.lds + 131072;
    f32x16 S[NDT][2];
#pragma unroll
    for (int a = 0; a < NDT; ++a)
#pragma unroll
        for (int c = 0; c < 2; ++c)
#pragma unroll
            for (int i = 0; i < 16; ++i) S[a][c][i] = 0.f;
    const int b0 = GLA ? b : 0;
    const char* QFb = (const char*)(GLA ? F.QFG : F.QFR) + (((size_t)(b * NH + h) * 33 * 8 + w8) * (NKS * 2)) * 1024 + lane * 16;
    const char* QF0 = (const char*)(GLA ? F.QFG : F.QFR) + (((size_t)(b0 * NH + h) * 33 * 8 + w8) * (NKS * 2)) * 1024 + lane * 16;
    const char* KF0 = (const char*)(GLA ? F.KFG : F.KFR) + (((size_t)(b0 * NH + h) * 33 * 8 + w8) * (NDT * 4)) * 1024 + lane * 16;
    const char* PF0 = (const char*)(GLA ? F.PFG : F.PFR) + ((size_t)(b0 * NH + h) * 33 * 8 + w8) * 1024 + lane * 16;
    const char* KFb = (const char*)(GLA ? F.KFG : F.KFR) + (((size_t)(b * NH + h) * 33 * 8 + w8) * (NDT * 4)) * 1024 + lane * 16;
    const char* VF0 = (const char*)(GLA ? F.VFG : F.VFR) + ((size_t)slg * 8 + w8) * 1024 + lane * 16;
    const char* VFb = VF0 + (size_t)b * 33 * 64 * 8 * 1024;
    const char* PFb = (const char*)(GLA ? F.PFG : F.PFR) + ((size_t)(b * NH + h) * 33 * 8 + w8) * 1024 + lane * 16;
    bf16* Y = GLA ? F.YG : F.YR;
    const float gam64 = exp2f(64.0f * log2f(1.0f - exp2f(-5.0f - (float)h)));
    bf16x8 qf[NKS * 2];
#pragma unroll
    for (int f = 0; f < NKS * 2; ++f) qf[f] = *(const bf16x8*)(QF0 + f * 1024);
    bf16x8 bp = *(const bf16x8*)PF0;
    *(LAS bf16x8*)(VL + w8 * 1024 + lane * 16) = *(const bf16x8*)VF0;
    __syncthreads();
#pragma unroll 1
    for (int n = 0; n < 33; ++n) {
        const size_t cb = (size_t)(b * NH + h) * 33 + n;
        const char* kp = n ? KFb + (size_t)n * (8 * NDT * 4 * 1024) : KF0;
        const LAS unsigned char* vl = VL + (n & 1) * 8192 + lane * 16;
        const int nn = n < 32 ? n + 1 : n;
        bf16x8 kf[NDT * 4];
#pragma unroll
        for (int f = 0; f < NDT * 4; ++f) kf[f] = *(const bf16x8*)((ABL == 2 ? KF0 : kp) + f * 1024);
        const bf16x8 vnext = *(const bf16x8*)(ABL == 2 ? VF0 : VFb + (size_t)nn * (64 * 8 * 1024));
        { const int ks2 = w8 >> 1, qt2 = w8 & 1;
#pragma unroll
          for (int wt = 0; wt < 2; ++wt) { f32x16 o0, o1;
#pragma unroll
            for (int i = 0; i < 16; ++i) { o0[i] = 0.f; o1[i] = 0.f; }
#pragma unroll
            for (int ks = 0; ks < NKS; ++ks) { const bf16x8 a = pack8(S[ks >> 1][wt], ks & 1); o0 = SMFMA(a, qf[ks * 2], o0); o1 = SMFMA(a, qf[ks * 2 + 1], o1); }
            const bf16x8 av = *(const LAS bf16x8*)(vl + (wt * 4 + ks2) * 1024);
            if (qt2 == 0) o0 = SMFMA(av, bp, o0); else o1 = SMFMA(av, bp, o1);
            if (ABL != 3 && wt == 0) LDS_BAR();
            if (ABL != 3) { LAS unsigned char* d0 = RED + ((w8 * 4 + wt * 2) * 64 + lane) * 48; LAS unsigned char* d1 = d0 + 64 * 48;
              *(LAS v4u*)d0 = (v4u){pkbf(o0[0], o0[1]), pkbf(o0[2], o0[3]), pkbf(o0[4], o0[5]), pkbf(o0[6], o0[7])}; *(LAS v4u*)(d0 + 16) = (v4u){pkbf(o0[8], o0[9]), pkbf(o0[10], o0[11]), pkbf(o0[12], o0[13]), pkbf(o0[14], o0[15])};
              *(LAS v4u*)d1 = (v4u){pkbf(o1[0], o1[1]), pkbf(o1[2], o1[3]), pkbf(o1[4], o1[5]), pkbf(o1[6], o1[7])}; *(LAS v4u*)(d1 + 16) = (v4u){pkbf(o1[8], o1[9]), pkbf(o1[10], o1[11]), pkbf(o1[12], o1[13]), pkbf(o1[14], o1[15])}; } } }
        if (ABL != 2) { const char* qn = QFb + (size_t)nn * (8 * NKS * 2 * 1024);
#pragma unroll
          for (int f = 0; f < NKS * 2; ++f) qf[f] = *(const bf16x8*)(qn + f * 1024);
          bp = *(const bf16x8*)(PFb + (size_t)nn * 8192); }
#pragma unroll
        for (int ks = 0; ks < 4; ++ks) { bf16x8 bv[2];
#pragma unroll
            for (int wt = 0; wt < 2; ++wt) bv[wt] = *(const LAS bf16x8*)(vl + (wt * 4 + ks) * 1024);
#pragma unroll
            for (int dkt = 0; dkt < NDT; ++dkt)
#pragma unroll
                for (int wt = 0; wt < 2; ++wt) S[dkt][wt] = SMFMA(kf[dkt * 4 + ks], bv[wt], S[dkt][wt]); }
        if (GLA) {
#pragma unroll
            for (int dkt = 0; dkt < NDT; ++dkt) { const float* dp = F.DECG + cb * GLA_DK + DKW * w8 + 32 * dkt + 4 * hh;
#pragma unroll
                for (int g4 = 0; g4 < 4; ++g4) { const f32x4 dv = *(const f32x4*)(dp + 8 * g4);
#pragma unroll
                    for (int e = 0; e < 4; ++e) { S[dkt][0][4 * g4 + e] *= dv[e]; S[dkt][1][4 * g4 + e] *= dv[e]; } } }
        } else {
#pragma unroll
            for (int wt = 0; wt < 2; ++wt)
#pragma unroll
                for (int i = 0; i < 16; ++i) S[0][wt][i] *= gam64;
        }
        *(LAS bf16x8*)(VL + ((n + 1) & 1) * 8192 + w8 * 1024 + lane * 16) = vnext;
        LDS_BAR();
        if (ABL != 3) {
            const int t = w8 >> 1, wt = t >> 1, qt = t & 1; float val[8];
#pragma unroll
            for (int ii = 0; ii < 8; ++ii) val[ii] = 0.f;
#pragma unroll
            for (int src = 0; src < 8; ++src) { const v4u w = *(const LAS v4u*)(RED + ((src * 4 + t) * 64 + lane) * 48 + 16 * (w8 & 1));
#pragma unroll
                for (int q = 0; q < 4; ++q) { val[2 * q] += __builtin_bit_cast(float, w[q] << 16); val[2 * q + 1] += __builtin_bit_cast(float, w[q] & 0xffff0000u); } }
            const int row = chunk_row(b, n, 32 * qt + r);
            if (ABL == 0 && row >= 0 && (n > 0 || b == 0)) {
#pragma unroll
                for (int g = 0; g < 2; ++g) { const int w0 = 32 * wt + 8 * (2 * (w8 & 1) + g) + 4 * hh;
                    *(unsigned long long*)(Y + (size_t)row * DM + h * DV + 64 * sl + w0) = (unsigned long long)pkbf(val[4 * g], val[4 * g + 1]) | ((unsigned long long)pkbf(val[4 * g + 2], val[4 * g + 3]) << 32); } }
        }
    }
    __syncthreads();
}
#undef SMFMA
#ifndef SCAN_ABL
#define SCAN_ABL 0
#endif
__device__ __forceinline__ void p3_scan(Frame& F) {
    for (int i = blockIdx.x; i < 512; i += F.G) {
        const int w = i & 255, x = w & 7, idx = w >> 3;
        if (i < 256) { scan_unit<true>(F, (2 * x + (idx >> 4)) * 16 + (idx & 15)); if (SCAN_ABL) scan_unit<true, SCAN_ABL>(F, (2 * x + (idx >> 4)) * 16 + (idx & 15)); }
        else { scan_unit<false>(F, (4 * x + (idx >> 3)) * 8 + (idx & 7)); if (SCAN_ABL) scan_unit<false, SCAN_ABL>(F, (4 * x + (idx >> 3)) * 8 + (idx & 7)); }
    }
}

__device__ __forceinline__ void ld8bf(const bf16* p, float (&o)[8]) { const v4u w = *(const v4u*)p;
#pragma unroll
    for (int q = 0; q < 4; ++q) { o[2 * q] = __builtin_bit_cast(float, w[q] << 16); o[2 * q + 1] = __builtin_bit_cast(float, w[q] & 0xffff0000u); } }
__device__ __forceinline__ void p4_merge(Frame& F) {
    const int gw = blockIdx.x * NWAVES + F.wave, NGW = F.G * NWAVES, lane = F.lane;
    for (int m = gw; m < MROWS; m += NGW) {
#pragma unroll 1
        for (int hg = 0; hg < 4; ++hg) {
            float yr[2][8], yg[2][8];
#pragma unroll
            for (int j = 0; j < 2; ++j) { const int c = hg * 1024 + j * 512 + lane * 8; ld8bf(F.YR + (size_t)m * DM + c, yr[j]); ld8bf(F.YG + (size_t)m * DM + c, yg[j]); }
            float sg = 0.f, sa = 0.f, sb = 0.f;
#pragma unroll
            for (int e = 0; e < 8; ++e) { sg += yg[0][e] * yg[0][e] + yg[1][e] * yg[1][e]; sa += yr[0][e]; sb += yr[1][e]; }
            sg = wave_sum(sg); sa = wave_sum(sa); sb = wave_sum(sb);
            const float rg = 1.0f / sqrtf(sg * (1.0f / 1024.0f) + EPS), ma = sa * (1.0f / 512.0f), mb = sb * (1.0f / 512.0f);
            float qa = 0.f, qb = 0.f;
#pragma unroll
            for (int e = 0; e < 8; ++e) { yr[0][e] -= ma; yr[1][e] -= mb; qa += yr[0][e] * yr[0][e]; qb += yr[1][e] * yr[1][e]; }
            qa = wave_sum(qa); qb = wave_sum(qb);
            const float ra = 1.0f / sqrtf(qa * (1.0f / 512.0f) + EPS), rb = 1.0f / sqrtf(qb * (1.0f / 512.0f) + EPS);
#pragma unroll
            for (int j = 0; j < 2; ++j) { const int c = hg * 1024 + j * 512 + lane * 8; const float rr = j ? rb : ra; float tr[8], tg[8], res[8];
                ld8bf(F.GR + (size_t)m * DM + c, tr); ld8bf(F.GG + (size_t)m * DM + c, tg);
                const f32x4 gr0 = *(const f32x4*)(F.ret_norm + c), gr1 = *(const f32x4*)(F.ret_norm + c + 4), gg0 = *(const f32x4*)(F.gla_norm + c), gg1 = *(const f32x4*)(F.gla_norm + c + 4);
#pragma unroll
                for (int e = 0; e < 8; ++e) res[e] = tr[e] * (yr[j][e] * rr * (e < 4 ? gr0[e & 3] : gr1[e & 3])) + tg[e] * (yg[j][e] * rg * (e < 4 ? gg0[e & 3] : gg1[e & 3]));
                *(v4u*)(F.MRG + (size_t)m * DM + c) = (v4u){pk2(res[0], res[1]), pk2(res[2], res[3]), pk2(res[4], res[5]), pk2(res[6], res[7])}; }
        }
    }
}

__device__ __forceinline__ void p8_act(Frame& F) {
    for (int i = blockIdx.x * NTHR + F.tid; i < 32 * DFF; i += F.G * NTHR) {
        const int pm = i / DFF, c = i % DFF;
        const float* prev = (pm & 7) ? F.UPH + (size_t)(pm - 1) * 2 * DFF : F.UPM;
        const float p0 = prev[c], p1 = prev[DFF + c], w0 = F.conv_w[c], w1 = F.conv_w[DFF + c];
        const float c0 = F.PARTC[(size_t)pm * 2 * DFF + c] + w1 * p1 + w0 * p0, c1 = F.PARTC[(size_t)pm * 2 * DFF + DFF + c] + w0 * p1;
        F.ACT[(size_t)(256 * pm) * DFF + c] = f2b(silu(c0) * F.PARTG[(size_t)pm * 2 * DFF + c]);
        F.ACT[(size_t)(256 * pm + 1) * DFF + c] = f2b(silu(c1) * F.PARTG[(size_t)pm * 2 * DFF + DFF + c]);
    }
}

__device__ __forceinline__ void p10_final(Frame& F) {
    const int gw = blockIdx.x * NWAVES + F.wave, NGW = F.G * NWAVES;
    for (int m = gw; m < MR; m += NGW) {
        GAS f32x4* xr = (GAS f32x4*)(F.out + (size_t)m * DM) + F.lane; f32x4 v[16]; float ss = 0.f;
#pragma unroll
        for (int j = 0; j < 16; ++j) { v[j] = xr[64 * j]; ss += (v[j].x * v[j].x + v[j].y * v[j].y) + (v[j].z * v[j].z + v[j].w * v[j].w); }
        ss = wave_sum(ss); const float r = 1.0f / sqrtf(ss * (1.0f / DM) + EPS);
#pragma unroll
        for (int j = 0; j < 16; ++j) { const f32x4 g = *((const GAS f32x4*)F.final_norm + F.lane + 64 * j); xr[64 * j] = v[j] * r * g; }
    }
}

#ifndef REP_MASK
#define REP_MASK 0u
#endif
#define REPS(k) (((REP_MASK >> (k)) & 1u) ? 2 : 1)
struct Args { const void* in[16]; float* out; unsigned char* ws; int ph_lo, ph_hi, li, pad; };
__global__ void __launch_bounds__(NTHR, 2) fwd(Args args) {
    extern __shared__ __attribute__((aligned(16))) unsigned char lds[];
    Frame F;
    F.lds = (LAS unsigned char*)lds;
    F.MISC = (volatile LAS unsigned*)(F.lds + MISC_OFF);
    F.tid = threadIdx.x; F.lane = F.tid & 63; F.wave = __builtin_amdgcn_readfirstlane(F.tid >> 6); F.G = gridDim.x;
    unsigned char* ws = args.ws;
    F.ctl = (gu32*)(ws + WS_CTL);
    F.x = (const float*)args.in[0]; F.positions = (const int*)args.in[1]; F.meta = (const float*)args.in[2]; F.attn_norm = (const float*)args.in[3]; F.w_in = (const float*)args.in[4];
    F.w_gate_up = (const float*)args.in[5]; F.b_gate = (const float*)args.in[6]; F.ret_norm = (const float*)args.in[7]; F.gla_norm = (const float*)args.in[8]; F.w_out = (const float*)args.in[9];
    F.ffn_norm = (const float*)args.in[10]; F.w_ffn_in = (const float*)args.in[11]; F.conv_w = (const float*)args.in[12]; F.conv_b = (const float*)args.in[13]; F.w_ffn_out = (const float*)args.in[14];
    F.final_norm = (const float*)args.in[15]; F.out = args.out;
    F.W1t = (bf16*)(ws + WS_W1T); F.Wot = (bf16*)(ws + WS_WOT); F.Wft = (bf16*)(ws + WS_WFT); F.W2t = (bf16*)(ws + WS_W2T); F.XB = (bf16*)(ws + WS_XB);
    F.PROJ = (bf16*)(ws + WS_PROJ); F.UG = (bf16*)(ws + WS_UG); F.ACT = (bf16*)(ws + WS_ACT); F.MRG = (bf16*)(ws + WS_MRG); F.H1B = (bf16*)(ws + WS_H1B);
    F.RS1 = (float*)(ws + WS_RS1); F.SS2 = (float*)(F.ctl + CW_SS2); F.ZB = (float*)(ws + WS_ZB); F.COS = (float*)(ws + WS_COS); F.SIN = (float*)(ws + WS_SIN); F.COST = (float*)(ws + WS_COST); F.SINT = (float*)(ws + WS_SINT);
    F.YR = (bf16*)(ws + WS_YR); F.YG = (bf16*)(ws + WS_YG); F.GR = (bf16*)(ws + WS_GR); F.GG = (bf16*)(ws + WS_GG); F.H1 = (float*)(ws + WS_H1); F.DECG = (float*)(ws + WS_DECG); F.UPH = (float*)(ws + WS_UPH); F.PARTC = (float*)(ws + WS_PARTC); F.PARTG = (float*)(ws + WS_PARTG); F.UPM = (float*)(ws + WS_UPM);
    F.QFG = (bf16*)(ws + WS_QFG); F.KFG = (bf16*)(ws + WS_KFG); F.QFR = (bf16*)(ws + WS_QFR); F.KFR = (bf16*)(ws + WS_KFR);
    F.VFG = (bf16*)(ws + WS_VFG); F.VFR = (bf16*)(ws + WS_VFR); F.PFG = (bf16*)(ws + WS_PFG); F.PFR = (bf16*)(ws + WS_PFR);
    for (int u = F.tid; u < (LDS_BYTES - LDSCTL_OFF) / 4; u += NTHR) ((LAS unsigned*)(F.lds + LDSCTL_OFF))[u] = 0u;
    __syncthreads();
    XcdBarrier bar; bar.bar = (unsigned*)(F.ctl + CW_BAR); bar.x = 0; bar.st = nullptr;
    if (N_LAUNCHES != NPH) bar = xcd_barrier_post((unsigned*)(F.ctl + CW_BAR) + args.li * XCD_BAR_WORDS, F.MISC + 8);
#define GRID_BAR(seam) do { if (N_LAUNCHES == NPH) { if (F.tid == 0) __hip_atomic_store(F.ctl + CW_TMO, 0xBADBA0u | (unsigned)(seam), RLX_AGENT); } else { xcd_barrier(bar); } } while (0)
    const int lo = args.ph_lo, hi = args.ph_hi;
#define IN(k) (lo <= (k) && (k) < hi)
#define BOTH(k) (IN(k) && IN((k) + 1))
#ifndef SKINNY_REP
#define SKINNY_REP 0
#endif
#define PH1() do { z_proj(F); if (SKINNY_REP & 1) z_proj(F); meta_proj(F); if (SKINNY_REP & 2) meta_proj(F); \
        { pg8::Gemm g{F.XB, F.W1t, MR, C_B, DM}; pg8::StaticOrder S; S.init(MR, C_B, F.G, (int)blockIdx.x); pg8::EpiA E{F.PROJ, F.RS1, F.COS, F.SIN, (unsigned char*)F.QFR, F.GR, F.GG}; \
          pg8::gemm_phase<pg8::EpiA, pg8::StaticOrder, PG8_ALIGN, PG8_SP2>(F.lds + RING_OFF, g, S, E); } \
        { pg8::Gemm g{F.XB, F.W1t + (size_t)C_B * DM, MR, 32768 - C_B, DM}; pg8::StaticOrder S; S.init(MR, 32768 - C_B, F.G, (int)blockIdx.x); pg8::EpiB E{(unsigned char*)F.VFR, (unsigned char*)F.VFG, (unsigned char*)F.KFR, F.RS1, F.COST, F.SINT}; \
          pg8::gemm_phase<pg8::EpiB, pg8::StaticOrder, PG8_ALIGN, PG8_SP2, false>(F.lds + RING_OFF, g, S, E); } } while (0)
#define PH5() do { meta_wout(F); pg8::Gemm g{F.MRG, F.Wot, MR, DM, DM}; pg8::StaticOrder S; S.init(MR, DM, F.G, (int)blockIdx.x); pg8::EpiResX E{F.x, F.meta, F.H1, F.H1B, F.SS2, DM, MR, NMETA}; \
        pg8::gemm_phase<pg8::EpiResX, pg8::StaticOrder, PG8_ALIGN, PG8_SP2>(F.lds + RING_OFF, g, S, E); } while (0)
#define PH7() do { meta_up(F); pg8::Gemm g{F.H1B, F.Wft, MR, NF, DM}; pg8::StaticOrder S; S.init(MR, NF, F.G, (int)blockIdx.x); pg8::EpiFfn E{F.ACT, F.SS2, F.conv_w, F.conv_b, F.UPH, F.PARTC, F.PARTG, (LAS float*)(F.lds + 131072)}; \
        pg8::gemm_phase<pg8::EpiFfn, pg8::StaticOrder, true, PG8_SP2>(F.lds + RING_OFF, g, S, E); } while (0)
#define PH9() do { pg8::Gemm g{F.ACT, F.W2t, MR, DM, DFF}; pg8::StaticOrder S; S.init(MR, DM, F.G, (int)blockIdx.x); pg8::EpiResF32 E{F.H1, F.out, DM}; \
        pg8::gemm_phase<pg8::EpiResF32, pg8::StaticOrder, PG8_ALIGN, PG8_SP2>(F.lds + RING_OFF, g, S, E); } while (0)
#define REIDX() do { int tz = threadIdx.x; asm volatile("" : "+v"(tz)); F.tid = tz; F.lane = tz & 63; F.wave = __builtin_amdgcn_readfirstlane(tz >> 6); } while (0)
#define RUN(k, body) do { if (IN(k)) { REIDX(); body; if (REPS(k) == 2) { __syncthreads(); body; } if (BOTH(k)) GRID_BAR(k); } } while (0)
    RUN(0, p0_prologue(F));
    RUN(1, PH1());
    RUN(2, p2_prep(F));
    RUN(3, p3_scan(F));
    RUN(4, p4_merge(F));
    RUN(5, PH5());
    RUN(7, PH7());
    RUN(8, p8_act(F));
    RUN(9, PH9());
    if (IN(10)) { REIDX(); p10_final(F); }
#undef IN
#undef BOTH
}

extern "C" void kernel_launch(void* const* d_in, const int* in_sizes, int n_in, void* d_out, int out_size, void* d_ws, size_t ws_size, hipStream_t stream) {
    static int grid = 0;
    if (grid == 0) {
        if (n_in != 16 || in_sizes[0] != MR * DM || out_size != MR * DM || ws_size < WS_END) {
            fprintf(stderr, "kernel_launch: shape/workspace mismatch: n_in %d in0 %d out %d ws %zu (need %zu); nothing launched\n", n_in, n_in > 0 ? in_sizes[0] : -1, out_size, ws_size, (size_t)WS_END); grid = -1; return; }
        int dev = 0, cus = 0, per_cu = 0;
        if (hipGetDevice(&dev) != hipSuccess || hipDeviceGetAttribute(&cus, hipDeviceAttributeMultiprocessorCount, dev) != hipSuccess) { fprintf(stderr, "kernel_launch: device query failed\n"); grid = -1; return; }
        if (hipFuncSetAttribute((const void*)fwd, hipFuncAttributeMaxDynamicSharedMemorySize, LDS_BYTES) != hipSuccess) { fprintf(stderr, "kernel_launch: hipFuncSetAttribute failed\n"); grid = -1; return; }
        if (hipOccupancyMaxActiveBlocksPerMultiprocessor(&per_cu, (const void*)fwd, NTHR, LDS_BYTES) != hipSuccess || per_cu < 1)
            fprintf(stderr, "kernel_launch: note: occupancy query reports %d workgroups per CU\n", per_cu);
        (void)hipGetLastError();
        grid = cus;
    }
    if (grid < 0) return;
    if (hipMemsetAsync((char*)d_ws + WS_CTL, 0, CTL_ZERO_BYTES, stream) != hipSuccess) { fprintf(stderr, "kernel_launch: memset failed\n"); return; }
    Args a{};
    for (int i = 0; i < 16; ++i) a.in[i] = d_in[i];
    a.out = (float*)d_out; a.ws = (unsigned char*)d_ws;
    for (int li = 0; li < N_LAUNCHES; ++li) {
        a.ph_lo = (N_LAUNCHES == NPH) ? li : 0; a.ph_hi = (N_LAUNCHES == NPH) ? li + 1 : NPH; a.li = (N_LAUNCHES == NPH) ? 0 : li;
        hipLaunchKernelGGL(fwd, dim3(grid), dim3(NTHR), LDS_BYTES, stream, a);
        const hipError_t le = hipPeekAtLastError();
        if (le != hipSuccess) { fprintf(stderr, "kernel_launch: launch %d failed: %s\n", li, hipGetErrorName(le)); break; }
    }
}
```

```cpp
#include <hip/hip_runtime.h>
#include <cstdio>
#include <cstdint>
namespace pg8 {
#define PG8_LAS __attribute__((address_space(3)))
typedef unsigned short bf16_t;
typedef short bf16x8 __attribute__((ext_vector_type(8)));
typedef float f32x4 __attribute__((ext_vector_type(4)));
typedef unsigned u32x4 __attribute__((ext_vector_type(4)));
constexpr int BM = 256, BK = 64, HALF = 128, HTB = HALF * BK * 2  , STAGE_BYTES = 8 * HTB, NXCD = 8, WGM = 4;

__host__ __device__ __forceinline__ int lds_byte(int r, int c) { const int st = (r >> 4) * 2 + (c >> 5), rr = r & 15, cc = c & 31, ob = rr * 64 + cc * 2; return st * 1024 + (ob ^ (((ob >> 9) & 1) << 5)); }
__host__ __device__ __forceinline__ void stage_rc(int b, int& R, int& C) { const int st = b / 1024, sb = b % 1024, swz = sb ^ (((sb >> 9) & 1) << 5); R = (st >> 1) * 16 + swz / 64; C = (st & 1) * 32 + (swz % 64) / 2; }
__host__ __device__ __forceinline__ int perm32(int rho) { const int n = rho >> 4, i = rho & 15; return 8 * (i >> 2) + 4 * n + (i & 3); }

struct Unit { int pm, pn; };
struct Gemm { const bf16_t* A; const bf16_t* Bt; int M, N, K; };

struct StaticOrder {
    int nM, nN, nwg, G, c;
    __host__ __device__ void init(int M, int N, int G_, int c_) { nM = M / BM; nN = N / BM; nwg = nM * nN; G = G_; c = c_; }
    __host__ __device__ bool next(int i, Unit& u) const {
        const long L = (long)i * G + c; if (L >= nwg) return false;
        int wgid = (int)L; { const int q = nwg / NXCD, r = nwg % NXCD, xcd = wgid % NXCD, off = wgid / NXCD; wgid = (xcd < r ? xcd * (q + 1) : r * (q + 1) + (xcd - r) * q) + off; }
        const int nig = WGM * nN, gid = wgid / nig, fm = gid * WGM, gsz = (nM - fm) < WGM ? (nM - fm) : WGM;
        u.pm = fm + ((wgid % nig) % gsz); u.pn = (wgid % nig) / gsz; return true;
    }
    __device__ __forceinline__ void a_ready(const Unit&) const {}
    __device__ __forceinline__ void done(const Unit&) const {}
};
__device__ __forceinline__ unsigned cvt_pk_bf16(float lo, float hi) { unsigned r; asm volatile("v_cvt_pk_bf16_f32 %0, %1, %2" : "=v"(r) : "v"(lo), "v"(hi)); return r; }
template <class Epi, class Sched, bool ALIGN_EPI = false, bool SP2 = false, bool TR = true  >
__device__ __forceinline__ void gemm_phase(PG8_LAS unsigned char* lds, const Gemm g, const Sched& S, const Epi& E) {
    const int tid = threadIdx.x, wid = __builtin_amdgcn_readfirstlane(tid >> 6), lane = tid & 63, wr = wid >> 2, wc = wid & 3, fr = lane & 15, fq = lane >> 4;
    const int K = g.K, nt = K / BK;
    unsigned voffA[2], voffB[2];
#pragma unroll
    for (int i = 0; i < 2; ++i) { int R, C; stage_rc(tid * 16 + i * 8192, R, C); const int Rb = Epi::PERM ? ((R & ~31) + perm32(R & 31)) : R;
        voffA[i] = (unsigned)(R * K + C) * 2u; voffB[i] = (unsigned)(Rb * K + C) * 2u; }
    const size_t kstep = (size_t)(BK * 2);
    const size_t hstep = (size_t)HALF * K * 2;
    const size_t tstep = 2 * hstep;
    const unsigned ldsw = (unsigned)wid * 1024u;
    const int aoff = lds_byte(wr * 64 + fr, fq * 8), boff = lds_byte(wc * 32 + fr, fq * 8);
#define PG8_SA(b, h) (((b) * 2 + (h)) * HTB)
#define PG8_SB(b, h) ((4 + (b) * 2 + (h)) * HTB)
#define PG8_STAGE(bufoff, gbase, voff) do { _Pragma("unroll") for (int _i = 0; _i < 2; ++_i) \
        __builtin_amdgcn_global_load_lds((const unsigned*)((const char*)(gbase) + (voff)[_i]), (PG8_LAS unsigned*)(lds + (bufoff) + ldsw + _i * 8192), 16, 0, 0); } while (0)
#define PG8_LDA(dst, b, h) do { _Pragma("unroll") for (int m = 0; m < 4; ++m) _Pragma("unroll") for (int k = 0; k < 2; ++k) dst[m][k] = *(const PG8_LAS bf16x8*)(lds + PG8_SA(b, h) + aoff + m * 2048 + k * 1024); } while (0)
#define PG8_LDB(dst, b, h) do { _Pragma("unroll") for (int n = 0; n < 2; ++n) _Pragma("unroll") for (int k = 0; k < 2; ++k) dst[n][k] = *(const PG8_LAS bf16x8*)(lds + PG8_SB(b, h) + boff + n * 2048 + k * 1024); } while (0)
#define PG8_MMA(ai, bj, At, Bt) do { __builtin_amdgcn_s_setprio(1); _Pragma("unroll") for (int m = 0; m < 4; ++m) _Pragma("unroll") for (int n = 0; n < 2; ++n) _Pragma("unroll") for (int k = 0; k < 2; ++k) \
        acc[ai][bj][m][n] = TR ? __builtin_amdgcn_mfma_f32_16x16x32_bf16(Bt[n][k], At[m][k], acc[ai][bj][m][n], 0, 0, 0) : __builtin_amdgcn_mfma_f32_16x16x32_bf16(At[m][k], Bt[n][k], acc[ai][bj][m][n], 0, 0, 0); __builtin_amdgcn_s_setprio(0); } while (0)
#define PG8_WAIT_V(n) asm volatile("s_waitcnt vmcnt(" #n ")" ::: "memory")
#define PG8_WAIT_L(n) asm volatile("s_waitcnt lgkmcnt(" #n ")" ::: "memory")
#define PG8_BAR __builtin_amdgcn_s_barrier()
#define PG8_SCHED __builtin_amdgcn_sched_barrier(0)
    Unit cur, nxt; int ui = 0;
    if (!S.next(0, cur)) return;
    f32x4 acc[2][2][4][2];
#pragma unroll
    for (int a = 0; a < 2; ++a)
#pragma unroll
        for (int b = 0; b < 2; ++b)
#pragma unroll
            for (int m = 0; m < 4; ++m)
#pragma unroll
                for (int n = 0; n < 2; ++n) acc[a][b][m][n] = (f32x4){0.f, 0.f, 0.f, 0.f};
    bf16x8 At[4][2], B0[2][2], B1[2][2];
    const char* cA = (const char*)g.A + (size_t)cur.pm * tstep; const char* cB = (const char*)g.Bt + (size_t)cur.pn * tstep;
    S.a_ready(cur);
    if constexpr (SP2) {
        PG8_STAGE(PG8_SB(0, 0), cB, voffB); PG8_STAGE(PG8_SB(0, 1), cB + hstep, voffB); PG8_STAGE(PG8_SA(0, 0), cA, voffA); PG8_STAGE(PG8_SA(0, 1), cA + hstep, voffA);
        if (wr == 1) PG8_BAR;
        PG8_WAIT_V(2); PG8_BAR;
        PG8_STAGE(PG8_SB(1, 0), cB + kstep, voffB); PG8_STAGE(PG8_SA(1, 0), cA + kstep, voffA); PG8_STAGE(PG8_SB(1, 1), cB + hstep + kstep, voffB);
        PG8_WAIT_V(6); PG8_BAR;
    } else {
        PG8_STAGE(PG8_SB(0, 0), cB, voffB); PG8_STAGE(PG8_SA(0, 0), cA, voffA); PG8_STAGE(PG8_SB(0, 1), cB + hstep, voffB); PG8_STAGE(PG8_SA(0, 1), cA + hstep, voffA);
        if (wr == 1) PG8_BAR;
        PG8_WAIT_V(4); PG8_BAR;
        PG8_STAGE(PG8_SB(1, 0), cB + kstep, voffB); PG8_STAGE(PG8_SA(1, 0), cA + kstep, voffA); PG8_STAGE(PG8_SB(1, 1), cB + hstep + kstep, voffB);
        PG8_WAIT_V(6); PG8_BAR;
    }
    for (;;) {
        const bool has_next = S.next(ui + 1, nxt);
        const char* nA = has_next ? (const char*)g.A + (size_t)nxt.pm * tstep : cA; const char* nB = has_next ? (const char*)g.Bt + (size_t)nxt.pn * tstep : cB;
        for (int t = 0; t < nt; t += 2) {
            const bool last = (t == nt - 2);
            const char* a1 = cA + (size_t)(t + 1) * kstep;
            const char* a2 = last ? nA : cA + (size_t)(t + 2) * kstep; const char* b2 = last ? nB : cB + (size_t)(t + 2) * kstep;
            const char* a3 = a2 + kstep; const char* b3 = b2 + kstep;
            if (last && has_next) S.a_ready(nxt);
            if constexpr (SP2) {
            PG8_LDB(B0, 0, 0); PG8_LDB(B1, 0, 1); PG8_SCHED; PG8_LDA(At, 0, 0); PG8_STAGE(PG8_SA(1, 1), a1 + hstep, voffA);
            PG8_WAIT_V(8); PG8_WAIT_L(0); PG8_BAR; PG8_MMA(0, 0, At, B0); PG8_MMA(0, 1, At, B1); PG8_BAR; PG8_SCHED;
            PG8_LDA(At, 0, 1); PG8_STAGE(PG8_SB(0, 0), b2, voffB); PG8_STAGE(PG8_SB(0, 1), b2 + hstep, voffB); PG8_STAGE(PG8_SA(0, 0), a2, voffA);
            PG8_WAIT_V(8); PG8_WAIT_L(0); PG8_BAR; PG8_MMA(1, 0, At, B0); PG8_MMA(1, 1, At, B1); PG8_BAR; PG8_SCHED;
            PG8_LDB(B0, 1, 0); PG8_LDB(B1, 1, 1); PG8_SCHED; PG8_LDA(At, 1, 0); PG8_STAGE(PG8_SA(0, 1), a2 + hstep, voffA);
            PG8_WAIT_V(8); PG8_WAIT_L(0); PG8_BAR; PG8_MMA(0, 0, At, B0); PG8_MMA(0, 1, At, B1); PG8_BAR; PG8_SCHED;
            PG8_LDA(At, 1, 1); PG8_STAGE(PG8_SB(1, 0), b3, voffB); PG8_STAGE(PG8_SB(1, 1), b3 + hstep, voffB); PG8_STAGE(PG8_SA(1, 0), a3, voffA);
            PG8_WAIT_V(8); PG8_WAIT_L(0); PG8_BAR; PG8_MMA(1, 0, At, B0); PG8_MMA(1, 1, At, B1); PG8_BAR; PG8_SCHED;
            } else {
            PG8_LDB(B0, 0, 0); PG8_SCHED; PG8_LDA(At, 0, 0); PG8_STAGE(PG8_SA(1, 1), a1 + hstep, voffA);
            PG8_WAIT_L(8); PG8_BAR; PG8_WAIT_L(0); PG8_MMA(0, 0, At, B0); PG8_BAR; PG8_SCHED;
            PG8_LDB(B1, 0, 1); PG8_STAGE(PG8_SB(0, 0), b2, voffB);
            PG8_BAR; PG8_WAIT_L(0); PG8_MMA(0, 1, At, B1); PG8_BAR;
            PG8_LDA(At, 0, 1); PG8_STAGE(PG8_SA(0, 0), a2, voffA);
            PG8_BAR; PG8_WAIT_L(0); PG8_MMA(1, 0, At, B0); PG8_BAR; PG8_SCHED;
            PG8_STAGE(PG8_SB(0, 1), b2 + hstep, voffB);
            PG8_WAIT_V(6); PG8_BAR; PG8_MMA(1, 1, At, B1); PG8_BAR;
            PG8_LDB(B0, 1, 0); PG8_SCHED; PG8_LDA(At, 1, 0); PG8_STAGE(PG8_SA(0, 1), a2 + hstep, voffA);
            PG8_WAIT_L(8); PG8_BAR; PG8_WAIT_L(0); PG8_MMA(0, 0, At, B0); PG8_BAR; PG8_SCHED;
            PG8_LDB(B1, 1, 1); PG8_STAGE(PG8_SB(1, 0), b3, voffB);
            PG8_BAR; PG8_WAIT_L(0); PG8_MMA(0, 1, At, B1); PG8_BAR;
            PG8_LDA(At, 1, 1); PG8_STAGE(PG8_SA(1, 0), a3, voffA);
            PG8_BAR; PG8_WAIT_L(0); PG8_MMA(1, 0, At, B0); PG8_BAR; PG8_SCHED;
            PG8_STAGE(PG8_SB(1, 1), b3 + hstep, voffB);
            PG8_WAIT_V(6); PG8_BAR; PG8_MMA(1, 1, At, B1); PG8_BAR;
            }
        }
        if constexpr (ALIGN_EPI) { if (wr == 0) PG8_BAR; }
        if constexpr (!Epi::AFTER_DRAIN) { E(acc, cur, wr, wc, fr, fq); S.done(cur); }
        if (!has_next) break;
#pragma unroll
        for (int a = 0; a < 2; ++a)
#pragma unroll
            for (int b = 0; b < 2; ++b)
#pragma unroll
                for (int m = 0; m < 4; ++m)
#pragma unroll
                    for (int n = 0; n < 2; ++n) acc[a][b][m][n] = (f32x4){0.f, 0.f, 0.f, 0.f};
        cur = nxt; cA = nA; cB = nB; ++ui;
        if constexpr (ALIGN_EPI) { if (wr == 1) PG8_BAR; }
    }
    PG8_WAIT_V(0);
    if constexpr (!ALIGN_EPI) { if (wr == 0) PG8_BAR; }
    PG8_BAR;
    if constexpr (Epi::AFTER_DRAIN) { E.fused(acc, cur, wr, wc, fr, fq, lds, wid, lane); S.done(cur); }
#undef PG8_SA
#undef PG8_SB
#undef PG8_STAGE
#undef PG8_LDA
#undef PG8_LDB
#undef PG8_MMA
#undef PG8_WAIT_V
#undef PG8_WAIT_L
#undef PG8_BAR
#undef PG8_SCHED
}
}
#define GAS __attribute__((address_space(1)))
#define LAS __attribute__((address_space(3)))
typedef unsigned short bf16;
typedef unsigned v4u __attribute__((ext_vector_type(4)));
typedef float f32x4 __attribute__((ext_vector_type(4)));
typedef short bf16x8 __attribute__((ext_vector_type(8)));
typedef GAS unsigned gu32;
typedef GAS unsigned long long gu64;
#define RLX_AGENT __ATOMIC_RELAXED, __HIP_MEMORY_SCOPE_AGENT
#define LDS_WAIT() asm volatile("s_waitcnt lgkmcnt(0)" ::: "memory")
#define VM_WAIT() asm volatile("s_waitcnt vmcnt(0)" ::: "memory")
__device__ __forceinline__ unsigned long long rt() { return __builtin_amdgcn_s_memrealtime(); }
__device__ __forceinline__ unsigned f2bf(float f) { unsigned u = __builtin_bit_cast(unsigned, f); return (u + 0x7fffu + ((u >> 16) & 1u)) >> 16; }
__device__ __forceinline__ unsigned pk2(float lo, float hi) { typedef __bf16 b2_ __attribute__((ext_vector_type(2))); typedef float f2_ __attribute__((ext_vector_type(2))); return __builtin_bit_cast(unsigned, __builtin_convertvector((f2_){lo, hi}, b2_)); }
#define XB_TMO      128
#define XB_XCNT(j)  (256  + 64 * (j))
#define XB_XSUB(j)  (1280 + 64 * (j))
#define XB_XGEN(j)  (2304 + 64 * (j))
#define XB_TOP      3328
#define XB_TOPGEN   3392
#define XCD_BAR_WORDS 3456
#define XB_SPIN_CAP (1u << 18)

__device__ __forceinline__ unsigned xb_ld(unsigned* p)              { return __hip_atomic_load(p, __ATOMIC_RELAXED, __HIP_MEMORY_SCOPE_AGENT); }
__device__ __forceinline__ unsigned xb_add(unsigned* p, unsigned v) { return __hip_atomic_fetch_add(p, v, __ATOMIC_RELAXED, __HIP_MEMORY_SCOPE_AGENT); }
__device__ __forceinline__ unsigned xb_xcc_id() { return (unsigned)__builtin_amdgcn_s_getreg((3 << 11) | 20) & 0xFu; }
#define XB_SPIN(cond, bar) do { unsigned _sp = 0; while (cond) { __builtin_amdgcn_s_sleep(1); \
    if ((++_sp & 255u) == 0u) { if (xb_ld(&(bar)[XB_TMO])) break; if (_sp > XB_SPIN_CAP) { atomicAdd(&(bar)[XB_TMO], 1u); break; } } } } while (0)

struct XcdBarrier {
    unsigned* bar; unsigned x;
    volatile LAS unsigned* st;
};

__device__ __forceinline__ XcdBarrier xcd_barrier_post(unsigned* bar, volatile LAS unsigned* st) {
    XcdBarrier b; b.bar = bar; b.x = xb_xcc_id(); b.st = st;
    if (threadIdx.x == 0) (void)xb_add(&bar[XB_XCNT(b.x)], 1u);
    return b;
}
__device__ __forceinline__ void xcd_barrier_complete(unsigned* bar, unsigned x, unsigned& nloc, unsigned& nx) {
    const unsigned G = gridDim.x * gridDim.y * gridDim.z;
    unsigned sum, cnt, mine, sp = 0u;
    for (;;) {
        sum = 0u; cnt = 0u; mine = 0u;
#pragma unroll
        for (unsigned j = 0; j < 16; ++j) { const unsigned c = xb_ld(&bar[XB_XCNT(j)]); sum += c; cnt += (c > 0u) ? 1u : 0u; mine = (j == x) ? c : mine; }
        if (sum == G) break;
        __builtin_amdgcn_s_sleep(1);
        if ((++sp & 255u) == 0u) { if (xb_ld(&bar[XB_TMO])) break; if (sp > XB_SPIN_CAP) { atomicAdd(&bar[XB_TMO], 1u); break; } }
    }
    nloc = mine > 0u ? mine : 1u; nx = cnt > 0u ? cnt : 1u;
}

__device__ __forceinline__ void xcd_barrier(const XcdBarrier& b) {
    asm volatile("s_waitcnt vmcnt(0)" ::: "memory");
    __syncthreads();
    if (threadIdx.x == 0) {
        unsigned* bar = b.bar;
        __builtin_amdgcn_s_waitcnt(0);
        unsigned nloc = b.st[0], nx = b.st[1];
        if (nloc == 0u) { xcd_barrier_complete(bar, b.x, nloc, nx); b.st[0] = nloc; b.st[1] = nx; }
        const unsigned old = xb_add(&bar[XB_XSUB(b.x)], 1u);
        const unsigned gen = old / nloc;
        if (old + 1u == (gen + 1u) * nloc) {
            __builtin_amdgcn_fence(__ATOMIC_RELEASE, "agent");
            asm volatile("s_waitcnt vmcnt(0)" ::: "memory");
            const unsigned og = xb_add(&bar[XB_TOP], 1u);
            const unsigned tg = og / nx;
            if (og + 1u == (tg + 1u) * nx) xb_add(&bar[XB_TOPGEN], 1u);
            else XB_SPIN(xb_ld(&bar[XB_TOPGEN]) == tg, bar);
            __builtin_amdgcn_fence(__ATOMIC_ACQUIRE, "agent");
            xb_add(&bar[XB_XGEN(b.x)], 1u);
            asm volatile("s_waitcnt vmcnt(0)" ::: "memory");
        } else {
            XB_SPIN(xb_ld(&bar[XB_XGEN(b.x)]) == gen, bar);
            __builtin_amdgcn_fence(__ATOMIC_ACQUIRE, "agent");
            asm volatile("s_waitcnt vmcnt(0)" ::: "memory");
        }
    }
    __syncthreads();
}
#define REP_MASK 0u
#ifndef PG8_SP2
#define PG8_SP2 true
#endif
#ifndef PG8_ALIGN
#define PG8_ALIGN true
#endif
constexpr int NWAVES = 8, NTHR = NWAVES * 64;
constexpr int BATCH = 4, SEQ = 2048, DM = 4096, NMETA = 16;
constexpr int MR = BATCH * SEQ;
constexpr int MROWS = MR + NMETA;
constexpr int MT = 8448;
constexpr int NIN = 32784;
constexpr int N1 = 33024;
constexpr int DFF = 11008, NF = 2 * DFF;
constexpr int RET_H = 8, RET_DK = 256, RET_DV = 512, GLA_H = 4, GLA_DK = 512, GLA_DV = 1024, GLA_RANK = 16;
constexpr float EPS = 1e-6f;
constexpr int C_QR = 0, C_QG = 2048, C_KG = 4096, C_GR = 6144, C_GG = 14336, C_B = 22528, C_KR = 22528, C_V = 24576, C_Z = 32768, LDP = 4096, P_QG = 0, P_KG = 2048;
constexpr int NPH = 11;
#ifndef MK_N_LAUNCHES
#define MK_N_LAUNCHES 1
#endif
constexpr int N_LAUNCHES = MK_N_LAUNCHES;

constexpr size_t al256(size_t x) { return (x + 255) & ~(size_t)255; }
constexpr size_t WS_CTL = 0, CTL_ZERO_BYTES = 1u << 20;
constexpr size_t WS_W1T = WS_CTL + CTL_ZERO_BYTES;
constexpr size_t WS_WOT = WS_W1T + al256((size_t)N1 * DM * 2);
constexpr size_t WS_WFT = WS_WOT + al256((size_t)DM * DM * 2);
constexpr size_t WS_W2T = WS_WFT + al256((size_t)NF * DM * 2);
constexpr size_t WS_XB  = WS_W2T + al256((size_t)DM * DFF * 2);
constexpr size_t WS_RS1 = WS_XB + al256((size_t)MT * DM * 2);
constexpr size_t WS_RS2 = WS_RS1 + al256((size_t)MT * 4);
constexpr size_t WS_ZB  = WS_RS2 + al256((size_t)MT * 4);
constexpr size_t WS_COS = WS_ZB + al256((size_t)MT * 16 * 4);
constexpr size_t WS_SIN = WS_COS + al256((size_t)MROWS * 128 * 4);
constexpr size_t WS_COST = WS_SIN + al256((size_t)MROWS * 128 * 4);
constexpr size_t WS_SINT = WS_COST + (size_t)128 * MT * 4;
constexpr size_t WS_PROJ = WS_SINT + (size_t)128 * MT * 4;
constexpr size_t WS_UG  = WS_PROJ;
constexpr size_t WS_ACT = WS_UG + al256((size_t)MT * NF * 2);
constexpr size_t WS_YR  = WS_PROJ + al256((size_t)MT * N1 * 2);
constexpr size_t WS_YG  = WS_YR + al256((size_t)MROWS * DM * 2);
constexpr size_t WS_GR  = WS_YG + al256((size_t)MROWS * DM * 2);
constexpr size_t WS_GG  = WS_GR + al256((size_t)MT * DM * 2);
constexpr size_t WS_MRG = WS_GG + al256((size_t)MT * DM * 2);
constexpr size_t WS_H1  = WS_MRG + al256((size_t)MT * DM * 2);
constexpr size_t WS_H1B = WS_H1 + al256((size_t)MT * DM * 4);
constexpr size_t WS_QFG = WS_H1B + al256((size_t)MT * DM * 2);
constexpr size_t WS_KFG = WS_QFG + (size_t)4 * 4 * 33 * 65536;
constexpr size_t WS_QFR = WS_KFG + (size_t)4 * 4 * 33 * 65536;
constexpr size_t WS_KFR = WS_QFR + (size_t)4 * 8 * 33 * 32768;
constexpr size_t WS_VFG = WS_KFR + (size_t)4 * 8 * 33 * 32768;
constexpr size_t WS_VFR = WS_VFG + (size_t)4 * 33 * 64 * 8192;
constexpr size_t WS_PFG = WS_VFR + (size_t)4 * 33 * 64 * 8192;
constexpr size_t WS_PFR = WS_PFG + (size_t)4 * 4 * 33 * 8192;
constexpr size_t WS_DECG = WS_PFR + (size_t)4 * 8 * 33 * 8192;
constexpr size_t WS_UPH = WS_DECG + (size_t)4 * 4 * 33 * 512 * 4;
constexpr size_t WS_PARTC = WS_UPH + (size_t)32 * 2 * DFF * 4;
constexpr size_t WS_PARTG = WS_PARTC + (size_t)32 * 2 * DFF * 4;
constexpr size_t WS_UPM = WS_PARTG + (size_t)32 * 2 * DFF * 4;
constexpr size_t WS_END = WS_UPM + (size_t)2 * DFF * 4;
static_assert(WS_ACT + (size_t)MR * DFF * 2 <= WS_YR, "UG | ACT overlay fits inside PROJ");
static_assert(WS_END <= (size_t)4 * 4096 * NIN * 4, "workspace map fits 4 x the largest tensor");
constexpr int CW_TMO = 0, CW_CODE = 1, CW_BAR = 4096, CW_SS2 = 8192;

constexpr int RING_OFF = 0, RING_BYTES = 131072;
constexpr int LDS_BYTES = 163840;
constexpr int LDSCTL_OFF = LDS_BYTES - 1024, MISC_OFF = LDSCTL_OFF + 320;
static_assert(MISC_OFF + 128 <= LDS_BYTES, "LDS map");

__device__ __forceinline__ float bf2f(bf16 v) { return __builtin_bit_cast(float, (unsigned)v << 16); }
__device__ __forceinline__ float wave_sum(float v) {
#pragma unroll
    for (int o = 1; o < 64; o <<= 1) v += __shfl_xor(v, o);
    return v;
}
__device__ __forceinline__ float sigm(float x) { return 1.f / (1.f + __expf(-x)); }
__device__ __forceinline__ float silu(float x) { return x / (1.f + __expf(-x)); }
__device__ __forceinline__ float logsig(float x) { return fminf(x, 0.f) - __logf(1.0f + __expf(-fabsf(x))); }

typedef float f32x16 __attribute__((ext_vector_type(16)));
#define MFMA32(a, b, c) __builtin_amdgcn_mfma_f32_32x32x16_bf16((a), (b), (c), 0, 0, 0)
__device__ __forceinline__ unsigned pkbf(float lo, float hi) { typedef __bf16 b2 __attribute__((ext_vector_type(2))); typedef float f2 __attribute__((ext_vector_type(2))); return __builtin_bit_cast(unsigned, __builtin_convertvector((f2){lo, hi}, b2)); }
__device__ __forceinline__ bf16 f2b(float x) { return (bf16)(pkbf(x, 0.f) & 0xffffu); }
__device__ __forceinline__ int chunk_row(int b, int n, int i) { return n == 0 ? (i < 48 ? -1 : MR + i - 48) : b * SEQ + 64 * (n - 1) + i; }

struct Frame {
    LAS unsigned char* lds;
    volatile LAS unsigned* MISC;
    gu32* ctl;
    int tid, lane, wave, G;
    const float *x, *meta, *attn_norm, *w_in, *w_gate_up, *b_gate, *ret_norm, *gla_norm, *w_out, *ffn_norm, *w_ffn_in, *conv_w, *conv_b, *w_ffn_out, *final_norm;
    const int* positions;
    float* out;
    bf16 *W1t, *Wot, *Wft, *W2t, *XB, *PROJ, *UG, *ACT, *MRG, *H1B;
    float *RS1, *SS2, *ZB, *COS, *SIN, *COST, *SINT, *H1, *DECG, *UPH, *PARTC, *PARTG, *UPM;
    bf16 *YR, *YG, *GR, *GG, *QFG, *KFG, *QFR, *KFR, *VFG, *VFR, *PFG, *PFR;
};

namespace pg8 {
__device__ __forceinline__ float gate2(float o, float m) { return o * __builtin_amdgcn_rcpf((1.0f + __expf(-o)) * (1.0f + __expf(-m))); }
typedef unsigned long long u64_t;
__device__ __forceinline__ u64_t pk4(const f32x4& v) { return (u64_t)cvt_pk_bf16(v[0], v[1]) | ((u64_t)cvt_pk_bf16(v[2], v[3]) << 32); }
struct EpiA {
    static constexpr bool PERM = true, AFTER_DRAIN = false;
    bf16_t* O; const float* rs; const float* cs; const float* sn; unsigned char* QFR; bf16_t* GR; bf16_t* GG;
    __device__ __forceinline__ void operator()(const f32x4 (&acc)[2][2][4][2], const Unit& u, int wr, int wc, int fr, int fq) const {
        const int row0 = u.pm * BM + wr * 64 + fr;
        if (u.pn < 8) {
            const int h = u.pn, b = u.pm >> 3; const float l2g = __log2f(1.0f - exp2f(-5.0f - (float)h));
#pragma unroll
            for (int ai = 0; ai < 2; ++ai) { const size_t cb = (size_t)(b * 8 + h) * 33 + 1 + 4 * (u.pm & 7) + 2 * ai + wr;
                unsigned char* qb = QFR + (cb * 8 + wc) * 4096 + (fq >> 1) * 2048 + fr * 16 + 8 * (fq & 1);
#pragma unroll
                for (int m = 0; m < 4; ++m) { const int row = row0 + ai * HALF + m * 16; const float dq = exp2f((float)(16 * m + fr + 1) * l2g) * rs[row];
                    const float* cp = cs + (size_t)row * 128 + wc * 32 + 8 * fq; const float* sp = sn + (size_t)row * 128 + wc * 32 + 8 * fq;
#pragma unroll
                    for (int n = 0; n < 2; ++n) { const f32x4 c = *(const f32x4*)(cp + 4 * n), s4 = *(const f32x4*)(sp + 4 * n), x1 = acc[ai][0][m][n], x2 = acc[ai][1][m][n];
                        const f32x4 o1 = (x1 * c - x2 * s4) * dq, o2 = (x2 * c + x1 * s4) * dq;
                        unsigned char* d = qb + (m >> 1) * 1024 + (16 * (m & 1) + 32 * n) * 16;
                        *(u64_t*)d = pk4(o1); *(u64_t*)(d + 4 * 4096) = pk4(o2); }
                    asm volatile("" ::: "memory"); } }
        } else if (u.pn < 24) {
            const int col0 = (u.pn - 8) * BM + wc * 32 + 8 * fq;
#pragma unroll
            for (int ai = 0; ai < 2; ++ai)
#pragma unroll
                for (int m = 0; m < 4; ++m) { const int row = row0 + ai * HALF + m * 16; const float s = rs[row]; bf16_t* rowp = O + (size_t)row * LDP + col0;
#pragma unroll
                    for (int bj = 0; bj < 2; ++bj) { const f32x4 v0 = acc[ai][bj][m][0] * s, v1 = acc[ai][bj][m][1] * s;
                        u32x4 w; w.x = cvt_pk_bf16(v0[0], v0[1]); w.y = cvt_pk_bf16(v0[2], v0[3]); w.z = cvt_pk_bf16(v1[0], v1[1]); w.w = cvt_pk_bf16(v1[2], v1[3]);
                        *(u32x4*)(rowp + bj * HALF) = w; } }
        } else {
            bf16_t* G = u.pn < 56 ? GR : GG; const int col0 = 128 * ((u.pn - 24) & 31) + wc * 32 + 8 * fq;
#pragma unroll
            for (int ai = 0; ai < 2; ++ai)
#pragma unroll
                for (int m = 0; m < 4; ++m) { const int row = row0 + ai * HALF + m * 16; const float s = rs[row];
                    const f32x4 o0 = acc[ai][0][m][0] * s, o1 = acc[ai][0][m][1] * s, m0 = acc[ai][1][m][0] * s, m1 = acc[ai][1][m][1] * s;
                    u32x4 w; w.x = cvt_pk_bf16(gate2(o0[0], m0[0]), gate2(o0[1], m0[1])); w.y = cvt_pk_bf16(gate2(o0[2], m0[2]), gate2(o0[3], m0[3]));
                    w.z = cvt_pk_bf16(gate2(o1[0], m1[0]), gate2(o1[1], m1[1])); w.w = cvt_pk_bf16(gate2(o1[2], m1[2]), gate2(o1[3], m1[3]));
                    *(u32x4*)(G + (size_t)row * DM + col0) = w; }
        }
    }
};
struct EpiB {
    static constexpr bool PERM = false, AFTER_DRAIN = false;
    unsigned char* VFR; unsigned char* VFG; unsigned char* KFR; const float* rs; const float* cst; const float* snt;
    __device__ __forceinline__ void operator()(const f32x4 (&acc)[2][2][4][2], const Unit& u, int wr, int wc, int fr, int fq) const {
        const int b = u.pm >> 3;
        if (u.pn < 8) {
            const int h = u.pn; const float l2g = __log2f(1.0f - exp2f(-5.0f - (float)h));
#pragma unroll
            for (int ai = 0; ai < 2; ++ai) { const size_t cb = (size_t)(b * 8 + h) * 33 + 1 + 4 * (u.pm & 7) + 2 * ai + wr;
                unsigned char* kb = KFR + (cb * 8 + wc) * 4096 + (fr + 32 * (fq & 1)) * 16 + 8 * (fq >> 1);
#pragma unroll
                for (int m = 0; m < 4; ++m) { const int rowb = u.pm * BM + ai * HALF + wr * 64 + m * 16 + 4 * fq; const f32x4 s4 = *(const f32x4*)(rs + rowb); f32x4 dk4;
#pragma unroll
                    for (int e = 0; e < 4; ++e) dk4[e] = exp2f(-(float)(16 * m + 4 * fq + e + 1) * l2g) * 0.0625f * s4[e];
#pragma unroll
                    for (int n = 0; n < 2; ++n) { const int idx = wc * 32 + n * 16 + fr;
                        const f32x4 c = *(const f32x4*)(cst + (size_t)idx * MT + rowb), sn4 = *(const f32x4*)(snt + (size_t)idx * MT + rowb), x1 = acc[ai][0][m][n], x2 = acc[ai][1][m][n];
                        const f32x4 o1 = (x1 * c - x2 * sn4) * dk4, o2 = (x2 * c + x1 * sn4) * dk4;
                        unsigned char* d = kb + m * 1024 + n * 256;
                        *(u64_t*)d = pk4(o1); *(u64_t*)(d + 4 * 4096) = pk4(o2); }
                    asm volatile("" ::: "memory"); } }
        } else {
            const int pv = u.pn - 8; unsigned char* VF = pv < 16 ? VFR : VFG;
#pragma unroll
            for (int ai = 0; ai < 2; ++ai) { const int nc = 1 + 4 * (u.pm & 7) + 2 * ai + wr;
#pragma unroll
                for (int m = 0; m < 4; ++m) { const f32x4 s4 = *(const f32x4*)(rs + u.pm * BM + ai * HALF + wr * 64 + m * 16 + 4 * fq);
#pragma unroll
                    for (int bj = 0; bj < 2; ++bj) { const int slg = 4 * (pv & 15) + 2 * bj + (wc >> 1);
                        unsigned char* fb = VF + ((((size_t)b * 33 + nc) * 64 + slg) * 8 + (wc & 1) * 4 + m) * 1024 + (fr + 32 * (fq & 1)) * 16 + 8 * (fq >> 1);
#pragma unroll
                        for (int n = 0; n < 2; ++n) { const f32x4 v = acc[ai][bj][m][n] * s4; *(u64_t*)(fb + n * 256) = pk4(v); } } } }
        }
    }
};
struct EpiScaleBf16 {
    static constexpr bool PERM = true, AFTER_DRAIN = false;
    bf16_t* O; int ldc; const float* ss;
    __device__ __forceinline__ void operator()(const f32x4 (&acc)[2][2][4][2], const Unit& u, int wr, int wc, int fr, int fq) const {
        const int row0 = u.pm * BM + wr * 64 + fr, col0 = u.pn * BM + wc * 32 + 8 * fq;
#pragma unroll
        for (int ai = 0; ai < 2; ++ai)
#pragma unroll
            for (int m = 0; m < 4; ++m) { const int row = row0 + ai * HALF + m * 16; const float s = 1.0f / sqrtf(ss[row] * (1.0f / 4096.0f) + 1e-6f); bf16_t* rowp = O + (size_t)row * ldc + col0;
#pragma unroll
                for (int bj = 0; bj < 2; ++bj) { const f32x4 v0 = acc[ai][bj][m][0] * s, v1 = acc[ai][bj][m][1] * s;
                    u32x4 w; w.x = cvt_pk_bf16(v0[0], v0[1]); w.y = cvt_pk_bf16(v0[2], v0[3]); w.z = cvt_pk_bf16(v1[0], v1[1]); w.w = cvt_pk_bf16(v1[2], v1[3]);
                    *(u32x4*)(rowp + bj * HALF) = w; } }
    }
};
struct EpiFfn {
    static constexpr bool PERM = true, AFTER_DRAIN = false;
    bf16_t* ACT; const float* ss; const float* cw; const float* cbias; float* UPH; float* PARTC; float* PARTG; PG8_LAS float* hl;
    __device__ __forceinline__ void operator()(const f32x4 (&acc)[2][2][4][2], const Unit& u, int wr, int wc, int fr, int fq) const {
        const int ch0 = wc * 32 + 8 * fq, cg = 128 * u.pn + ch0;
        f32x4 w0[2], w1[2], w2[2], cb[2];
#pragma unroll
        for (int n = 0; n < 2; ++n) { w0[n] = *(const f32x4*)(cw + cg + 4 * n); w1[n] = *(const f32x4*)(cw + DFF + cg + 4 * n); w2[n] = *(const f32x4*)(cw + 2 * DFF + cg + 4 * n); cb[n] = *(const f32x4*)(cbias + cg + 4 * n); }
        float rsv[2][4];
#pragma unroll
        for (int ai = 0; ai < 2; ++ai)
#pragma unroll
            for (int m = 0; m < 4; ++m) rsv[ai][m] = 1.0f / sqrtf(ss[u.pm * BM + ai * HALF + wr * 64 + m * 16 + fr] * (1.0f / 4096.0f) + 1e-6f);
        if (fr >= 14) {
#pragma unroll
            for (int ai = 0; ai < 2; ++ai)
#pragma unroll
                for (int n = 0; n < 2; ++n) { const f32x4 v = acc[ai][0][3][n] * rsv[ai][3];
                    *(PG8_LAS f32x4*)(hl + ((2 * ai + wr) * 2 + (fr - 14)) * 128 + ch0 + 4 * n) = v;
                    if (ai == 1 && wr == 1) *(f32x4*)(UPH + ((size_t)u.pm * 2 + (fr - 14)) * DFF + cg + 4 * n) = v; }
        }
        asm volatile("s_waitcnt lgkmcnt(0)" ::: "memory"); __builtin_amdgcn_s_barrier(); asm volatile("" ::: "memory");
#pragma unroll
        for (int ai = 0; ai < 2; ++ai) { const int bl = 2 * ai + wr;
            f32x4 p1[2], p2[2];
#pragma unroll
            for (int n = 0; n < 2; ++n) { p1[n] = (f32x4){0.f, 0.f, 0.f, 0.f}; p2[n] = p1[n];
                if (bl > 0) { const f32x4 r62 = *(const PG8_LAS f32x4*)(hl + ((bl - 1) * 2 + 0) * 128 + ch0 + 4 * n), r63 = *(const PG8_LAS f32x4*)(hl + ((bl - 1) * 2 + 1) * 128 + ch0 + 4 * n);
                    p1[n] = r63; p2[n] = fr == 0 ? r62 : r63; } }
#pragma unroll
            for (int m = 0; m < 4; ++m) { const int row = u.pm * BM + ai * HALF + wr * 64 + m * 16 + fr; float res[8];
#pragma unroll
                for (int n = 0; n < 2; ++n) { const f32x4 up0 = acc[ai][0][m][n] * rsv[ai][m], gt = acc[ai][1][m][n] * rsv[ai][m]; f32x4 c1, c2, l15, l14;
#pragma unroll
                    for (int j = 0; j < 4; ++j) { c1[j] = __shfl_up(up0[j], 1, 16); c2[j] = __shfl_up(up0[j], 2, 16); l15[j] = __shfl(up0[j], 15, 16); l14[j] = __shfl(up0[j], 14, 16); }
                    const f32x4 up1 = fr >= 1 ? c1 : p1[n], up2 = fr >= 2 ? c2 : p2[n];
                    const f32x4 cc = cb[n] + w0[n] * up2 + w1[n] * up1 + w2[n] * up0;
                    if (bl == 0 && m == 0 && fr < 2) {
                        *(f32x4*)(PARTC + ((size_t)u.pm * 2 + fr) * DFF + cg + 4 * n) = cc; *(f32x4*)(PARTG + ((size_t)u.pm * 2 + fr) * DFF + cg + 4 * n) = gt; }
#pragma unroll
                    for (int j = 0; j < 4; ++j) res[4 * n + j] = cc[j] * __builtin_amdgcn_rcpf(1.0f + __expf(-cc[j])) * gt[j];
                    p1[n] = l15; p2[n] = fr == 0 ? l14 : l15; }
                u32x4 w; w.x = cvt_pk_bf16(res[0], res[1]); w.y = cvt_pk_bf16(res[2], res[3]); w.z = cvt_pk_bf16(res[4], res[5]); w.w = cvt_pk_bf16(res[6], res[7]);
                *(u32x4*)(ACT + (size_t)row * DFF + cg) = w; } }
    }
};
struct EpiResX {
    static constexpr bool PERM = true, AFTER_DRAIN = false;
    const float* x; const float* meta; float* out; bf16_t* outb; float* ss; int ldc; int nreal, nmeta;
    __device__ __forceinline__ void operator()(const f32x4 (&acc)[2][2][4][2], const Unit& u, int wr, int wc, int fr, int fq) const {
        const int row0 = u.pm * BM + wr * 64 + fr, col0 = u.pn * BM + wc * 32 + 8 * fq;
#pragma unroll
        for (int ai = 0; ai < 2; ++ai)
#pragma unroll
            for (int m = 0; m < 4; ++m) { const int row = row0 + ai * HALF + m * 16;
                const float* bp = row < nreal ? x + (size_t)row * ldc : (row < nreal + nmeta ? meta + (size_t)(row - nreal) * ldc : nullptr);
                float* rowp = out + (size_t)row * ldc + col0; bf16_t* rowb = outb + (size_t)row * ldc + col0; float q = 0.f;
#pragma unroll
                for (int bj = 0; bj < 2; ++bj) { f32x4 o0 = (f32x4){0.f, 0.f, 0.f, 0.f}, o1 = o0;
                    if (bp) { o0 = *(const f32x4*)(bp + col0 + bj * HALF) + acc[ai][bj][m][0]; o1 = *(const f32x4*)(bp + col0 + bj * HALF + 4) + acc[ai][bj][m][1]; }
                    *(f32x4*)(rowp + bj * HALF) = o0; *(f32x4*)(rowp + bj * HALF + 4) = o1;
                    u32x4 w; w.x = cvt_pk_bf16(o0[0], o0[1]); w.y = cvt_pk_bf16(o0[2], o0[3]); w.z = cvt_pk_bf16(o1[0], o1[1]); w.w = cvt_pk_bf16(o1[2], o1[3]);
                    *(u32x4*)(rowb + bj * HALF) = w;
                    q += (o0[0] * o0[0] + o0[1] * o0[1]) + (o0[2] * o0[2] + o0[3] * o0[3]) + (o1[0] * o1[0] + o1[1] * o1[1]) + (o1[2] * o1[2] + o1[3] * o1[3]); }
                q += __shfl_xor(q, 16); q += __shfl_xor(q, 32);
                if (fq == 0 && bp) atomicAdd(ss + row, q); }
    }
};
struct EpiResF32 {
    static constexpr bool PERM = false, AFTER_DRAIN = false;
    const float* base; float* out; int ldc;
    __device__ __forceinline__ void operator()(const f32x4 (&acc)[2][2][4][2], const Unit& u, int wr, int wc, int fr, int fq) const {
        const int row0 = u.pm * BM + wr * 64 + fr, col0 = u.pn * BM + wc * 32 + 4 * fq;
#pragma unroll
        for (int ai = 0; ai < 2; ++ai)
#pragma unroll
            for (int m = 0; m < 4; ++m) { const size_t off = (size_t)(row0 + ai * HALF + m * 16) * ldc + col0;
#pragma unroll
                for (int bj = 0; bj < 2; ++bj)
#pragma unroll
                    for (int n = 0; n < 2; ++n) *(f32x4*)(out + off + bj * HALF + n * 16) = *(const f32x4*)(base + off + bj * HALF + n * 16) + acc[ai][bj][m][n]; }
    }
};
}

struct TItem { const float* W; int K, ldw, c0, nc; bf16* WT; int row_off; const float* kscale; int item; int blk, bstride; };
__device__ __forceinline__ void titem_kn(const TItem& t, int& kb, int& nb) {
    const int nblk = (t.nc + 63) / 64, nkb = t.K / 64;
    if (nblk % 4) { kb = t.item % nkb; nb = t.item / nkb; } else { const int g = t.item >> 2; kb = g % nkb; nb = (g / nkb) * 4 + (t.item & 3); }
}
__device__ __forceinline__ void titem_load(const TItem& t, f32x4 (&v)[16], int lane) {
    int kb, nb; titem_kn(t, kb, nb); const int k0 = 64 * kb, n = 64 * nb + 4 * (lane & 15);
    const bool ok = n < t.nc;
    const float* p = t.W + (size_t)(k0 + (lane >> 4)) * t.ldw + t.c0 + n;
#pragma unroll
    for (int i = 0; i < 16; ++i) v[i] = ok ? *(const f32x4*)(p + (size_t)(4 * i) * t.ldw) : (f32x4){0.f, 0.f, 0.f, 0.f};
}
__device__ __forceinline__ void titem_store(const TItem& t, const f32x4 (&v)[16], LAS float* scr, int lane) {
    int kb, nb; titem_kn(t, kb, nb); const int k0 = 64 * kb, n0 = 64 * nb;
#pragma unroll
    for (int i = 0; i < 16; ++i) { LAS float* d = scr + (4 * i + (lane >> 4)) * 65 + 4 * (lane & 15); d[0] = v[i].x; d[1] = v[i].y; d[2] = v[i].z; d[3] = v[i].w; }
    LDS_WAIT(); asm volatile("" ::: "memory");
    const int c = lane & 7;
    f32x4 s0 = (f32x4){1.f, 1.f, 1.f, 1.f}, s1 = s0;
    if (t.kscale) { s0 = *(const f32x4*)(t.kscale + k0 + 8 * c); s1 = *(const f32x4*)(t.kscale + k0 + 8 * c + 4); }
#pragma unroll
    for (int j = 0; j < 8; ++j) { const int nn = (lane >> 3) + 8 * j; const LAS float* s = scr + (8 * c) * 65 + nn;
        v4u o; o.x = pk2(s[0 * 65] * s0.x, s[1 * 65] * s0.y); o.y = pk2(s[2 * 65] * s0.z, s[3 * 65] * s0.w); o.z = pk2(s[4 * 65] * s1.x, s[5 * 65] * s1.y); o.w = pk2(s[6 * 65] * s1.z, s[7 * 65] * s1.w);
        const int nd = n0 + nn; *(GAS v4u*)(t.WT + (size_t)(t.row_off + (nd / t.blk) * t.bstride + nd % t.blk) * t.K + k0 + 8 * c) = o; }
    LDS_WAIT(); asm volatile("" ::: "memory");
}
__device__ __forceinline__ void p0_prologue(Frame& F) {
    LAS float* scr = (LAS float*)(F.lds + RING_OFF + F.wave * 17408);
    const int gw = blockIdx.x * NWAVES + F.wave, NGW = F.G * NWAVES;
    constexpr int BIG = 1 << 30;
    constexpr int I_2K = 64 * (2048 / 64), I_4K = 64 * (4096 / 64), I_Z = 64;
    constexpr int I_O = 64 * (DM / 64), I_F = 64 * (NF / 64), I_2 = (DFF / 64) * (DM / 64);
    constexpr int NITEMS = 4 * I_2K + 6 * I_4K + I_Z + I_O + I_F + I_2;
    auto mk = [&](int it) { TItem t; int r = it;
        if (r < I_2K) { t = TItem{F.w_in, DM, NIN, 0, 2048, F.W1t, C_QR, F.attn_norm, r, BIG, 0}; return t; } r -= I_2K;
        if (r < I_2K) { t = TItem{F.w_in, DM, NIN, 2048, 2048, F.W1t, C_KR, F.attn_norm, r, BIG, 0}; return t; } r -= I_2K;
        if (r < I_4K) { t = TItem{F.w_in, DM, NIN, 4096, 4096, F.W1t, C_V, F.attn_norm, r, BIG, 0}; return t; } r -= I_4K;
        if (r < I_4K) { t = TItem{F.w_in, DM, NIN, 8192, 4096, F.W1t, C_GR, F.attn_norm, r, 128, 256}; return t; } r -= I_4K;
        if (r < I_2K) { t = TItem{F.w_in, DM, NIN, 12288, 2048, F.W1t, C_QG, F.attn_norm, r, BIG, 0}; return t; } r -= I_2K;
        if (r < I_2K) { t = TItem{F.w_in, DM, NIN, 14336, 2048, F.W1t, C_KG, F.attn_norm, r, BIG, 0}; return t; } r -= I_2K;
        if (r < I_4K) { t = TItem{F.w_in, DM, NIN, 16384, 4096, F.W1t, C_V + 4096, F.attn_norm, r, BIG, 0}; return t; } r -= I_4K;
        if (r < I_4K) { t = TItem{F.w_in, DM, NIN, 20480, 4096, F.W1t, C_GG, F.attn_norm, r, 128, 256}; return t; } r -= I_4K;
        if (r < I_Z) { t = TItem{F.w_in, DM, NIN, 24576, 16, F.W1t, C_Z, F.attn_norm, r, BIG, 0}; return t; } r -= I_Z;
        if (r < I_4K) { t = TItem{F.w_in, DM, NIN, 24592, 4096, F.W1t, C_GR + 128, F.attn_norm, r, 128, 256}; return t; } r -= I_4K;
        if (r < I_4K) { t = TItem{F.w_in, DM, NIN, 28688, 4096, F.W1t, C_GG + 128, F.attn_norm, r, 128, 256}; return t; } r -= I_4K;
        if (r < I_O) { t = TItem{F.w_out, DM, DM, 0, DM, F.Wot, 0, nullptr, r, BIG, 0}; return t; } r -= I_O;
        if (r < I_F / 2) { t = TItem{F.w_ffn_in, DM, NF, 0, DFF, F.Wft, 0, F.ffn_norm, r, 128, 256}; return t; } r -= I_F / 2;
        if (r < I_F / 2) { t = TItem{F.w_ffn_in, DM, NF, DFF, DFF, F.Wft, 128, F.ffn_norm, r, 128, 256}; return t; } r -= I_F / 2;
        t = TItem{F.w_ffn_out, DFF, DM, 0, DM, F.W2t, 0, nullptr, r, BIG, 0}; return t; };
    if (gw < NITEMS) {
        f32x4 cur[16], nxt[16]; TItem tc = mk(gw); titem_load(tc, cur, F.lane);
        for (int it = gw; it < NITEMS; it += NGW) {
            const bool more = it + NGW < NITEMS; TItem tn = tc;
            if (more) { tn = mk(it + NGW); titem_load(tn, nxt, F.lane); }
            titem_store(tc, cur, scr, F.lane);
            if (more) {
#pragma unroll
                for (int i = 0; i < 16; ++i) cur[i] = nxt[i];
                tc = tn; }
        }
    }
    { const size_t n16 = (size_t)(N1 - C_Z - 64) * DM * 2 / 16; GAS v4u* p = (GAS v4u*)(F.W1t + (size_t)(C_Z + 64) * DM);
      for (size_t i = (size_t)blockIdx.x * NTHR + F.tid; i < n16; i += (size_t)F.G * NTHR) p[i] = (v4u){0u, 0u, 0u, 0u}; }
    { const size_t n16 = (size_t)64 * 8 * 1024 / 16;
      for (size_t i = (size_t)blockIdx.x * NTHR + F.tid; i < 2 * n16; i += (size_t)F.G * NTHR) ((GAS v4u*)(i < n16 ? F.VFR : F.VFG))[i < n16 ? i : i - n16] = (v4u){0u, 0u, 0u, 0u}; }
    for (int i = blockIdx.x * NTHR + F.tid; i < 2 * 8 * 2048; i += F.G * NTHR) {
        const int which = i >> 14, h = (i >> 11) & 7, o = i & 2047; ((GAS v4u*)((unsigned char*)(which ? F.KFR : F.QFR) + (size_t)h * 33 * 32768))[o] = (v4u){0u, 0u, 0u, 0u}; }
    for (int m = gw; m < MT; m += NGW) {
        GAS unsigned long long* o8 = (GAS unsigned long long*)(F.XB + (size_t)m * DM) + F.lane;
        if (m < MROWS) {
            const float* xrow = m < MR ? F.x + (size_t)m * DM : F.meta + (size_t)(m - MR) * DM;
            const GAS f32x4* xr = (const GAS f32x4*)xrow + F.lane; float ss = 0.f;
#pragma unroll
            for (int j = 0; j < 16; ++j) { const f32x4 v = xr[64 * j]; ss += (v.x * v.x + v.y * v.y) + (v.z * v.z + v.w * v.w);
                o8[64 * j] = (unsigned long long)pk2(v.x, v.y) | ((unsigned long long)pk2(v.z, v.w) << 32); }
            ss = wave_sum(ss);
            if (F.lane == 0) F.RS1[m] = 1.0f / sqrtf(ss * (1.0f / DM) + EPS);
        } else {
            GAS unsigned long long* o2 = (GAS unsigned long long*)(F.MRG + (size_t)m * DM) + F.lane;
            GAS unsigned long long* o3 = (GAS unsigned long long*)(F.H1B + (size_t)m * DM) + F.lane;
#pragma unroll
            for (int j = 0; j < 16; ++j) { o8[64 * j] = 0ull; o2[64 * j] = 0ull; o3[64 * j] = 0ull; }
            if (F.lane == 0) F.RS1[m] = 0.f;
        }
    }
    for (int i = blockIdx.x * NTHR + F.tid; i < 2 * MROWS * 128; i += F.G * NTHR) {
        const bool tr = i >= MROWS * 128; const int ii = tr ? i - MROWS * 128 : i;
        const int m = tr ? ii % MROWS : ii >> 7, j = tr ? ii / MROWS : ii & 127;
        const int pos = m < MR ? F.positions[m] + NMETA : m - MR;
        const float inv_freq = powf(10000.0f, -(float)j * (1.0f / 128.0f));
        const float ang = (float)pos * inv_freq; float s, c; sincosf(ang, &s, &c);
        if (tr) { F.COST[(size_t)j * MT + m] = c; F.SINT[(size_t)j * MT + m] = s; } else { F.COS[ii] = c; F.SIN[ii] = s; }
    }
}

typedef float f32x4v __attribute__((ext_vector_type(4)));
#define MFMA16(a, b, c) __builtin_amdgcn_mfma_f32_16x16x32_bf16((a), (b), (c), 0, 0, 0)
__device__ __forceinline__ f32x4v skinny_dot(const bf16* A, const bf16* Bt, int n0, int k0, int nks, int lane) {
    const int fr = lane & 15, fq = lane >> 4;
    const bf16* ap = A + (size_t)fr * DM + k0 + 8 * fq; const bf16* bp = Bt + (size_t)(n0 + fr) * DM + k0 + 8 * fq;
    f32x4v acc = (f32x4v){0.f, 0.f, 0.f, 0.f};
#pragma unroll 8
    for (int ks = 0; ks < nks; ++ks) acc = MFMA16(*(const bf16x8*)(ap + 32 * ks), *(const bf16x8*)(bp + 32 * ks), acc);
    return acc;
}
__device__ __forceinline__ void meta_proj(Frame& F) {
    const int lane = F.lane, fr = lane & 15, fq = lane >> 4, w8 = F.wave; LAS float* ex = (LAS float*)F.lds;
    const bf16* A = F.XB + (size_t)MR * DM;
    for (int it = blockIdx.x; it < 256; it += F.G) {
        if (it < 32) {
            const bool isk = it >= 16; const int h = (it & 15) >> 1, s2 = it & 1, idx = 64 * s2 + 16 * (w8 & 3) + fr, dk = idx + (w8 >= 4 ? 128 : 0);
            const f32x4v acc = skinny_dot(A, F.W1t, (isk ? C_KR : C_QR) + 256 * h + dk - fr, 0, DM / 32, lane);
#pragma unroll
            for (int e = 0; e < 4; ++e) ex[(w8 * 4 + e) * 64 + lane] = acc[e] * F.RS1[MR + 4 * fq + e];
            __syncthreads();
            const float l2g = __log2f(1.0f - exp2f(-5.0f - (float)h)); float o[4];
#pragma unroll
            for (int e = 0; e < 4; ++e) { const int mrow = 4 * fq + e; const float mine = ex[(w8 * 4 + e) * 64 + lane], other = ex[((w8 ^ 4) * 4 + e) * 64 + lane];
                const float c = F.COS[(MR + mrow) * 128 + idx], sn = F.SIN[(MR + mrow) * 128 + idx];
                const float rot = w8 < 4 ? mine * c - other * sn : mine * c + other * sn;
                const float dec = exp2f((float)(48 + mrow + 1) * l2g); o[e] = isk ? rot * 0.0625f / dec : rot * dec; }
            if (isk) *(unsigned long long*)((unsigned char*)F.KFR + (((size_t)h * 33 * 8 + (dk >> 5)) * 4 + 3) * 1024 + ((dk & 31) + 32 * (fq & 1)) * 16 + 8 * (fq >> 1)) = (unsigned long long)pkbf(o[0], o[1]) | ((unsigned long long)pkbf(o[2], o[3]) << 32);
            else {
#pragma unroll
                for (int e = 0; e < 4; ++e) { const int mrow = 4 * fq + e;
                    *(bf16*)((unsigned char*)F.QFR + (((size_t)h * 33 * 8 + (dk >> 5)) * 4 + ((dk >> 4) & 1) * 2 + 1) * 1024 + (16 + mrow + 32 * ((dk >> 2) & 1)) * 16 + 2 * (4 * ((dk >> 3) & 1) + (dk & 3))) = f2b(o[e]); } }
            __syncthreads();
        } else if (it < 64) {
            const int n0 = 128 * (it - 32) + 16 * w8; const f32x4v acc = skinny_dot(A, F.W1t, C_QG + n0, 0, DM / 32, lane);
#pragma unroll
            for (int e = 0; e < 4; ++e) { const int row = MR + 4 * fq + e; F.PROJ[(size_t)row * LDP + n0 + fr] = f2b(acc[e] * F.RS1[row]); }
        } else if (it >= 192) {
            const int cvv = 128 * (it - 192) + 16 * w8 + fr; const f32x4v acc = skinny_dot(A, F.W1t, C_V + 128 * (it - 192) + 16 * w8, 0, DM / 32, lane);
            const int cv = cvv & 4095, slg = cv >> 6, wt = (cv >> 5) & 1, rp = cv & 31; unsigned char* VF = (unsigned char*)(cvv < 4096 ? F.VFR : F.VFG);
            const f32x4v sc = *(const f32x4v*)(F.RS1 + MR + 4 * fq);
            *(unsigned long long*)(VF + ((size_t)slg * 8 + wt * 4 + 3) * 1024 + (rp + 32 * (fq & 1)) * 16 + 8 * (fq >> 1)) = (unsigned long long)pkbf(acc[0] * sc[0], acc[1] * sc[1]) | ((unsigned long long)pkbf(acc[2] * sc[2], acc[3] * sc[3]) << 32);
        } else {
            const int t = (it - 64) >> 1, sp = (it - 64) & 1;
            const int n0 = C_GR + 256 * t + (w8 >= 4 ? 128 : 0) + 64 * sp + 16 * (w8 & 3);
            const f32x4v acc = skinny_dot(A, F.W1t, n0, 0, DM / 32, lane);
#pragma unroll
            for (int e = 0; e < 4; ++e) ex[(w8 * 4 + e) * 64 + lane] = acc[e] * F.RS1[MR + 4 * fq + e];
            __syncthreads();
            if (w8 < 4) { bf16* G = t < 32 ? F.GR : F.GG; const int ch = 128 * (t & 31) + 64 * sp + 16 * w8 + fr;
#pragma unroll
                for (int e = 0; e < 4; ++e) { const int row = MR + 4 * fq + e; G[(size_t)row * DM + ch] = f2b(pg8::gate2(ex[(w8 * 4 + e) * 64 + lane], ex[((w8 + 4) * 4 + e) * 64 + lane])); } }
            __syncthreads();
        }
    }
    __syncthreads();
}
__device__ __forceinline__ void z_proj(Frame& F) {
    const int lane = F.lane, fr = lane & 15, fq = lane >> 4;
    for (int g = blockIdx.x * NWAVES + F.wave; g < MROWS / 16; g += F.G * NWAVES) {
        const f32x4v acc = skinny_dot(F.XB + (size_t)(16 * g) * DM, F.W1t, C_Z, 0, DM / 32, lane);
#pragma unroll
        for (int e = 0; e < 4; ++e) { const int row = 16 * g + 4 * fq + e; F.ZB[(size_t)row * 16 + fr] = acc[e] * F.RS1[row]; }
    }
}
__device__ __forceinline__ void meta_wout(Frame& F) {
    const int lane = F.lane, fr = lane & 15, fq = lane >> 4, w8 = F.wave; LAS float* ex = (LAS float*)F.lds;
    for (int it = blockIdx.x; it < DM / 16; it += F.G) {
        const int n0 = 16 * it; const f32x4v acc = skinny_dot(F.MRG + (size_t)MR * DM, F.Wot, n0, 512 * w8, 16, lane);
#pragma unroll
        for (int e = 0; e < 4; ++e) ex[(w8 * 4 + e) * 64 + lane] = acc[e];
        __syncthreads();
        if (w8 == 0) {
#pragma unroll
            for (int e = 2; e < 4; ++e) { float v = 0.f;
#pragma unroll
                for (int w = 0; w < 8; ++w) v += ex[(w * 4 + e) * 64 + lane];
                const int mrow = 4 * fq + e;
                const float hv = F.meta[(size_t)(mrow & 15) * DM + n0 + fr] + v; float q = hv * hv;
                q += __shfl_xor(q, 1); q += __shfl_xor(q, 2); q += __shfl_xor(q, 4); q += __shfl_xor(q, 8);
                if (fq == 3) { F.H1[(size_t)(MR + mrow) * DM + n0 + fr] = hv; F.H1B[(size_t)(MR + mrow) * DM + n0 + fr] = f2b(hv); if (fr == 0) atomicAdd(F.SS2 + MR + mrow, q); } }
        }
        __syncthreads();
    }
}
__device__ __forceinline__ void meta_up(Frame& F) {
    const int lane = F.lane, fr = lane & 15, fq = lane >> 4;
    for (int g = blockIdx.x * NWAVES + F.wave; g < DFF / 16; g += F.G * NWAVES) {
        const int c0 = 16 * g; const f32x4v acc = skinny_dot(F.H1B + (size_t)MR * DM, F.Wft, 256 * (c0 >> 7) + (c0 & 127), 0, DM / 32, lane);
        if (fq == 3) {
#pragma unroll
            for (int e = 2; e < 4; ++e) { const float rs = 1.0f / sqrtf(F.SS2[MR + 12 + e] * (1.0f / 4096.0f) + EPS); F.UPM[(size_t)(e - 2) * DFF + c0 + fr] = acc[e] * rs; } }
    }
}

template <bool GLA> __device__ __forceinline__ void prep_qkp(Frame& F, int u) {
    constexpr int DK = GLA ? GLA_DK : RET_DK, NH = GLA ? GLA_H : RET_H, LDQ = DK + 8, DKW = DK / 8, NKS = DKW / 16, NDT = DKW / 32;
    const int n = u % 33, h = (u / 33) % NH, b = u / (33 * NH);
    LAS bf16* Qs = (LAS bf16*)F.lds; LAS bf16* Ks = Qs + 64 * LDQ; LAS float* zs = (LAS float*)(Ks + 64 * LDQ);
    const int tid = F.tid, lane = F.lane, w8 = F.wave, r = lane & 31, hh = lane >> 5;
    if (GLA) {
        for (int e = tid; e < 64 * 16; e += NTHR) { const int row = chunk_row(b, n, e >> 4); zs[e] = row >= 0 ? F.ZB[(size_t)row * 16 + (e & 15)] : 0.f; }
        __syncthreads();
        const int d = tid, ch = h * GLA_DK + d; float wg[GLA_RANK];
#pragma unroll
        for (int q = 0; q < GLA_RANK; ++q) wg[q] = F.w_gate_up[q * 2048 + ch];
        const float bg = F.b_gate[ch]; float bc = 0.f;
#pragma unroll 1
        for (int i0 = 0; i0 < 64; i0 += 16) {
            unsigned qr[16], kr[16];
#pragma unroll
            for (int ii = 0; ii < 16; ++ii) { const int row = chunk_row(b, n, i0 + ii); qr[ii] = 0u; kr[ii] = 0u;
                if (row >= 0) { const bf16* pr = F.PROJ + (size_t)row * LDP; qr[ii] = pr[P_QG + ch]; kr[ii] = pr[P_KG + ch]; } }
#pragma unroll
            for (int ii = 0; ii < 16; ++ii) { const int i = i0 + ii, row = chunk_row(b, n, i); float qv = 0.f, kv = 0.f;
                if (row >= 0) { float lg = bg;
#pragma unroll
                    for (int q = 0; q < GLA_RANK; ++q) lg += zs[i * 16 + q] * wg[q];
                    bc += logsig(lg) * (1.0f / 16.0f);
                    qv = bf2f((bf16)qr[ii]) * 0.04419417382415922f * __expf(bc); kv = bf2f((bf16)kr[ii]) * __expf(-bc); }
                Qs[i * LDQ + d] = f2b(qv); Ks[i * LDQ + d] = f2b(kv); }
        }
        F.DECG[((size_t)(b * GLA_H + h) * 33 + n) * GLA_DK + d] = __expf(bc);
    } else {
        const int p = tid & 127, tg = tid >> 7; const float l2g = log2f(1.0f - exp2f(-5.0f - (float)h));
#pragma unroll 1
        for (int i8 = 0; i8 < 16; i8 += 8) {
            unsigned q1r[8], q2r[8], k1r[8], k2r[8]; float cr[8], sr[8];
#pragma unroll
            for (int ii = 0; ii < 8; ++ii) { const int row = chunk_row(b, n, tg * 16 + i8 + ii); q1r[ii] = q2r[ii] = k1r[ii] = k2r[ii] = 0u; cr[ii] = 0.f; sr[ii] = 0.f;
                if (row >= 0) { const bf16* pr = F.PROJ + (size_t)row * LDP; cr[ii] = F.COS[row * 128 + p]; sr[ii] = F.SIN[row * 128 + p];
                    q1r[ii] = pr[C_QR + h * 256 + p]; q2r[ii] = pr[C_QR + h * 256 + 128 + p]; k1r[ii] = pr[C_KR + h * 256 + p]; k2r[ii] = pr[C_KR + h * 256 + 128 + p]; } }
#pragma unroll
            for (int ii = 0; ii < 8; ++ii) { const int i = tg * 16 + i8 + ii; const float c = cr[ii], sn = sr[ii];
                const float q1 = bf2f((bf16)q1r[ii]), q2 = bf2f((bf16)q2r[ii]), k1 = bf2f((bf16)k1r[ii]), k2 = bf2f((bf16)k2r[ii]);
                const float dq = exp2f((float)(i + 1) * l2g), dkk = 0.0625f / dq;
                Qs[i * LDQ + p] = f2b((q1 * c - q2 * sn) * dq); Qs[i * LDQ + p + 128] = f2b((q2 * c + q1 * sn) * dq);
                Ks[i * LDQ + p] = f2b((k1 * c - k2 * sn) * dkk); Ks[i * LDQ + p + 128] = f2b((k2 * c + k1 * sn) * dkk); }
        }
    }
    __syncthreads();
    const size_t cb = (size_t)(b * NH + h) * 33 + n;
    {
        char* qdst = (char*)(GLA ? F.QFG : F.QFR) + ((cb * 8 + w8) * (NKS * 2)) * 1024 + lane * 16;
#pragma unroll
        for (int ks = 0; ks < NKS; ++ks)
#pragma unroll
            for (int qt = 0; qt < 2; ++qt) { const LAS bf16* src = Qs + (32 * qt + r) * LDQ + DKW * w8 + 16 * ks + 4 * hh;
                const unsigned long long lo = *(const LAS unsigned long long*)src, hi = *(const LAS unsigned long long*)(src + 8);
                *(v4u*)(qdst + (ks * 2 + qt) * 1024) = (v4u){(unsigned)lo, (unsigned)(lo >> 32), (unsigned)hi, (unsigned)(hi >> 32)}; }
        char* kdst = (char*)(GLA ? F.KFG : F.KFR) + ((cb * 8 + w8) * (NDT * 4)) * 1024 + lane * 16;
#pragma unroll
        for (int dkt = 0; dkt < NDT; ++dkt)
#pragma unroll
            for (int ks = 0; ks < 4; ++ks) { unsigned w[4];
#pragma unroll
                for (int jj = 0; jj < 4; ++jj) { const int j0 = 2 * jj, t0 = 16 * ks + 8 * (j0 >> 2) + 4 * hh + (j0 & 3);
                    const unsigned e0 = Ks[t0 * LDQ + DKW * w8 + 32 * dkt + r], e1 = Ks[(t0 + 1) * LDQ + DKW * w8 + 32 * dkt + r]; w[jj] = e0 | (e1 << 16); }
                *(v4u*)(kdst + (dkt * 4 + ks) * 1024) = (v4u){w[0], w[1], w[2], w[3]}; }
    }
    if (w8 < 4) {
        const int kt = w8 >> 1, qt = w8 & 1; f32x16 acc;
#pragma unroll
        for (int i = 0; i < 16; ++i) acc[i] = 0.f;
        if (!(kt == 1 && qt == 0)) {
            const LAS bf16* ap = Ks + (32 * kt + r) * LDQ + 8 * hh; const LAS bf16* bp = Qs + (32 * qt + r) * LDQ + 8 * hh;
#pragma unroll 8
            for (int s = 0; s < DK / 16; ++s) acc = MFMA32(*(const LAS bf16x8*)(ap + 16 * s), *(const LAS bf16x8*)(bp + 16 * s), acc);
        }
        char* pdst = (char*)(GLA ? F.PFG : F.PFR) + (cb * 8) * 1024 + lane * 16;
#pragma unroll
        for (int s2 = 0; s2 < 2; ++s2) { unsigned w[4];
#pragma unroll
            for (int jj = 0; jj < 4; ++jj) { const int i0 = 8 * s2 + 2 * jj, i1 = i0 + 1;
                const int k0 = 32 * kt + (i0 & 3) + 8 * (i0 >> 2) + 4 * hh, k1 = 32 * kt + (i1 & 3) + 8 * (i1 >> 2) + 4 * hh, qc = 32 * qt + r;
                w[jj] = pkbf(k0 <= qc ? acc[i0] : 0.f, k1 <= qc ? acc[i1] : 0.f); }
            *(v4u*)(pdst + ((2 * kt + s2) * 2 + qt) * 1024) = (v4u){w[0], w[1], w[2], w[3]}; }
    }
    __syncthreads();
}
__device__ __forceinline__ void prep_p_ret(Frame& F, int u) {
    const int n = u % 33, h = (u / 33) % 8, b = u / (33 * 8);
    if (n == 0 && b != 0) return;
    constexpr int LDK = 264;
    LAS bf16* Ks = (LAS bf16*)F.lds;
    const int lane = F.lane, w8 = F.wave, r = lane & 31, hh = lane >> 5;
    const size_t cb = (size_t)(b * 8 + h) * 33 + n;
    { const unsigned char* kp = (const unsigned char*)F.KFR + (cb * 8 + w8) * 4096 + lane * 16;
#pragma unroll
      for (int ks = 0; ks < 4; ++ks) { const v4u w = *(const v4u*)(kp + ks * 1024);
#pragma unroll
          for (int j = 0; j < 8; ++j) { const int tok = 16 * ks + 8 * (j >> 2) + 4 * hh + (j & 3); Ks[tok * LDK + 32 * w8 + r] = (bf16)(w[j >> 1] >> (16 * (j & 1))); } } }
    __syncthreads();
    if (w8 < 3) {
        const int kt = w8 >> 1, qt = w8 == 0 ? 0 : 1; f32x16 acc;
#pragma unroll
        for (int i = 0; i < 16; ++i) acc[i] = 0.f;
        const unsigned char* qp = (const unsigned char*)F.QFR + (cb * 8) * 4096 + qt * 1024 + lane * 16;
        const LAS bf16* ap = Ks + (32 * kt + r) * LDK + 4 * hh;
#pragma unroll 4
        for (int s = 0; s < 16; ++s) {
            const unsigned long long lo = *(const LAS unsigned long long*)(ap + 16 * s), hi = *(const LAS unsigned long long*)(ap + 16 * s + 8);
            const v4u av = (v4u){(unsigned)lo, (unsigned)(lo >> 32), (unsigned)hi, (unsigned)(hi >> 32)};
            acc = MFMA32(__builtin_bit_cast(bf16x8, av), *(const bf16x8*)(qp + (s >> 1) * 4096 + (s & 1) * 2048), acc); }
        unsigned char* pdst = (unsigned char*)F.PFR + (cb * 8) * 1024 + lane * 16;
#pragma unroll
        for (int s2 = 0; s2 < 2; ++s2) { unsigned w[4];
#pragma unroll
            for (int jj = 0; jj < 4; ++jj) { const int i0 = 8 * s2 + 2 * jj, i1 = i0 + 1;
                const int k0 = 32 * kt + (i0 & 3) + 8 * (i0 >> 2) + 4 * hh, k1 = 32 * kt + (i1 & 3) + 8 * (i1 >> 2) + 4 * hh, qc = 32 * qt + r;
                w[jj] = pkbf(k0 <= qc ? acc[i0] : 0.f, k1 <= qc ? acc[i1] : 0.f); }
            *(v4u*)(pdst + ((2 * kt + s2) * 2 + qt) * 1024) = (v4u){w[0], w[1], w[2], w[3]}; }
    } else if (w8 == 3) {
        unsigned char* pdst = (unsigned char*)F.PFR + (cb * 8) * 1024 + lane * 16;
        *(v4u*)(pdst + (2 * 2 + 0) * 1024) = (v4u){0u, 0u, 0u, 0u}; *(v4u*)(pdst + (3 * 2 + 0) * 1024) = (v4u){0u, 0u, 0u, 0u};
    }
    __syncthreads();
}
#ifndef PREP_REP
#define PREP_REP 0
#endif
__device__ __forceinline__ void p2_prep(Frame& F) {
    constexpr int U_R = 4 * 8 * 33, U_G = 4 * 4 * 33;
    for (int u = blockIdx.x; u < U_G + U_R; u += F.G) {
        if (u < U_G) { prep_qkp<true>(F, u); if (PREP_REP & 1) prep_qkp<true>(F, u); }
        else { prep_p_ret(F, u - U_G); if (PREP_REP & 2) prep_p_ret(F, u - U_G); }
    }
}

__device__ __forceinline__ bf16x8 pack8(const f32x16& x, int s) { v4u w;
    if (s == 0) { w.x = pkbf(x[0], x[1]); w.y = pkbf(x[2], x[3]); w.z = pkbf(x[4], x[5]); w.w = pkbf(x[6], x[7]); }
    else { w.x = pkbf(x[8], x[9]); w.y = pkbf(x[10], x[11]); w.z = pkbf(x[12], x[13]); w.w = pkbf(x[14], x[15]); }
    return __builtin_bit_cast(bf16x8, w); }
#define LDS_BAR() do { asm volatile("s_waitcnt lgkmcnt(0)" ::: "memory"); __builtin_amdgcn_s_barrier(); asm volatile("" ::: "memory"); } while (0)
template <bool GLA, int ABL = 0> __device__ __forceinline__ void scan_unit(Frame& F, int u) {
    constexpr int DK = GLA ? GLA_DK : RET_DK, DV = GLA ? GLA_DV : RET_DV, NH = GLA ? GLA_H : RET_H, NSL = DV / 64, DKW = DK / 8, NKS = DKW / 16, NDT = DKW / 32;
    const int b = u / (NH * NSL), h = (u / NSL) % NH, sl = u % NSL, slg = h * NSL + sl;
    const int lane = F.lane, r = lane & 31, hh = lane >> 5, w8 = F.wave;
#define SMFMA(a, b, c) (ABL == 4 ? (c) : MFMA32((a), (b), (c)))
    LAS unsigned char* RED = F.lds;
    LAS unsigned char* VL = F.lds + 131072;
    f32x16 S[NDT][2];
#pragma unroll
    for (int a = 0; a < NDT; ++a)
#pragma unroll
        for (int c = 0; c < 2; ++c)
#pragma unroll
            for (int i = 0; i < 16; ++i) S[a][c][i] = 0.f;
    const int b0 = GLA ? b : 0;
    const char* QFb = (const char*)(GLA ? F.QFG : F.QFR) + (((size_t)(b * NH + h) * 33 * 8 + w8) * (NKS * 2)) * 1024 + lane * 16;
    const char* QF0 = (const char*)(GLA ? F.QFG : F.QFR) + (((size_t)(b0 * NH + h) * 33 * 8 + w8) * (NKS * 2)) * 1024 + lane * 16;
    const char* KF0 = (const char*)(GLA ? F.KFG : F.KFR) + (((size_t)(b0 * NH + h) * 33 * 8 + w8) * (NDT * 4)) * 1024 + lane * 16;
    const char* PF0 = (const char*)(GLA ? F.PFG : F.PFR) + ((size_t)(b0 * NH + h) * 33 * 8 + w8) * 1024 + lane * 16;
    const char* KFb = (const char*)(GLA ? F.KFG : F.KFR) + (((size_t)(b * NH + h) * 33 * 8 + w8) * (NDT * 4)) * 1024 + lane * 16;
    const char* VF0 = (const char*)(GLA ? F.VFG : F.VFR) + ((size_t)slg * 8 + w8) * 1024 + lane * 16;
    const char* VFb = VF0 + (size_t)b * 33 * 64 * 8 * 1024;
    const char* PFb = (const char*)(GLA ? F.PFG : F.PFR) + ((size_t)(b * NH + h) * 33 * 8 + w8) * 1024 + lane * 16;
    bf16* Y = GLA ? F.YG : F.YR;
    const float gam64 = exp2f(64.0f * log2f(1.0f - exp2f(-5.0f - (float)h)));
    bf16x8 qf[NKS * 2];
#pragma unroll
    for (int f = 0; f < NKS * 2; ++f) qf[f] = *(const bf16x8*)(QF0 + f * 1024);
    bf16x8 bp = *(const bf16x8*)PF0;
    *(LAS bf16x8*)(VL + w8 * 1024 + lane * 16) = *(const bf16x8*)VF0;
    __syncthreads();
#pragma unroll 1
    for (int n = 0; n < 33; ++n) {
        const size_t cb = (size_t)(b * NH + h) * 33 + n;
        const char* kp = n ? KFb + (size_t)n * (8 * NDT * 4 * 1024) : KF0;
        const LAS unsigned char* vl = VL + (n & 1) * 8192 + lane * 16;
        const int nn = n < 32 ? n + 1 : n;
        bf16x8 kf[NDT * 4];
#pragma unroll
        for (int f = 0; f < NDT * 4; ++f) kf[f] = *(const bf16x8*)((ABL == 2 ? KF0 : kp) + f * 1024);
        const bf16x8 vnext = *(const bf16x8*)(ABL == 2 ? VF0 : VFb + (size_t)nn * (64 * 8 * 1024));
        { const int ks2 = w8 >> 1, qt2 = w8 & 1;
#pragma unroll
          for (int wt = 0; wt < 2; ++wt) { f32x16 o0, o1;
#pragma unroll
            for (int i = 0; i < 16; ++i) { o0[i] = 0.f; o1[i] = 0.f; }
#pragma unroll
            for (int ks = 0; ks < NKS; ++ks) { const bf16x8 a = pack8(S[ks >> 1][wt], ks & 1); o0 = SMFMA(a, qf[ks * 2], o0); o1 = SMFMA(a, qf[ks * 2 + 1], o1); }
            const bf16x8 av = *(const LAS bf16x8*)(vl + (wt * 4 + ks2) * 1024);
            if (qt2 == 0) o0 = SMFMA(av, bp, o0); else o1 = SMFMA(av, bp, o1);
            if (ABL != 3 && wt == 0) LDS_BAR();
            if (ABL != 3) { LAS unsigned char* d0 = RED + ((w8 * 4 + wt * 2) * 64 + lane) * 48; LAS unsigned char* d1 = d0 + 64 * 48;
              *(LAS v4u*)d0 = (v4u){pkbf(o0[0], o0[1]), pkbf(o0[2], o0[3]), pkbf(o0[4], o0[5]), pkbf(o0[6], o0[7])}; *(LAS v4u*)(d0 + 16) = (v4u){pkbf(o0[8], o0[9]), pkbf(o0[10], o0[11]), pkbf(o0[12], o0[13]), pkbf(o0[14], o0[15])};
              *(LAS v4u*)d1 = (v4u){pkbf(o1[0], o1[1]), pkbf(o1[2], o1[3]), pkbf(o1[4], o1[5]), pkbf(o1[6], o1[7])}; *(LAS v4u*)(d1 + 16) = (v4u){pkbf(o1[8], o1[9]), pkbf(o1[10], o1[11]), pkbf(o1[12], o1[13]), pkbf(o1[14], o1[15])}; } } }
        if (ABL != 2) { const char* qn = QFb + (size_t)nn * (8 * NKS * 2 * 1024);
#pragma unroll
          for (int f = 0; f < NKS * 2; ++f) qf[f] = *(const bf16x8*)(qn + f * 1024);
          bp = *(const bf16x8*)(PFb + (size_t)nn * 8192); }
#pragma unroll
        for (int ks = 0; ks < 4; ++ks) { bf16x8 bv[2];
#pragma unroll
            for (int wt = 0; wt < 2; ++wt) bv[wt] = *(const LAS bf16x8*)(vl + (wt * 4 + ks) * 1024);
#pragma unroll
            for (int dkt = 0; dkt < NDT; ++dkt)
#pragma unroll
                for (int wt = 0; wt < 2; ++wt) S[dkt][wt] = SMFMA(kf[dkt * 4 + ks], bv[wt], S[dkt][wt]); }
        if (GLA) {
#pragma unroll
            for (int dkt = 0; dkt < NDT; ++dkt) { const float* dp = F.DECG + cb * GLA_DK + DKW * w8 + 32 * dkt + 4 * hh;
#pragma unroll
                for (int g4 = 0; g4 < 4; ++g4) { const f32x4 dv = *(const f32x4*)(dp + 8 * g4);
#pragma unroll
                    for (int e = 0; e < 4; ++e) { S[dkt][0][4 * g4 + e] *= dv[e]; S[dkt][1][4 * g4 + e] *= dv[e]; } } }
        } else {
#pragma unroll
            for (int wt = 0; wt < 2; ++wt)
#pragma unroll
                for (int i = 0; i < 16; ++i) S[0][wt][i] *= gam64;
        }
        *(LAS bf16x8*)(VL + ((n + 1) & 1) * 8192 + w8 * 1024 + lane * 16) = vnext;
        LDS_BAR();
        if (ABL != 3) {
            const int t = w8 >> 1, wt = t >> 1, qt = t & 1; float val[8];
#pragma unroll
            for (int ii = 0; ii < 8; ++ii) val[ii] = 0.f;
#pragma unroll
            for (int src = 0; src < 8; ++src) { const v4u w = *(const LAS v4u*)(RED + ((src * 4 + t) * 64 + lane) * 48 + 16 * (w8 & 1));
#pragma unroll
                for (int q = 0; q < 4; ++q) { val[2 * q] += __builtin_bit_cast(float, w[q] << 16); val[2 * q + 1] += __builtin_bit_cast(float, w[q] & 0xffff0000u); } }
            const int row = chunk_row(b, n, 32 * qt + r);
            if (ABL == 0 && row >= 0 && (n > 0 || b == 0)) {
#pragma unroll
                for (int g = 0; g < 2; ++g) { const int w0 = 32 * wt + 8 * (2 * (w8 & 1) + g) + 4 * hh;
                    *(unsigned long long*)(Y + (size_t)row * DM + h * DV + 64 * sl + w0) = (unsigned long long)pkbf(val[4 * g], val[4 * g + 1]) | ((unsigned long long)pkbf(val[4 * g + 2], val[4 * g + 3]) << 32); } }
        }
    }
    __syncthreads();
}
#undef SMFMA
#ifndef SCAN_ABL
#define SCAN_ABL 0
#endif
__device__ __forceinline__ void p3_scan(Frame& F) {
    for (int i = blockIdx.x; i < 512; i += F.G) {
        const int w = i & 255, x = w & 7, idx = w >> 3;
        if (i < 256) { scan_unit<true>(F, (2 * x + (idx >> 4)) * 16 + (idx & 15)); if (SCAN_ABL) scan_unit<true, SCAN_ABL>(F, (2 * x + (idx >> 4)) * 16 + (idx & 15)); }
        else { scan_unit<false>(F, (4 * x + (idx >> 3)) * 8 + (idx & 7)); if (SCAN_ABL) scan_unit<false, SCAN_ABL>(F, (4 * x + (idx >> 3)) * 8 + (idx & 7)); }
    }
}

__device__ __forceinline__ void ld8bf(const bf16* p, float (&o)[8]) { const v4u w = *(const v4u*)p;
#pragma unroll
    for (int q = 0; q < 4; ++q) { o[2 * q] = __builtin_bit_cast(float, w[q] << 16); o[2 * q + 1] = __builtin_bit_cast(float, w[q] & 0xffff0000u); } }
__device__ __forceinline__ void p4_merge(Frame& F) {
    const int gw = blockIdx.x * NWAVES + F.wave, NGW = F.G * NWAVES, lane = F.lane;
    for (int m = gw; m < MROWS; m += NGW) {
#pragma unroll 1
        for (int hg = 0; hg < 4; ++hg) {
            float yr[2][8], yg[2][8];
#pragma unroll
            for (int j = 0; j < 2; ++j) { const int c = hg * 1024 + j * 512 + lane * 8; ld8bf(F.YR + (size_t)m * DM + c, yr[j]); ld8bf(F.YG + (size_t)m * DM + c, yg[j]); }
            float sg = 0.f, sa = 0.f, sb = 0.f;
#pragma unroll
            for (int e = 0; e < 8; ++e) { sg += yg[0][e] * yg[0][e] + yg[1][e] * yg[1][e]; sa += yr[0][e]; sb += yr[1][e]; }
            sg = wave_sum(sg); sa = wave_sum(sa); sb = wave_sum(sb);
            const float rg = 1.0f / sqrtf(sg * (1.0f / 1024.0f) + EPS), ma = sa * (1.0f / 512.0f), mb = sb * (1.0f / 512.0f);
            float qa = 0.f, qb = 0.f;
#pragma unroll
            for (int e = 0; e < 8; ++e) { yr[0][e] -= ma; yr[1][e] -= mb; qa += yr[0][e] * yr[0][e]; qb += yr[1][e] * yr[1][e]; }
            qa = wave_sum(qa); qb = wave_sum(qb);
            const float ra = 1.0f / sqrtf(qa * (1.0f / 512.0f) + EPS), rb = 1.0f / sqrtf(qb * (1.0f / 512.0f) + EPS);
#pragma unroll
            for (int j = 0; j < 2; ++j) { const int c = hg * 1024 + j * 512 + lane * 8; const float rr = j ? rb : ra; float tr[8], tg[8], res[8];
                ld8bf(F.GR + (size_t)m * DM + c, tr); ld8bf(F.GG + (size_t)m * DM + c, tg);
                const f32x4 gr0 = *(const f32x4*)(F.ret_norm + c), gr1 = *(const f32x4*)(F.ret_norm + c + 4), gg0 = *(const f32x4*)(F.gla_norm + c), gg1 = *(const f32x4*)(F.gla_norm + c + 4);
#pragma unroll
                for (int e = 0; e < 8; ++e) res[e] = tr[e] * (yr[j][e] * rr * (e < 4 ? gr0[e & 3] : gr1[e & 3])) + tg[e] * (yg[j][e] * rg * (e < 4 ? gg0[e & 3] : gg1[e & 3]));
                *(v4u*)(F.MRG + (size_t)m * DM + c) = (v4u){pk2(res[0], res[1]), pk2(res[2], res[3]), pk2(res[4], res[5]), pk2(res[6], res[7])}; }
        }
    }
}

__device__ __forceinline__ void p8_act(Frame& F) {
    for (int i = blockIdx.x * NTHR + F.tid; i < 32 * DFF; i += F.G * NTHR) {
        const int pm = i / DFF, c = i % DFF;
        const float* prev = (pm & 7) ? F.UPH + (size_t)(pm - 1) * 2 * DFF : F.UPM;
        const float p0 = prev[c], p1 = prev[DFF + c], w0 = F.conv_w[c], w1 = F.conv_w[DFF + c];
        const float c0 = F.PARTC[(size_t)pm * 2 * DFF + c] + w1 * p1 + w0 * p0, c1 = F.PARTC[(size_t)pm * 2 * DFF + DFF + c] + w0 * p1;
        F.ACT[(size_t)(256 * pm) * DFF + c] = f2b(silu(c0) * F.PARTG[(size_t)pm * 2 * DFF + c]);
        F.ACT[(size_t)(256 * pm + 1) * DFF + c] = f2b(silu(c1) * F.PARTG[(size_t)pm * 2 * DFF + DFF + c]);
    }
}

__device__ __forceinline__ void p10_final(Frame& F) {
    const int gw = blockIdx.x * NWAVES + F.wave, NGW = F.G * NWAVES;
    for (int m = gw; m < MR; m += NGW) {
        GAS f32x4* xr = (GAS f32x4*)(F.out + (size_t)m * DM) + F.lane; f32x4 v[16]; float ss = 0.f;
#pragma unroll
        for (int j = 0; j < 16; ++j) { v[j] = xr[64 * j]; ss += (v[j].x * v[j].x + v[j].y * v[j].y) + (v[j].z * v[j].z + v[j].w * v[j].w); }
        ss = wave_sum(ss); const float r = 1.0f / sqrtf(ss * (1.0f / DM) + EPS);
#pragma unroll
        for (int j = 0; j < 16; ++j) { const f32x4 g = *((const GAS f32x4*)F.final_norm + F.lane + 64 * j); xr[64 * j] = v[j] * r * g; }
    }
}

#ifndef REP_MASK
#define REP_MASK 0u
#endif
#define REPS(k) (((REP_MASK >> (k)) & 1u) ? 2 : 1)
struct Args { const void* in[16]; float* out; unsigned char* ws; int ph_lo, ph_hi, li, pad; };
__global__ void __launch_bounds__(NTHR, 2) fwd(Args args) {
    extern __shared__ __attribute__((aligned(16))) unsigned char lds[];
    Frame F;
    F.lds = (LAS unsigned char*)lds;
    F.MISC = (volatile LAS unsigned*)(F.lds + MISC_OFF);
    F.tid = threadIdx.x; F.lane = F.tid & 63; F.wave = __builtin_amdgcn_readfirstlane(F.tid >> 6); F.G = gridDim.x;
    unsigned char* ws = args.ws;
    F.ctl = (gu32*)(ws + WS_CTL);
    F.x = (const float*)args.in[0]; F.positions = (const int*)args.in[1]; F.meta = (const float*)args.in[2]; F.attn_norm = (const float*)args.in[3]; F.w_in = (const float*)args.in[4];
    F.w_gate_up = (const float*)args.in[5]; F.b_gate = (const float*)args.in[6]; F.ret_norm = (const float*)args.in[7]; F.gla_norm = (const float*)args.in[8]; F.w_out = (const float*)args.in[9];
    F.ffn_norm = (const float*)args.in[10]; F.w_ffn_in = (const float*)args.in[11]; F.conv_w = (const float*)args.in[12]; F.conv_b = (const float*)args.in[13]; F.w_ffn_out = (const float*)args.in[14];
    F.final_norm = (const float*)args.in[15]; F.out = args.out;
    F.W1t = (bf16*)(ws + WS_W1T); F.Wot = (bf16*)(ws + WS_WOT); F.Wft = (bf16*)(ws + WS_WFT); F.W2t = (bf16*)(ws + WS_W2T); F.XB = (bf16*)(ws + WS_XB);
    F.PROJ = (bf16*)(ws + WS_PROJ); F.UG = (bf16*)(ws + WS_UG); F.ACT = (bf16*)(ws + WS_ACT); F.MRG = (bf16*)(ws + WS_MRG); F.H1B = (bf16*)(ws + WS_H1B);
    F.RS1 = (float*)(ws + WS_RS1); F.SS2 = (float*)(F.ctl + CW_SS2); F.ZB = (float*)(ws + WS_ZB); F.COS = (float*)(ws + WS_COS); F.SIN = (float*)(ws + WS_SIN); F.COST = (float*)(ws + WS_COST); F.SINT = (float*)(ws + WS_SINT);
    F.YR = (bf16*)(ws + WS_YR); F.YG = (bf16*)(ws + WS_YG); F.GR = (bf16*)(ws + WS_GR); F.GG = (bf16*)(ws + WS_GG); F.H1 = (float*)(ws + WS_H1); F.DECG = (float*)(ws + WS_DECG); F.UPH = (float*)(ws + WS_UPH); F.PARTC = (float*)(ws + WS_PARTC); F.PARTG = (float*)(ws + WS_PARTG); F.UPM = (float*)(ws + WS_UPM);
    F.QFG = (bf16*)(ws + WS_QFG); F.KFG = (bf16*)(ws + WS_KFG); F.QFR = (bf16*)(ws + WS_QFR); F.KFR = (bf16*)(ws + WS_KFR);
    F.VFG = (bf16*)(ws + WS_VFG); F.VFR = (bf16*)(ws + WS_VFR); F.PFG = (bf16*)(ws + WS_PFG); F.PFR = (bf16*)(ws + WS_PFR);
    for (int u = F.tid; u < (LDS_BYTES - LDSCTL_OFF) / 4; u += NTHR) ((LAS unsigned*)(F.lds + LDSCTL_OFF))[u] = 0u;
    __syncthreads();
    XcdBarrier bar; bar.bar = (unsigned*)(F.ctl + CW_BAR); bar.x = 0; bar.st = nullptr;
    if (N_LAUNCHES != NPH) bar = xcd_barrier_post((unsigned*)(F.ctl + CW_BAR) + args.li * XCD_BAR_WORDS, F.MISC + 8);
#define GRID_BAR(seam) do { if (N_LAUNCHES == NPH) { if (F.tid == 0) __hip_atomic_store(F.ctl + CW_TMO, 0xBADBA0u | (unsigned)(seam), RLX_AGENT); } else { xcd_barrier(bar); } } while (0)
    const int lo = args.ph_lo, hi = args.ph_hi;
#define IN(k) (lo <= (k) && (k) < hi)
#define BOTH(k) (IN(k) && IN((k) + 1))
#ifndef SKINNY_REP
#define SKINNY_REP 0
#endif
#ifndef G1_REP
#define G1_REP 0
#endif
#define PH1A() do { pg8::Gemm g{F.XB, F.W1t, MR, C_B, DM}; pg8::StaticOrder S; S.init(MR, C_B, F.G, (int)blockIdx.x); pg8::EpiA E{F.PROJ, F.RS1, F.COS, F.SIN, (unsigned char*)F.QFR, F.GR, F.GG}; \
          pg8::gemm_phase<pg8::EpiA, pg8::StaticOrder, PG8_ALIGN, PG8_SP2>(F.lds + RING_OFF, g, S, E); } while (0)
#define PH1B() do { pg8::Gemm g{F.XB, F.W1t + (size_t)C_B * DM, MR, 32768 - C_B, DM}; pg8::StaticOrder S; S.init(MR, 32768 - C_B, F.G, (int)blockIdx.x); pg8::EpiB E{(unsigned char*)F.VFR, (unsigned char*)F.VFG, (unsigned char*)F.KFR, F.RS1, F.COST, F.SINT}; \
          pg8::gemm_phase<pg8::EpiB, pg8::StaticOrder, PG8_ALIGN, PG8_SP2, false>(F.lds + RING_OFF, g, S, E); } while (0)
#define PH1() do { z_proj(F); if (SKINNY_REP & 1) z_proj(F); meta_proj(F); if (SKINNY_REP & 2) meta_proj(F); PH1A(); if (G1_REP & 1) PH1A(); PH1B(); if (G1_REP & 2) PH1B(); } while (0)
#define PH5() do { meta_wout(F); pg8::Gemm g{F.MRG, F.Wot, MR, DM, DM}; pg8::StaticOrder S; S.init(MR, DM, F.G, (int)blockIdx.x); pg8::EpiResX E{F.x, F.meta, F.H1, F.H1B, F.SS2, DM, MR, NMETA}; \
        pg8::gemm_phase<pg8::EpiResX, pg8::StaticOrder, PG8_ALIGN, PG8_SP2>(F.lds + RING_OFF, g, S, E); } while (0)
#define PH7() do { meta_up(F); pg8::Gemm g{F.H1B, F.Wft, MR, NF, DM}; pg8::StaticOrder S; S.init(MR, NF, F.G, (int)blockIdx.x); pg8::EpiFfn E{F.ACT, F.SS2, F.conv_w, F.conv_b, F.UPH, F.PARTC, F.PARTG, (LAS float*)(F.lds + 131072)}; \
        pg8::gemm_phase<pg8::EpiFfn, pg8::StaticOrder, true, PG8_SP2>(F.lds + RING_OFF, g, S, E); } while (0)
#define PH9() do { pg8::Gemm g{F.ACT, F.W2t, MR, DM, DFF}; pg8::StaticOrder S; S.init(MR, DM, F.G, (int)blockIdx.x); pg8::EpiResF32 E{F.H1, F.out, DM}; \
        pg8::gemm_phase<pg8::EpiResF32, pg8::StaticOrder, PG8_ALIGN, PG8_SP2>(F.lds + RING_OFF, g, S, E); } while (0)
#define REIDX() do { int tz = threadIdx.x; asm volatile("" : "+v"(tz)); F.tid = tz; F.lane = tz & 63; F.wave = __builtin_amdgcn_readfirstlane(tz >> 6); } while (0)
#define RUN(k, body) do { if (IN(k)) { REIDX(); body; if (REPS(k) == 2) { __syncthreads(); body; } if (BOTH(k)) GRID_BAR(k); } } while (0)
    RUN(0, p0_prologue(F));
    RUN(1, PH1());
    RUN(2, p2_prep(F));
    RUN(3, p3_scan(F));
    RUN(4, p4_merge(F));
    RUN(5, PH5());
    RUN(7, PH7());
    RUN(8, p8_act(F));
    RUN(9, PH9());
    if (IN(10)) { REIDX(); p10_final(F); }
#undef IN
#undef BOTH
}

extern "C" void kernel_launch(void* const* d_in, const int* in_sizes, int n_in, void* d_out, int out_size, void* d_ws, size_t ws_size, hipStream_t stream) {
    static int grid = 0;
    if (grid == 0) {
        if (n_in != 16 || in_sizes[0] != MR * DM || out_size != MR * DM || ws_size < WS_END) {
            fprintf(stderr, "kernel_launch: shape/workspace mismatch: n_in %d in0 %d out %d ws %zu (need %zu); nothing launched\n", n_in, n_in > 0 ? in_sizes[0] : -1, out_size, ws_size, (size_t)WS_END); grid = -1; return; }
        int dev = 0, cus = 0, per_cu = 0;
        if (hipGetDevice(&dev) != hipSuccess || hipDeviceGetAttribute(&cus, hipDeviceAttributeMultiprocessorCount, dev) != hipSuccess) { fprintf(stderr, "kernel_launch: device query failed\n"); grid = -1; return; }
        if (hipFuncSetAttribute((const void*)fwd, hipFuncAttributeMaxDynamicSharedMemorySize, LDS_BYTES) != hipSuccess) { fprintf(stderr, "kernel_launch: hipFuncSetAttribute failed\n"); grid = -1; return; }
        if (hipOccupancyMaxActiveBlocksPerMultiprocessor(&per_cu, (const void*)fwd, NTHR, LDS_BYTES) != hipSuccess || per_cu < 1)
            fprintf(stderr, "kernel_launch: note: occupancy query reports %d workgroups per CU\n", per_cu);
        (void)hipGetLastError();
        grid = cus;
    }
    if (grid < 0) return;
    if (hipMemsetAsync((char*)d_ws + WS_CTL, 0, CTL_ZERO_BYTES, stream) != hipSuccess) { fprintf(stderr, "kernel_launch: memset failed\n"); return; }
    Args a{};
    for (int i = 0; i < 16; ++i) a.in[i] = d_in[i];
    a.out = (float*)d_out; a.ws = (unsigned char*)d_ws;
    for (int li = 0; li < N_LAUNCHES; ++li) {
        a.ph_lo = (N_LAUNCHES == NPH) ? li : 0; a.ph_hi = (N_LAUNCHES == NPH) ? li + 1 : NPH; a.li = (N_LAUNCHES == NPH) ? 0 : li;
        hipLaunchKernelGGL(fwd, dim3(grid), dim3(NTHR), LDS_BYTES, stream, a);
        const hipError_t le = hipPeekAtLastError();
        if (le != hipSuccess) { fprintf(stderr, "kernel_launch: launch %d failed: %s\n", li, hipGetErrorName(le)); break; }
    }
}
```

```cpp
#include <hip/hip_runtime.h>
#include <cstdio>
#include <cstdint>
namespace pg8 {
#define PG8_LAS __attribute__((address_space(3)))
typedef unsigned short bf16_t;
typedef short bf16x8 __attribute__((ext_vector_type(8)));
typedef float f32x4 __attribute__((ext_vector_type(4)));
typedef unsigned u32x4 __attribute__((ext_vector_type(4)));
constexpr int BM = 256, BK = 64, HALF = 128, HTB = HALF * BK * 2  , STAGE_BYTES = 8 * HTB, NXCD = 8, WGM = 4;

__host__ __device__ __forceinline__ int lds_byte(int r, int c) { const int st = (r >> 4) * 2 + (c >> 5), rr = r & 15, cc = c & 31, ob = rr * 64 + cc * 2; return st * 1024 + (ob ^ (((ob >> 9) & 1) << 5)); }
__host__ __device__ __forceinline__ void stage_rc(int b, int& R, int& C) { const int st = b / 1024, sb = b % 1024, swz = sb ^ (((sb >> 9) & 1) << 5); R = (st >> 1) * 16 + swz / 64; C = (st & 1) * 32 + (swz % 64) / 2; }
__host__ __device__ __forceinline__ int perm32(int rho) { const int n = rho >> 4, i = rho & 15; return 8 * (i >> 2) + 4 * n + (i & 3); }

struct Unit { int pm, pn; };
struct Gemm { const bf16_t* A; const bf16_t* Bt; int M, N, K; };

struct StaticOrder {
    int nM, nN, nwg, G, c;
    __host__ __device__ void init(int M, int N, int G_, int c_) { nM = M / BM; nN = N / BM; nwg = nM * nN; G = G_; c = c_; }
    __host__ __device__ bool next(int i, Unit& u) const {
        const long L = (long)i * G + c; if (L >= nwg) return false;
        int wgid = (int)L; { const int q = nwg / NXCD, r = nwg % NXCD, xcd = wgid % NXCD, off = wgid / NXCD; wgid = (xcd < r ? xcd * (q + 1) : r * (q + 1) + (xcd - r) * q) + off; }
        const int nig = WGM * nN, gid = wgid / nig, fm = gid * WGM, gsz = (nM - fm) < WGM ? (nM - fm) : WGM;
        u.pm = fm + ((wgid % nig) % gsz); u.pn = (wgid % nig) / gsz; return true;
    }
    __device__ __forceinline__ void a_ready(const Unit&) const {}
    __device__ __forceinline__ void done(const Unit&) const {}
};
__device__ __forceinline__ unsigned cvt_pk_bf16(float lo, float hi) { unsigned r; asm volatile("v_cvt_pk_bf16_f32 %0, %1, %2" : "=v"(r) : "v"(lo), "v"(hi)); return r; }
template <class Epi, class Sched, bool ALIGN_EPI = false, bool SP2 = false, bool TR = true  >
__device__ __forceinline__ void gemm_phase(PG8_LAS unsigned char* lds, const Gemm g, const Sched& S, const Epi& E) {
    const int tid = threadIdx.x, wid = __builtin_amdgcn_readfirstlane(tid >> 6), lane = tid & 63, wr = wid >> 2, wc = wid & 3, fr = lane & 15, fq = lane >> 4;
    const int K = g.K, nt = K / BK;
    unsigned voffA[2], voffB[2];
#pragma unroll
    for (int i = 0; i < 2; ++i) { int R, C; stage_rc(tid * 16 + i * 8192, R, C); const int Rb = Epi::PERM ? ((R & ~31) + perm32(R & 31)) : R;
        voffA[i] = (unsigned)(R * K + C) * 2u; voffB[i] = (unsigned)(Rb * K + C) * 2u; }
    const size_t kstep = (size_t)(BK * 2);
    const size_t hstep = (size_t)HALF * K * 2;
    const size_t tstep = 2 * hstep;
    const unsigned ldsw = (unsigned)wid * 1024u;
    const int aoff = lds_byte(wr * 64 + fr, fq * 8), boff = lds_byte(wc * 32 + fr, fq * 8);
#define PG8_SA(b, h) (((b) * 2 + (h)) * HTB)
#define PG8_SB(b, h) ((4 + (b) * 2 + (h)) * HTB)
#define PG8_STAGE(bufoff, gbase, voff) do { _Pragma("unroll") for (int _i = 0; _i < 2; ++_i) \
        __builtin_amdgcn_global_load_lds((const unsigned*)((const char*)(gbase) + (voff)[_i]), (PG8_LAS unsigned*)(lds + (bufoff) + ldsw + _i * 8192), 16, 0, 0); } while (0)
#define PG8_LDA(dst, b, h) do { _Pragma("unroll") for (int m = 0; m < 4; ++m) _Pragma("unroll") for (int k = 0; k < 2; ++k) dst[m][k] = *(const PG8_LAS bf16x8*)(lds + PG8_SA(b, h) + aoff + m * 2048 + k * 1024); } while (0)
#define PG8_LDB(dst, b, h) do { _Pragma("unroll") for (int n = 0; n < 2; ++n) _Pragma("unroll") for (int k = 0; k < 2; ++k) dst[n][k] = *(const PG8_LAS bf16x8*)(lds + PG8_SB(b, h) + boff + n * 2048 + k * 1024); } while (0)
#define PG8_MMA(ai, bj, At, Bt) do { __builtin_amdgcn_s_setprio(1); _Pragma("unroll") for (int m = 0; m < 4; ++m) _Pragma("unroll") for (int n = 0; n < 2; ++n) _Pragma("unroll") for (int k = 0; k < 2; ++k) \
        acc[ai][bj][m][n] = TR ? __builtin_amdgcn_mfma_f32_16x16x32_bf16(Bt[n][k], At[m][k], acc[ai][bj][m][n], 0, 0, 0) : __builtin_amdgcn_mfma_f32_16x16x32_bf16(At[m][k], Bt[n][k], acc[ai][bj][m][n], 0, 0, 0); __builtin_amdgcn_s_setprio(0); } while (0)
#define PG8_WAIT_V(n) asm volatile("s_waitcnt vmcnt(" #n ")" ::: "memory")
#define PG8_WAIT_L(n) asm volatile("s_waitcnt lgkmcnt(" #n ")" ::: "memory")
#define PG8_BAR __builtin_amdgcn_s_barrier()
#define PG8_SCHED __builtin_amdgcn_sched_barrier(0)
    Unit cur, nxt; int ui = 0;
    if (!S.next(0, cur)) return;
    f32x4 acc[2][2][4][2];
#pragma unroll
    for (int a = 0; a < 2; ++a)
#pragma unroll
        for (int b = 0; b < 2; ++b)
#pragma unroll
            for (int m = 0; m < 4; ++m)
#pragma unroll
                for (int n = 0; n < 2; ++n) acc[a][b][m][n] = (f32x4){0.f, 0.f, 0.f, 0.f};
    bf16x8 At[4][2], B0[2][2], B1[2][2];
    const char* cA = (const char*)g.A + (size_t)cur.pm * tstep; const char* cB = (const char*)g.Bt + (size_t)cur.pn * tstep;
    S.a_ready(cur);
    if constexpr (SP2) {
        PG8_STAGE(PG8_SB(0, 0), cB, voffB); PG8_STAGE(PG8_SB(0, 1), cB + hstep, voffB); PG8_STAGE(PG8_SA(0, 0), cA, voffA); PG8_STAGE(PG8_SA(0, 1), cA + hstep, voffA);
        if (wr == 1) PG8_BAR;
        PG8_WAIT_V(2); PG8_BAR;
        PG8_STAGE(PG8_SB(1, 0), cB + kstep, voffB); PG8_STAGE(PG8_SA(1, 0), cA + kstep, voffA); PG8_STAGE(PG8_SB(1, 1), cB + hstep + kstep, voffB);
        PG8_WAIT_V(6); PG8_BAR;
    } else {
        PG8_STAGE(PG8_SB(0, 0), cB, voffB); PG8_STAGE(PG8_SA(0, 0), cA, voffA); PG8_STAGE(PG8_SB(0, 1), cB + hstep, voffB); PG8_STAGE(PG8_SA(0, 1), cA + hstep, voffA);
        if (wr == 1) PG8_BAR;
        PG8_WAIT_V(4); PG8_BAR;
        PG8_STAGE(PG8_SB(1, 0), cB + kstep, voffB); PG8_STAGE(PG8_SA(1, 0), cA + kstep, voffA); PG8_STAGE(PG8_SB(1, 1), cB + hstep + kstep, voffB);
        PG8_WAIT_V(6); PG8_BAR;
    }
    for (;;) {
        const bool has_next = S.next(ui + 1, nxt);
        const char* nA = has_next ? (const char*)g.A + (size_t)nxt.pm * tstep : cA; const char* nB = has_next ? (const char*)g.Bt + (size_t)nxt.pn * tstep : cB;
        for (int t = 0; t < nt; t += 2) {
            const bool last = (t == nt - 2);
            const char* a1 = cA + (size_t)(t + 1) * kstep;
            const char* a2 = last ? nA : cA + (size_t)(t + 2) * kstep; const char* b2 = last ? nB : cB + (size_t)(t + 2) * kstep;
            const char* a3 = a2 + kstep; const char* b3 = b2 + kstep;
            if (last && has_next) S.a_ready(nxt);
            if constexpr (SP2) {
            PG8_LDB(B0, 0, 0); PG8_LDB(B1, 0, 1); PG8_SCHED; PG8_LDA(At, 0, 0); PG8_STAGE(PG8_SA(1, 1), a1 + hstep, voffA);
            PG8_WAIT_V(8); PG8_WAIT_L(0); PG8_BAR; PG8_MMA(0, 0, At, B0); PG8_MMA(0, 1, At, B1); PG8_BAR; PG8_SCHED;
            PG8_LDA(At, 0, 1); PG8_STAGE(PG8_SB(0, 0), b2, voffB); PG8_STAGE(PG8_SB(0, 1), b2 + hstep, voffB); PG8_STAGE(PG8_SA(0, 0), a2, voffA);
            PG8_WAIT_V(8); PG8_WAIT_L(0); PG8_BAR; PG8_MMA(1, 0, At, B0); PG8_MMA(1, 1, At, B1); PG8_BAR; PG8_SCHED;
            PG8_LDB(B0, 1, 0); PG8_LDB(B1, 1, 1); PG8_SCHED; PG8_LDA(At, 1, 0); PG8_STAGE(PG8_SA(0, 1), a2 + hstep, voffA);
            PG8_WAIT_V(8); PG8_WAIT_L(0); PG8_BAR; PG8_MMA(0, 0, At, B0); PG8_MMA(0, 1, At, B1); PG8_BAR; PG8_SCHED;
            PG8_LDA(At, 1, 1); PG8_STAGE(PG8_SB(1, 0), b3, voffB); PG8_STAGE(PG8_SB(1, 1), b3 + hstep, voffB); PG8_STAGE(PG8_SA(1, 0), a3, voffA);
            PG8_WAIT_V(8); PG8_WAIT_L(0); PG8_BAR; PG8_MMA(1, 0, At, B0); PG8_MMA(1, 1, At, B1); PG8_BAR; PG8_SCHED;
            } else {
            PG8_LDB(B0, 0, 0); PG8_SCHED; PG8_LDA(At, 0, 0); PG8_STAGE(PG8_SA(1, 1), a1 + hstep, voffA);
            PG8_WAIT_L(8); PG8_BAR; PG8_WAIT_L(0); PG8_MMA(0, 0, At, B0); PG8_BAR; PG8_SCHED;
            PG8_LDB(B1, 0, 1); PG8_STAGE(PG8_SB(0, 0), b2, voffB);
            PG8_BAR; PG8_WAIT_L(0); PG8_MMA(0, 1, At, B1); PG8_BAR;
            PG8_LDA(At, 0, 1); PG8_STAGE(PG8_SA(0, 0), a2, voffA);
            PG8_BAR; PG8_WAIT_L(0); PG8_MMA(1, 0, At, B0); PG8_BAR; PG8_SCHED;
            PG8_STAGE(PG8_SB(0, 1), b2 + hstep, voffB);
            PG8_WAIT_V(6); PG8_BAR; PG8_MMA(1, 1, At, B1); PG8_BAR;
            PG8_LDB(B0, 1, 0); PG8_SCHED; PG8_LDA(At, 1, 0); PG8_STAGE(PG8_SA(0, 1), a2 + hstep, voffA);
            PG8_WAIT_L(8); PG8_BAR; PG8_WAIT_L(0); PG8_MMA(0, 0, At, B0); PG8_BAR; PG8_SCHED;
            PG8_LDB(B1, 1, 1); PG8_STAGE(PG8_SB(1, 0), b3, voffB);
            PG8_BAR; PG8_WAIT_L(0); PG8_MMA(0, 1, At, B1); PG8_BAR;
            PG8_LDA(At, 1, 1); PG8_STAGE(PG8_SA(1, 0), a3, voffA);
            PG8_BAR; PG8_WAIT_L(0); PG8_MMA(1, 0, At, B0); PG8_BAR; PG8_SCHED;
            PG8_STAGE(PG8_SB(1, 1), b3 + hstep, voffB);
            PG8_WAIT_V(6); PG8_BAR; PG8_MMA(1, 1, At, B1); PG8_BAR;
            }
        }
        if constexpr (ALIGN_EPI) { if (wr == 0) PG8_BAR; }
        if constexpr (!Epi::AFTER_DRAIN) { E(acc, cur, wr, wc, fr, fq); S.done(cur); }
        if (!has_next) break;
#pragma unroll
        for (int a = 0; a < 2; ++a)
#pragma unroll
            for (int b = 0; b < 2; ++b)
#pragma unroll
                for (int m = 0; m < 4; ++m)
#pragma unroll
                    for (int n = 0; n < 2; ++n) acc[a][b][m][n] = (f32x4){0.f, 0.f, 0.f, 0.f};
        cur = nxt; cA = nA; cB = nB; ++ui;
        if constexpr (ALIGN_EPI) { if (wr == 1) PG8_BAR; }
    }
    PG8_WAIT_V(0);
    if constexpr (!ALIGN_EPI) { if (wr == 0) PG8_BAR; }
    PG8_BAR;
    if constexpr (Epi::AFTER_DRAIN) { E.fused(acc, cur, wr, wc, fr, fq, lds, wid, lane); S.done(cur); }
#undef PG8_SA
#undef PG8_SB
#undef PG8_STAGE
#undef PG8_LDA
#undef PG8_LDB
#undef PG8_MMA
#undef PG8_WAIT_V
#undef PG8_WAIT_L
#undef PG8_BAR
#undef PG8_SCHED
}
}
#define GAS __attribute__((address_space(1)))
#define LAS __attribute__((address_space(3)))
typedef unsigned short bf16;
typedef unsigned v4u __attribute__((ext_vector_type(4)));
typedef float f32x4 __attribute__((ext_vector_type(4)));
typedef short bf16x8 __attribute__((ext_vector_type(8)));
typedef GAS unsigned gu32;
typedef GAS unsigned long long gu64;
#define RLX_AGENT __ATOMIC_RELAXED, __HIP_MEMORY_SCOPE_AGENT
#define LDS_WAIT() asm volatile("s_waitcnt lgkmcnt(0)" ::: "memory")
#define VM_WAIT() asm volatile("s_waitcnt vmcnt(0)" ::: "memory")
__device__ __forceinline__ unsigned long long rt() { return __builtin_amdgcn_s_memrealtime(); }
__device__ __forceinline__ unsigned f2bf(float f) { unsigned u = __builtin_bit_cast(unsigned, f); return (u + 0x7fffu + ((u >> 16) & 1u)) >> 16; }
__device__ __forceinline__ unsigned pk2(float lo, float hi) { typedef __bf16 b2_ __attribute__((ext_vector_type(2))); typedef float f2_ __attribute__((ext_vector_type(2))); return __builtin_bit_cast(unsigned, __builtin_convertvector((f2_){lo, hi}, b2_)); }
#define XB_TMO      128
#define XB_XCNT(j)  (256  + 64 * (j))
#define XB_XSUB(j)  (1280 + 64 * (j))
#define XB_XGEN(j)  (2304 + 64 * (j))
#define XB_TOP      3328
#define XB_TOPGEN   3392
#define XCD_BAR_WORDS 3456
#define XB_SPIN_CAP (1u << 18)

__device__ __forceinline__ unsigned xb_ld(unsigned* p)              { return __hip_atomic_load(p, __ATOMIC_RELAXED, __HIP_MEMORY_SCOPE_AGENT); }
__device__ __forceinline__ unsigned xb_add(unsigned* p, unsigned v) { return __hip_atomic_fetch_add(p, v, __ATOMIC_RELAXED, __HIP_MEMORY_SCOPE_AGENT); }
__device__ __forceinline__ unsigned xb_xcc_id() { return (unsigned)__builtin_amdgcn_s_getreg((3 << 11) | 20) & 0xFu; }
#define XB_SPIN(cond, bar) do { unsigned _sp = 0; while (cond) { __builtin_amdgcn_s_sleep(1); \
    if ((++_sp & 255u) == 0u) { if (xb_ld(&(bar)[XB_TMO])) break; if (_sp > XB_SPIN_CAP) { atomicAdd(&(bar)[XB_TMO], 1u); break; } } } } while (0)

struct XcdBarrier {
    unsigned* bar; unsigned x;
    volatile LAS unsigned* st;
};

__device__ __forceinline__ XcdBarrier xcd_barrier_post(unsigned* bar, volatile LAS unsigned* st) {
    XcdBarrier b; b.bar = bar; b.x = xb_xcc_id(); b.st = st;
    if (threadIdx.x == 0) (void)xb_add(&bar[XB_XCNT(b.x)], 1u);
    return b;
}
__device__ __forceinline__ void xcd_barrier_complete(unsigned* bar, unsigned x, unsigned& nloc, unsigned& nx) {
    const unsigned G = gridDim.x * gridDim.y * gridDim.z;
    unsigned sum, cnt, mine, sp = 0u;
    for (;;) {
        sum = 0u; cnt = 0u; mine = 0u;
#pragma unroll
        for (unsigned j = 0; j < 16; ++j) { const unsigned c = xb_ld(&bar[XB_XCNT(j)]); sum += c; cnt += (c > 0u) ? 1u : 0u; mine = (j == x) ? c : mine; }
        if (sum == G) break;
        __builtin_amdgcn_s_sleep(1);
        if ((++sp & 255u) == 0u) { if (xb_ld(&bar[XB_TMO])) break; if (sp > XB_SPIN_CAP) { atomicAdd(&bar[XB_TMO], 1u); break; } }
    }
    nloc = mine > 0u ? mine : 1u; nx = cnt > 0u ? cnt : 1u;
}

__device__ __forceinline__ void xcd_barrier(const XcdBarrier& b) {
    asm volatile("s_waitcnt vmcnt(0)" ::: "memory");
    __syncthreads();
    if (threadIdx.x == 0) {
        unsigned* bar = b.bar;
        __builtin_amdgcn_s_waitcnt(0);
        unsigned nloc = b.st[0], nx = b.st[1];
        if (nloc == 0u) { xcd_barrier_complete(bar, b.x, nloc, nx); b.st[0] = nloc; b.st[1] = nx; }
        const unsigned old = xb_add(&bar[XB_XSUB(b.x)], 1u);
        const unsigned gen = old / nloc;
        if (old + 1u == (gen + 1u) * nloc) {
            __builtin_amdgcn_fence(__ATOMIC_RELEASE, "agent");
            asm volatile("s_waitcnt vmcnt(0)" ::: "memory");
            const unsigned og = xb_add(&bar[XB_TOP], 1u);
            const unsigned tg = og / nx;
            if (og + 1u == (tg + 1u) * nx) xb_add(&bar[XB_TOPGEN], 1u);
            else XB_SPIN(xb_ld(&bar[XB_TOPGEN]) == tg, bar);
            __builtin_amdgcn_fence(__ATOMIC_ACQUIRE, "agent");
            xb_add(&bar[XB_XGEN(b.x)], 1u);
            asm volatile("s_waitcnt vmcnt(0)" ::: "memory");
        } else {
            XB_SPIN(xb_ld(&bar[XB_XGEN(b.x)]) == gen, bar);
            __builtin_amdgcn_fence(__ATOMIC_ACQUIRE, "agent");
            asm volatile("s_waitcnt vmcnt(0)" ::: "memory");
        }
    }
    __syncthreads();
}
#define REP_MASK 0u
#ifndef PG8_SP2
#define PG8_SP2 true
#endif
#ifndef PG8_ALIGN
#define PG8_ALIGN true
#endif
constexpr int NWAVES = 8, NTHR = NWAVES * 64;
constexpr int BATCH = 4, SEQ = 2048, DM = 4096, NMETA = 16;
constexpr int MR = BATCH * SEQ;
constexpr int MROWS = MR + NMETA;
constexpr int MT = 8448;
constexpr int NIN = 32784;
constexpr int N1 = 33024;
constexpr int DFF = 11008, NF = 2 * DFF;
constexpr int RET_H = 8, RET_DK = 256, RET_DV = 512, GLA_H = 4, GLA_DK = 512, GLA_DV = 1024, GLA_RANK = 16;
constexpr float EPS = 1e-6f;
constexpr int C_QR = 0, C_QG = 2048, C_KG = 4096, C_GR = 6144, C_GG = 14336, C_B = 22528, C_KR = 22528, C_V = 24576, C_Z = 32768, LDP = 4096, P_QG = 0, P_KG = 2048;
constexpr int NPH = 11;
#ifndef MK_N_LAUNCHES
#define MK_N_LAUNCHES 1
#endif
constexpr int N_LAUNCHES = MK_N_LAUNCHES;

constexpr size_t al256(size_t x) { return (x + 255) & ~(size_t)255; }
constexpr size_t WS_CTL = 0, CTL_ZERO_BYTES = 1u << 20;
constexpr size_t WS_W1T = WS_CTL + CTL_ZERO_BYTES;
constexpr size_t WS_WOT = WS_W1T + al256((size_t)N1 * DM * 2);
constexpr size_t WS_WFT = WS_WOT + al256((size_t)DM * DM * 2);
constexpr size_t WS_W2T = WS_WFT + al256((size_t)NF * DM * 2);
constexpr size_t WS_XB  = WS_W2T + al256((size_t)DM * DFF * 2);
constexpr size_t WS_RS1 = WS_XB + al256((size_t)MT * DM * 2);
constexpr size_t WS_RS2 = WS_RS1 + al256((size_t)MT * 4);
constexpr size_t WS_ZB  = WS_RS2 + al256((size_t)MT * 4);
constexpr size_t WS_COS = WS_ZB + al256((size_t)MT * 16 * 4);
constexpr size_t WS_SIN = WS_COS + al256((size_t)MROWS * 128 * 4);
constexpr size_t WS_COST = WS_SIN + al256((size_t)MROWS * 128 * 4);
constexpr size_t WS_SINT = WS_COST + (size_t)128 * MT * 4;
constexpr size_t WS_PROJ = WS_SINT + (size_t)128 * MT * 4;
constexpr size_t WS_UG  = WS_PROJ;
constexpr size_t WS_ACT = WS_UG + al256((size_t)MT * NF * 2);
constexpr size_t WS_YR  = WS_PROJ + al256((size_t)MT * N1 * 2);
constexpr size_t WS_YG  = WS_YR + al256((size_t)MROWS * DM * 2);
constexpr size_t WS_GR  = WS_YG + al256((size_t)MROWS * DM * 2);
constexpr size_t WS_GG  = WS_GR + al256((size_t)MT * DM * 2);
constexpr size_t WS_MRG = WS_GG + al256((size_t)MT * DM * 2);
constexpr size_t WS_H1  = WS_MRG + al256((size_t)MT * DM * 2);
constexpr size_t WS_H1B = WS_H1 + al256((size_t)MT * DM * 4);
constexpr size_t WS_QFG = WS_H1B + al256((size_t)MT * DM * 2);
constexpr size_t WS_KFG = WS_QFG + (size_t)4 * 4 * 33 * 65536;
constexpr size_t WS_QFR = WS_KFG + (size_t)4 * 4 * 33 * 65536;
constexpr size_t WS_KFR = WS_QFR + (size_t)4 * 8 * 33 * 32768;
constexpr size_t WS_VFG = WS_KFR + (size_t)4 * 8 * 33 * 32768;
constexpr size_t WS_VFR = WS_VFG + (size_t)4 * 33 * 64 * 8192;
constexpr size_t WS_PFG = WS_VFR + (size_t)4 * 33 * 64 * 8192;
constexpr size_t WS_PFR = WS_PFG + (size_t)4 * 4 * 33 * 8192;
constexpr size_t WS_DECG = WS_PFR + (size_t)4 * 8 * 33 * 8192;
constexpr size_t WS_UPH = WS_DECG + (size_t)4 * 4 * 33 * 512 * 4;
constexpr size_t WS_PARTC = WS_UPH + (size_t)32 * 2 * DFF * 4;
constexpr size_t WS_PARTG = WS_PARTC + (size_t)32 * 2 * DFF * 4;
constexpr size_t WS_UPM = WS_PARTG + (size_t)32 * 2 * DFF * 4;
constexpr size_t WS_END = WS_UPM + (size_t)2 * DFF * 4;
static_assert(WS_ACT + (size_t)MR * DFF * 2 <= WS_YR, "UG | ACT overlay fits inside PROJ");
static_assert(WS_END <= (size_t)4 * 4096 * NIN * 4, "workspace map fits 4 x the largest tensor");
constexpr int CW_TMO = 0, CW_CODE = 1, CW_BAR = 4096, CW_Q2 = 8000, CW_SS2 = 8192;

constexpr int RING_OFF = 0, RING_BYTES = 131072;
constexpr int LDS_BYTES = 163840;
constexpr int LDSCTL_OFF = LDS_BYTES - 1024, MISC_OFF = LDSCTL_OFF + 320;
static_assert(MISC_OFF + 128 <= LDS_BYTES, "LDS map");

__device__ __forceinline__ float bf2f(bf16 v) { return __builtin_bit_cast(float, (unsigned)v << 16); }
__device__ __forceinline__ float wave_sum(float v) {
#pragma unroll
    for (int o = 1; o < 64; o <<= 1) v += __shfl_xor(v, o);
    return v;
}
__device__ __forceinline__ float sigm(float x) { return 1.f / (1.f + __expf(-x)); }
__device__ __forceinline__ float silu(float x) { return x / (1.f + __expf(-x)); }
__device__ __forceinline__ float logsig(float x) { return fminf(x, 0.f) - __logf(1.0f + __expf(-fabsf(x))); }

typedef float f32x16 __attribute__((ext_vector_type(16)));
#define MFMA32(a, b, c) __builtin_amdgcn_mfma_f32_32x32x16_bf16((a), (b), (c), 0, 0, 0)
__device__ __forceinline__ unsigned pkbf(float lo, float hi) { typedef __bf16 b2 __attribute__((ext_vector_type(2))); typedef float f2 __attribute__((ext_vector_type(2))); return __builtin_bit_cast(unsigned, __builtin_convertvector((f2){lo, hi}, b2)); }
__device__ __forceinline__ bf16 f2b(float x) { return (bf16)(pkbf(x, 0.f) & 0xffffu); }
__device__ __forceinline__ int chunk_row(int b, int n, int i) { return n == 0 ? (i < 48 ? -1 : MR + i - 48) : b * SEQ + 64 * (n - 1) + i; }

struct Frame {
    LAS unsigned char* lds;
    volatile LAS unsigned* MISC;
    gu32* ctl;
    int tid, lane, wave, G;
    const float *x, *meta, *attn_norm, *w_in, *w_gate_up, *b_gate, *ret_norm, *gla_norm, *w_out, *ffn_norm, *w_ffn_in, *conv_w, *conv_b, *w_ffn_out, *final_norm;
    const int* positions;
    float* out;
    bf16 *W1t, *Wot, *Wft, *W2t, *XB, *PROJ, *UG, *ACT, *MRG, *H1B;
    float *RS1, *SS2, *ZB, *COS, *SIN, *COST, *SINT, *H1, *DECG, *UPH, *PARTC, *PARTG, *UPM;
    bf16 *YR, *YG, *GR, *GG, *QFG, *KFG, *QFR, *KFR, *VFG, *VFR, *PFG, *PFR;
};

namespace pg8 {
__device__ __forceinline__ float gate2(float o, float m) { return o * __builtin_amdgcn_rcpf((1.0f + __expf(-o)) * (1.0f + __expf(-m))); }
typedef unsigned long long u64_t;
__device__ __forceinline__ u64_t pk4(const f32x4& v) { return (u64_t)cvt_pk_bf16(v[0], v[1]) | ((u64_t)cvt_pk_bf16(v[2], v[3]) << 32); }
struct EpiA {
    static constexpr bool PERM = true, AFTER_DRAIN = false;
    bf16_t* O; const float* rs; const float* cs; const float* sn; unsigned char* QFR; bf16_t* GR; bf16_t* GG;
    __device__ __forceinline__ void operator()(const f32x4 (&acc)[2][2][4][2], const Unit& u, int wr, int wc, int fr, int fq) const {
        const int row0 = u.pm * BM + wr * 64 + fr;
        if (u.pn < 8) {
            const int h = u.pn, b = u.pm >> 3; const float l2g = __log2f(1.0f - exp2f(-5.0f - (float)h));
#pragma unroll
            for (int ai = 0; ai < 2; ++ai) { const size_t cb = (size_t)(b * 8 + h) * 33 + 1 + 4 * (u.pm & 7) + 2 * ai + wr;
                unsigned char* qb = QFR + (cb * 8 + wc) * 4096 + (fq >> 1) * 2048 + fr * 16 + 8 * (fq & 1);
#pragma unroll
                for (int m = 0; m < 4; ++m) { const int row = row0 + ai * HALF + m * 16; const float dq = exp2f((float)(16 * m + fr + 1) * l2g) * rs[row];
                    const float* cp = cs + (size_t)row * 128 + wc * 32 + 8 * fq; const float* sp = sn + (size_t)row * 128 + wc * 32 + 8 * fq;
#pragma unroll
                    for (int n = 0; n < 2; ++n) { const f32x4 c = *(const f32x4*)(cp + 4 * n), s4 = *(const f32x4*)(sp + 4 * n), x1 = acc[ai][0][m][n], x2 = acc[ai][1][m][n];
                        const f32x4 o1 = (x1 * c - x2 * s4) * dq, o2 = (x2 * c + x1 * s4) * dq;
                        unsigned char* d = qb + (m >> 1) * 1024 + (16 * (m & 1) + 32 * n) * 16;
                        *(u64_t*)d = pk4(o1); *(u64_t*)(d + 4 * 4096) = pk4(o2); }
                    asm volatile("" ::: "memory"); } }
        } else if (u.pn < 24) {
            const int col0 = (u.pn - 8) * BM + wc * 32 + 8 * fq;
#pragma unroll
            for (int ai = 0; ai < 2; ++ai)
#pragma unroll
                for (int m = 0; m < 4; ++m) { const int row = row0 + ai * HALF + m * 16; const float s = rs[row]; bf16_t* rowp = O + (size_t)row * LDP + col0;
#pragma unroll
                    for (int bj = 0; bj < 2; ++bj) { const f32x4 v0 = acc[ai][bj][m][0] * s, v1 = acc[ai][bj][m][1] * s;
                        u32x4 w; w.x = cvt_pk_bf16(v0[0], v0[1]); w.y = cvt_pk_bf16(v0[2], v0[3]); w.z = cvt_pk_bf16(v1[0], v1[1]); w.w = cvt_pk_bf16(v1[2], v1[3]);
                        *(u32x4*)(rowp + bj * HALF) = w; } }
        } else {
            bf16_t* G = u.pn < 56 ? GR : GG; const int col0 = 128 * ((u.pn - 24) & 31) + wc * 32 + 8 * fq;
#pragma unroll
            for (int ai = 0; ai < 2; ++ai)
#pragma unroll
                for (int m = 0; m < 4; ++m) { const int row = row0 + ai * HALF + m * 16; const float s = rs[row];
                    const f32x4 o0 = acc[ai][0][m][0] * s, o1 = acc[ai][0][m][1] * s, m0 = acc[ai][1][m][0] * s, m1 = acc[ai][1][m][1] * s;
                    u32x4 w; w.x = cvt_pk_bf16(gate2(o0[0], m0[0]), gate2(o0[1], m0[1])); w.y = cvt_pk_bf16(gate2(o0[2], m0[2]), gate2(o0[3], m0[3]));
                    w.z = cvt_pk_bf16(gate2(o1[0], m1[0]), gate2(o1[1], m1[1])); w.w = cvt_pk_bf16(gate2(o1[2], m1[2]), gate2(o1[3], m1[3]));
                    *(u32x4*)(G + (size_t)row * DM + col0) = w; }
        }
    }
};
struct EpiB {
    static constexpr bool PERM = false, AFTER_DRAIN = false;
    unsigned char* VFR; unsigned char* VFG; unsigned char* KFR; const float* rs; const float* cst; const float* snt;
    __device__ __forceinline__ void operator()(const f32x4 (&acc)[2][2][4][2], const Unit& u, int wr, int wc, int fr, int fq) const {
        const int b = u.pm >> 3;
        if (u.pn < 8) {
            const int h = u.pn; const float l2g = __log2f(1.0f - exp2f(-5.0f - (float)h));
#pragma unroll
            for (int ai = 0; ai < 2; ++ai) { const size_t cb = (size_t)(b * 8 + h) * 33 + 1 + 4 * (u.pm & 7) + 2 * ai + wr;
                unsigned char* kb = KFR + (cb * 8 + wc) * 4096 + (fr + 32 * (fq & 1)) * 16 + 8 * (fq >> 1);
#pragma unroll
                for (int m = 0; m < 4; ++m) { const int rowb = u.pm * BM + ai * HALF + wr * 64 + m * 16 + 4 * fq; const f32x4 s4 = *(const f32x4*)(rs + rowb); f32x4 dk4;
#pragma unroll
                    for (int e = 0; e < 4; ++e) dk4[e] = exp2f(-(float)(16 * m + 4 * fq + e + 1) * l2g) * 0.0625f * s4[e];
#pragma unroll
                    for (int n = 0; n < 2; ++n) { const int idx = wc * 32 + n * 16 + fr;
                        const f32x4 c = *(const f32x4*)(cst + (size_t)idx * MT + rowb), sn4 = *(const f32x4*)(snt + (size_t)idx * MT + rowb), x1 = acc[ai][0][m][n], x2 = acc[ai][1][m][n];
                        const f32x4 o1 = (x1 * c - x2 * sn4) * dk4, o2 = (x2 * c + x1 * sn4) * dk4;
                        unsigned char* d = kb + m * 1024 + n * 256;
                        *(u64_t*)d = pk4(o1); *(u64_t*)(d + 4 * 4096) = pk4(o2); }
                    asm volatile("" ::: "memory"); } }
        } else {
            const int pv = u.pn - 8; unsigned char* VF = pv < 16 ? VFR : VFG;
#pragma unroll
            for (int ai = 0; ai < 2; ++ai) { const int nc = 1 + 4 * (u.pm & 7) + 2 * ai + wr;
#pragma unroll
                for (int m = 0; m < 4; ++m) { const f32x4 s4 = *(const f32x4*)(rs + u.pm * BM + ai * HALF + wr * 64 + m * 16 + 4 * fq);
#pragma unroll
                    for (int bj = 0; bj < 2; ++bj) { const int slg = 4 * (pv & 15) + 2 * bj + (wc >> 1);
                        unsigned char* fb = VF + ((((size_t)b * 33 + nc) * 64 + slg) * 8 + (wc & 1) * 4 + m) * 1024 + (fr + 32 * (fq & 1)) * 16 + 8 * (fq >> 1);
#pragma unroll
                        for (int n = 0; n < 2; ++n) { const f32x4 v = acc[ai][bj][m][n] * s4; *(u64_t*)(fb + n * 256) = pk4(v); } } } }
        }
    }
};
struct EpiScaleBf16 {
    static constexpr bool PERM = true, AFTER_DRAIN = false;
    bf16_t* O; int ldc; const float* ss;
    __device__ __forceinline__ void operator()(const f32x4 (&acc)[2][2][4][2], const Unit& u, int wr, int wc, int fr, int fq) const {
        const int row0 = u.pm * BM + wr * 64 + fr, col0 = u.pn * BM + wc * 32 + 8 * fq;
#pragma unroll
        for (int ai = 0; ai < 2; ++ai)
#pragma unroll
            for (int m = 0; m < 4; ++m) { const int row = row0 + ai * HALF + m * 16; const float s = 1.0f / sqrtf(ss[row] * (1.0f / 4096.0f) + 1e-6f); bf16_t* rowp = O + (size_t)row * ldc + col0;
#pragma unroll
                for (int bj = 0; bj < 2; ++bj) { const f32x4 v0 = acc[ai][bj][m][0] * s, v1 = acc[ai][bj][m][1] * s;
                    u32x4 w; w.x = cvt_pk_bf16(v0[0], v0[1]); w.y = cvt_pk_bf16(v0[2], v0[3]); w.z = cvt_pk_bf16(v1[0], v1[1]); w.w = cvt_pk_bf16(v1[2], v1[3]);
                    *(u32x4*)(rowp + bj * HALF) = w; } }
    }
};
struct EpiFfn {
    static constexpr bool PERM = true, AFTER_DRAIN = false;
    bf16_t* ACT; const float* ss; const float* cw; const float* cbias; float* UPH; float* PARTC; float* PARTG; PG8_LAS float* hl;
    __device__ __forceinline__ void operator()(const f32x4 (&acc)[2][2][4][2], const Unit& u, int wr, int wc, int fr, int fq) const {
        const int ch0 = wc * 32 + 8 * fq, cg = 128 * u.pn + ch0;
        f32x4 w0[2], w1[2], w2[2], cb[2];
#pragma unroll
        for (int n = 0; n < 2; ++n) { w0[n] = *(const f32x4*)(cw + cg + 4 * n); w1[n] = *(const f32x4*)(cw + DFF + cg + 4 * n); w2[n] = *(const f32x4*)(cw + 2 * DFF + cg + 4 * n); cb[n] = *(const f32x4*)(cbias + cg + 4 * n); }
        float rsv[2][4];
#pragma unroll
        for (int ai = 0; ai < 2; ++ai)
#pragma unroll
            for (int m = 0; m < 4; ++m) rsv[ai][m] = 1.0f / sqrtf(ss[u.pm * BM + ai * HALF + wr * 64 + m * 16 + fr] * (1.0f / 4096.0f) + 1e-6f);
        if (fr >= 14) {
#pragma unroll
            for (int ai = 0; ai < 2; ++ai)
#pragma unroll
                for (int n = 0; n < 2; ++n) { const f32x4 v = acc[ai][0][3][n] * rsv[ai][3];
                    *(PG8_LAS f32x4*)(hl + ((2 * ai + wr) * 2 + (fr - 14)) * 128 + ch0 + 4 * n) = v;
                    if (ai == 1 && wr == 1) *(f32x4*)(UPH + ((size_t)u.pm * 2 + (fr - 14)) * DFF + cg + 4 * n) = v; }
        }
        asm volatile("s_waitcnt lgkmcnt(0)" ::: "memory"); __builtin_amdgcn_s_barrier(); asm volatile("" ::: "memory");
#pragma unroll
        for (int ai = 0; ai < 2; ++ai) { const int bl = 2 * ai + wr;
            f32x4 p1[2], p2[2];
#pragma unroll
            for (int n = 0; n < 2; ++n) { p1[n] = (f32x4){0.f, 0.f, 0.f, 0.f}; p2[n] = p1[n];
                if (bl > 0) { const f32x4 r62 = *(const PG8_LAS f32x4*)(hl + ((bl - 1) * 2 + 0) * 128 + ch0 + 4 * n), r63 = *(const PG8_LAS f32x4*)(hl + ((bl - 1) * 2 + 1) * 128 + ch0 + 4 * n);
                    p1[n] = r63; p2[n] = fr == 0 ? r62 : r63; } }
#pragma unroll
            for (int m = 0; m < 4; ++m) { const int row = u.pm * BM + ai * HALF + wr * 64 + m * 16 + fr; float res[8];
#pragma unroll
                for (int n = 0; n < 2; ++n) { const f32x4 up0 = acc[ai][0][m][n] * rsv[ai][m], gt = acc[ai][1][m][n] * rsv[ai][m]; f32x4 c1, c2, l15, l14;
#pragma unroll
                    for (int j = 0; j < 4; ++j) { c1[j] = __shfl_up(up0[j], 1, 16); c2[j] = __shfl_up(up0[j], 2, 16); l15[j] = __shfl(up0[j], 15, 16); l14[j] = __shfl(up0[j], 14, 16); }
                    const f32x4 up1 = fr >= 1 ? c1 : p1[n], up2 = fr >= 2 ? c2 : p2[n];
                    const f32x4 cc = cb[n] + w0[n] * up2 + w1[n] * up1 + w2[n] * up0;
                    if (bl == 0 && m == 0 && fr < 2) {
                        *(f32x4*)(PARTC + ((size_t)u.pm * 2 + fr) * DFF + cg + 4 * n) = cc; *(f32x4*)(PARTG + ((size_t)u.pm * 2 + fr) * DFF + cg + 4 * n) = gt; }
#pragma unroll
                    for (int j = 0; j < 4; ++j) res[4 * n + j] = cc[j] * __builtin_amdgcn_rcpf(1.0f + __expf(-cc[j])) * gt[j];
                    p1[n] = l15; p2[n] = fr == 0 ? l14 : l15; }
                u32x4 w; w.x = cvt_pk_bf16(res[0], res[1]); w.y = cvt_pk_bf16(res[2], res[3]); w.z = cvt_pk_bf16(res[4], res[5]); w.w = cvt_pk_bf16(res[6], res[7]);
                *(u32x4*)(ACT + (size_t)row * DFF + cg) = w; } }
    }
};
struct EpiResX {
    static constexpr bool PERM = true, AFTER_DRAIN = false;
    const float* x; const float* meta; float* out; bf16_t* outb; float* ss; int ldc; int nreal, nmeta;
    __device__ __forceinline__ void operator()(const f32x4 (&acc)[2][2][4][2], const Unit& u, int wr, int wc, int fr, int fq) const {
        const int row0 = u.pm * BM + wr * 64 + fr, col0 = u.pn * BM + wc * 32 + 8 * fq;
#pragma unroll
        for (int ai = 0; ai < 2; ++ai)
#pragma unroll
            for (int m = 0; m < 4; ++m) { const int row = row0 + ai * HALF + m * 16;
                const float* bp = row < nreal ? x + (size_t)row * ldc : (row < nreal + nmeta ? meta + (size_t)(row - nreal) * ldc : nullptr);
                float* rowp = out + (size_t)row * ldc + col0; bf16_t* rowb = outb + (size_t)row * ldc + col0; float q = 0.f;
#pragma unroll
                for (int bj = 0; bj < 2; ++bj) { f32x4 o0 = (f32x4){0.f, 0.f, 0.f, 0.f}, o1 = o0;
                    if (bp) { o0 = *(const f32x4*)(bp + col0 + bj * HALF) + acc[ai][bj][m][0]; o1 = *(const f32x4*)(bp + col0 + bj * HALF + 4) + acc[ai][bj][m][1]; }
                    *(f32x4*)(rowp + bj * HALF) = o0; *(f32x4*)(rowp + bj * HALF + 4) = o1;
                    u32x4 w; w.x = cvt_pk_bf16(o0[0], o0[1]); w.y = cvt_pk_bf16(o0[2], o0[3]); w.z = cvt_pk_bf16(o1[0], o1[1]); w.w = cvt_pk_bf16(o1[2], o1[3]);
                    *(u32x4*)(rowb + bj * HALF) = w;
                    q += (o0[0] * o0[0] + o0[1] * o0[1]) + (o0[2] * o0[2] + o0[3] * o0[3]) + (o1[0] * o1[0] + o1[1] * o1[1]) + (o1[2] * o1[2] + o1[3] * o1[3]); }
                q += __shfl_xor(q, 16); q += __shfl_xor(q, 32);
                if (fq == 0 && bp) atomicAdd(ss + row, q); }
    }
};
struct EpiResF32 {
    static constexpr bool PERM = false, AFTER_DRAIN = false;
    const float* base; float* out; int ldc;
    __device__ __forceinline__ void operator()(const f32x4 (&acc)[2][2][4][2], const Unit& u, int wr, int wc, int fr, int fq) const {
        const int row0 = u.pm * BM + wr * 64 + fr, col0 = u.pn * BM + wc * 32 + 4 * fq;
#pragma unroll
        for (int ai = 0; ai < 2; ++ai)
#pragma unroll
            for (int m = 0; m < 4; ++m) { const size_t off = (size_t)(row0 + ai * HALF + m * 16) * ldc + col0;
#pragma unroll
                for (int bj = 0; bj < 2; ++bj)
#pragma unroll
                    for (int n = 0; n < 2; ++n) *(f32x4*)(out + off + bj * HALF + n * 16) = *(const f32x4*)(base + off + bj * HALF + n * 16) + acc[ai][bj][m][n]; }
    }
};
}

struct TItem { const float* W; int K, ldw, c0, nc; bf16* WT; int row_off; const float* kscale; int item; int blk, bstride; };
__device__ __forceinline__ void titem_kn(const TItem& t, int& kb, int& nb) {
    const int nblk = (t.nc + 63) / 64, nkb = t.K / 64;
    if (nblk % 4) { kb = t.item % nkb; nb = t.item / nkb; } else { const int g = t.item >> 2; kb = g % nkb; nb = (g / nkb) * 4 + (t.item & 3); }
}
__device__ __forceinline__ void titem_load(const TItem& t, f32x4 (&v)[16], int lane) {
    int kb, nb; titem_kn(t, kb, nb); const int k0 = 64 * kb, n = 64 * nb + 4 * (lane & 15);
    const bool ok = n < t.nc;
    const float* p = t.W + (size_t)(k0 + (lane >> 4)) * t.ldw + t.c0 + n;
#pragma unroll
    for (int i = 0; i < 16; ++i) v[i] = ok ? *(const f32x4*)(p + (size_t)(4 * i) * t.ldw) : (f32x4){0.f, 0.f, 0.f, 0.f};
}
__device__ __forceinline__ void titem_store(const TItem& t, const f32x4 (&v)[16], LAS float* scr, int lane) {
    int kb, nb; titem_kn(t, kb, nb); const int k0 = 64 * kb, n0 = 64 * nb;
#pragma unroll
    for (int i = 0; i < 16; ++i) { LAS float* d = scr + (4 * i + (lane >> 4)) * 65 + 4 * (lane & 15); d[0] = v[i].x; d[1] = v[i].y; d[2] = v[i].z; d[3] = v[i].w; }
    LDS_WAIT(); asm volatile("" ::: "memory");
    const int c = lane & 7;
    f32x4 s0 = (f32x4){1.f, 1.f, 1.f, 1.f}, s1 = s0;
    if (t.kscale) { s0 = *(const f32x4*)(t.kscale + k0 + 8 * c); s1 = *(const f32x4*)(t.kscale + k0 + 8 * c + 4); }
#pragma unroll
    for (int j = 0; j < 8; ++j) { const int nn = (lane >> 3) + 8 * j; const LAS float* s = scr + (8 * c) * 65 + nn;
        v4u o; o.x = pk2(s[0 * 65] * s0.x, s[1 * 65] * s0.y); o.y = pk2(s[2 * 65] * s0.z, s[3 * 65] * s0.w); o.z = pk2(s[4 * 65] * s1.x, s[5 * 65] * s1.y); o.w = pk2(s[6 * 65] * s1.z, s[7 * 65] * s1.w);
        const int nd = n0 + nn; *(GAS v4u*)(t.WT + (size_t)(t.row_off + (nd / t.blk) * t.bstride + nd % t.blk) * t.K + k0 + 8 * c) = o; }
    LDS_WAIT(); asm volatile("" ::: "memory");
}
__device__ __forceinline__ void p0_prologue(Frame& F) {
    LAS float* scr = (LAS float*)(F.lds + RING_OFF + F.wave * 17408);
    const int gw = blockIdx.x * NWAVES + F.wave, NGW = F.G * NWAVES;
    constexpr int BIG = 1 << 30;
    constexpr int I_2K = 64 * (2048 / 64), I_4K = 64 * (4096 / 64), I_Z = 64;
    constexpr int I_O = 64 * (DM / 64), I_F = 64 * (NF / 64);
    constexpr int NITEMS = 4 * I_2K + 6 * I_4K + I_Z + I_O + I_F;
    auto mk = [&](int it) { TItem t; int r = it;
        if (r < I_2K) { t = TItem{F.w_in, DM, NIN, 0, 2048, F.W1t, C_QR, F.attn_norm, r, BIG, 0}; return t; } r -= I_2K;
        if (r < I_2K) { t = TItem{F.w_in, DM, NIN, 2048, 2048, F.W1t, C_KR, F.attn_norm, r, BIG, 0}; return t; } r -= I_2K;
        if (r < I_4K) { t = TItem{F.w_in, DM, NIN, 4096, 4096, F.W1t, C_V, F.attn_norm, r, BIG, 0}; return t; } r -= I_4K;
        if (r < I_4K) { t = TItem{F.w_in, DM, NIN, 8192, 4096, F.W1t, C_GR, F.attn_norm, r, 128, 256}; return t; } r -= I_4K;
        if (r < I_2K) { t = TItem{F.w_in, DM, NIN, 12288, 2048, F.W1t, C_QG, F.attn_norm, r, BIG, 0}; return t; } r -= I_2K;
        if (r < I_2K) { t = TItem{F.w_in, DM, NIN, 14336, 2048, F.W1t, C_KG, F.attn_norm, r, BIG, 0}; return t; } r -= I_2K;
        if (r < I_4K) { t = TItem{F.w_in, DM, NIN, 16384, 4096, F.W1t, C_V + 4096, F.attn_norm, r, BIG, 0}; return t; } r -= I_4K;
        if (r < I_4K) { t = TItem{F.w_in, DM, NIN, 20480, 4096, F.W1t, C_GG, F.attn_norm, r, 128, 256}; return t; } r -= I_4K;
        if (r < I_Z) { t = TItem{F.w_in, DM, NIN, 24576, 16, F.W1t, C_Z, F.attn_norm, r, BIG, 0}; return t; } r -= I_Z;
        if (r < I_4K) { t = TItem{F.w_in, DM, NIN, 24592, 4096, F.W1t, C_GR + 128, F.attn_norm, r, 128, 256}; return t; } r -= I_4K;
        if (r < I_4K) { t = TItem{F.w_in, DM, NIN, 28688, 4096, F.W1t, C_GG + 128, F.attn_norm, r, 128, 256}; return t; } r -= I_4K;
        if (r < I_O) { t = TItem{F.w_out, DM, DM, 0, DM, F.Wot, 0, nullptr, r, BIG, 0}; return t; } r -= I_O;
        if (r < I_F / 2) { t = TItem{F.w_ffn_in, DM, NF, 0, DFF, F.Wft, 0, F.ffn_norm, r, 128, 256}; return t; } r -= I_F / 2;
        t = TItem{F.w_ffn_in, DM, NF, DFF, DFF, F.Wft, 128, F.ffn_norm, r, 128, 256}; return t; };
    if (gw < NITEMS) {
        f32x4 cur[16], nxt[16]; TItem tc = mk(gw); titem_load(tc, cur, F.lane);
        for (int it = gw; it < NITEMS; it += NGW) {
            const bool more = it + NGW < NITEMS; TItem tn = tc;
            if (more) { tn = mk(it + NGW); titem_load(tn, nxt, F.lane); }
            titem_store(tc, cur, scr, F.lane);
            if (more) {
#pragma unroll
                for (int i = 0; i < 16; ++i) cur[i] = nxt[i];
                tc = tn; }
        }
    }
    { const size_t n16 = (size_t)(N1 - C_Z - 64) * DM * 2 / 16; GAS v4u* p = (GAS v4u*)(F.W1t + (size_t)(C_Z + 64) * DM);
      for (size_t i = (size_t)blockIdx.x * NTHR + F.tid; i < n16; i += (size_t)F.G * NTHR) p[i] = (v4u){0u, 0u, 0u, 0u}; }
    { const size_t n16 = (size_t)64 * 8 * 1024 / 16;
      for (size_t i = (size_t)blockIdx.x * NTHR + F.tid; i < 2 * n16; i += (size_t)F.G * NTHR) ((GAS v4u*)(i < n16 ? F.VFR : F.VFG))[i < n16 ? i : i - n16] = (v4u){0u, 0u, 0u, 0u}; }
    for (int i = blockIdx.x * NTHR + F.tid; i < 2 * 8 * 2048; i += F.G * NTHR) {
        const int which = i >> 14, h = (i >> 11) & 7, o = i & 2047; ((GAS v4u*)((unsigned char*)(which ? F.KFR : F.QFR) + (size_t)h * 33 * 32768))[o] = (v4u){0u, 0u, 0u, 0u}; }
    for (int m = gw; m < MT; m += NGW) {
        GAS unsigned long long* o8 = (GAS unsigned long long*)(F.XB + (size_t)m * DM) + F.lane;
        if (m < MROWS) {
            const float* xrow = m < MR ? F.x + (size_t)m * DM : F.meta + (size_t)(m - MR) * DM;
            const GAS f32x4* xr = (const GAS f32x4*)xrow + F.lane; float ss = 0.f;
#pragma unroll
            for (int j = 0; j < 16; ++j) { const f32x4 v = xr[64 * j]; ss += (v.x * v.x + v.y * v.y) + (v.z * v.z + v.w * v.w);
                o8[64 * j] = (unsigned long long)pk2(v.x, v.y) | ((unsigned long long)pk2(v.z, v.w) << 32); }
            ss = wave_sum(ss);
            if (F.lane == 0) F.RS1[m] = 1.0f / sqrtf(ss * (1.0f / DM) + EPS);
        } else {
            GAS unsigned long long* o2 = (GAS unsigned long long*)(F.MRG + (size_t)m * DM) + F.lane;
            GAS unsigned long long* o3 = (GAS unsigned long long*)(F.H1B + (size_t)m * DM) + F.lane;
#pragma unroll
            for (int j = 0; j < 16; ++j) { o8[64 * j] = 0ull; o2[64 * j] = 0ull; o3[64 * j] = 0ull; }
            if (F.lane == 0) F.RS1[m] = 0.f;
        }
    }
    for (int i = blockIdx.x * NTHR + F.tid; i < 2 * MROWS * 128; i += F.G * NTHR) {
        const bool tr = i >= MROWS * 128; const int ii = tr ? i - MROWS * 128 : i;
        const int m = tr ? ii % MROWS : ii >> 7, j = tr ? ii / MROWS : ii & 127;
        const int pos = m < MR ? F.positions[m] + NMETA : m - MR;
        const float inv_freq = exp2f(-(float)j * (13.287712379549449f / 128.0f));
        const float ang = (float)pos * inv_freq;
        float rev = ang * 0.15915494309189535f; rev -= floorf(rev);
        const float s = __builtin_amdgcn_sinf(rev), c = __builtin_amdgcn_cosf(rev);
        if (tr) { F.COST[(size_t)j * MT + m] = c; F.SINT[(size_t)j * MT + m] = s; } else { F.COS[ii] = c; F.SIN[ii] = s; }
    }
}

__device__ __forceinline__ void convert_w2(Frame& F) {
    constexpr int I_2 = (DFF / 64) * (DM / 64);
    LAS float* scr = (LAS float*)(F.lds + RING_OFF + F.wave * 17408);
    for (;;) {
        int it = 0; if (F.lane == 0) it = (int)__hip_atomic_fetch_add((unsigned*)(F.ctl + CW_Q2), 1u, __ATOMIC_RELAXED, __HIP_MEMORY_SCOPE_AGENT);
        it = __builtin_amdgcn_readfirstlane(it);
        if (it >= I_2) break;
        TItem t{F.w_ffn_out, DFF, DM, 0, DM, F.W2t, 0, nullptr, it, 1 << 30, 0}; f32x4 v[16];
        titem_load(t, v, F.lane); titem_store(t, v, scr, F.lane);
    }
    __syncthreads();
}

typedef float f32x4v __attribute__((ext_vector_type(4)));
#define MFMA16(a, b, c) __builtin_amdgcn_mfma_f32_16x16x32_bf16((a), (b), (c), 0, 0, 0)
__device__ __forceinline__ f32x4v skinny_dot(const bf16* A, const bf16* Bt, int n0, int k0, int nks, int lane) {
    const int fr = lane & 15, fq = lane >> 4;
    const bf16* ap = A + (size_t)fr * DM + k0 + 8 * fq; const bf16* bp = Bt + (size_t)(n0 + fr) * DM + k0 + 8 * fq;
    f32x4v acc = (f32x4v){0.f, 0.f, 0.f, 0.f};
#pragma unroll 8
    for (int ks = 0; ks < nks; ++ks) acc = MFMA16(*(const bf16x8*)(ap + 32 * ks), *(const bf16x8*)(bp + 32 * ks), acc);
    return acc;
}
__device__ __forceinline__ void meta_proj(Frame& F) {
    const int lane = F.lane, fr = lane & 15, fq = lane >> 4, w8 = F.wave; LAS float* ex = (LAS float*)F.lds;
    const bf16* A = F.XB + (size_t)MR * DM;
    for (int it = blockIdx.x; it < 256; it += F.G) {
        if (it < 32) {
            const bool isk = it >= 16; const int h = (it & 15) >> 1, s2 = it & 1, idx = 64 * s2 + 16 * (w8 & 3) + fr, dk = idx + (w8 >= 4 ? 128 : 0);
            const f32x4v acc = skinny_dot(A, F.W1t, (isk ? C_KR : C_QR) + 256 * h + dk - fr, 0, DM / 32, lane);
#pragma unroll
            for (int e = 0; e < 4; ++e) ex[(w8 * 4 + e) * 64 + lane] = acc[e] * F.RS1[MR + 4 * fq + e];
            __syncthreads();
            const float l2g = __log2f(1.0f - exp2f(-5.0f - (float)h)); float o[4];
#pragma unroll
            for (int e = 0; e < 4; ++e) { const int mrow = 4 * fq + e; const float mine = ex[(w8 * 4 + e) * 64 + lane], other = ex[((w8 ^ 4) * 4 + e) * 64 + lane];
                const float c = F.COS[(MR + mrow) * 128 + idx], sn = F.SIN[(MR + mrow) * 128 + idx];
                const float rot = w8 < 4 ? mine * c - other * sn : mine * c + other * sn;
                const float dec = exp2f((float)(48 + mrow + 1) * l2g); o[e] = isk ? rot * 0.0625f / dec : rot * dec; }
            if (isk) *(unsigned long long*)((unsigned char*)F.KFR + (((size_t)h * 33 * 8 + (dk >> 5)) * 4 + 3) * 1024 + ((dk & 31) + 32 * (fq & 1)) * 16 + 8 * (fq >> 1)) = (unsigned long long)pkbf(o[0], o[1]) | ((unsigned long long)pkbf(o[2], o[3]) << 32);
            else {
#pragma unroll
                for (int e = 0; e < 4; ++e) { const int mrow = 4 * fq + e;
                    *(bf16*)((unsigned char*)F.QFR + (((size_t)h * 33 * 8 + (dk >> 5)) * 4 + ((dk >> 4) & 1) * 2 + 1) * 1024 + (16 + mrow + 32 * ((dk >> 2) & 1)) * 16 + 2 * (4 * ((dk >> 3) & 1) + (dk & 3))) = f2b(o[e]); } }
            __syncthreads();
        } else if (it < 64) {
            const int n0 = 128 * (it - 32) + 16 * w8; const f32x4v acc = skinny_dot(A, F.W1t, C_QG + n0, 0, DM / 32, lane);
#pragma unroll
            for (int e = 0; e < 4; ++e) { const int row = MR + 4 * fq + e; F.PROJ[(size_t)row * LDP + n0 + fr] = f2b(acc[e] * F.RS1[row]); }
        } else if (it >= 192) {
            const int cvv = 128 * (it - 192) + 16 * w8 + fr; const f32x4v acc = skinny_dot(A, F.W1t, C_V + 128 * (it - 192) + 16 * w8, 0, DM / 32, lane);
            const int cv = cvv & 4095, slg = cv >> 6, wt = (cv >> 5) & 1, rp = cv & 31; unsigned char* VF = (unsigned char*)(cvv < 4096 ? F.VFR : F.VFG);
            const f32x4v sc = *(const f32x4v*)(F.RS1 + MR + 4 * fq);
            *(unsigned long long*)(VF + ((size_t)slg * 8 + wt * 4 + 3) * 1024 + (rp + 32 * (fq & 1)) * 16 + 8 * (fq >> 1)) = (unsigned long long)pkbf(acc[0] * sc[0], acc[1] * sc[1]) | ((unsigned long long)pkbf(acc[2] * sc[2], acc[3] * sc[3]) << 32);
        } else {
            const int t = (it - 64) >> 1, sp = (it - 64) & 1;
            const int n0 = C_GR + 256 * t + (w8 >= 4 ? 128 : 0) + 64 * sp + 16 * (w8 & 3);
            const f32x4v acc = skinny_dot(A, F.W1t, n0, 0, DM / 32, lane);
#pragma unroll
            for (int e = 0; e < 4; ++e) ex[(w8 * 4 + e) * 64 + lane] = acc[e] * F.RS1[MR + 4 * fq + e];
            __syncthreads();
            if (w8 < 4) { bf16* G = t < 32 ? F.GR : F.GG; const int ch = 128 * (t & 31) + 64 * sp + 16 * w8 + fr;
#pragma unroll
                for (int e = 0; e < 4; ++e) { const int row = MR + 4 * fq + e; G[(size_t)row * DM + ch] = f2b(pg8::gate2(ex[(w8 * 4 + e) * 64 + lane], ex[((w8 + 4) * 4 + e) * 64 + lane])); } }
            __syncthreads();
        }
    }
    __syncthreads();
}
__device__ __forceinline__ void z_proj(Frame& F) {
    const int lane = F.lane, fr = lane & 15, fq = lane >> 4;
    for (int g = blockIdx.x * NWAVES + F.wave; g < MROWS / 16; g += F.G * NWAVES) {
        const f32x4v acc = skinny_dot(F.XB + (size_t)(16 * g) * DM, F.W1t, C_Z, 0, DM / 32, lane);
#pragma unroll
        for (int e = 0; e < 4; ++e) { const int row = 16 * g + 4 * fq + e; F.ZB[(size_t)row * 16 + fr] = acc[e] * F.RS1[row]; }
    }
}
__device__ __forceinline__ void meta_wout(Frame& F) {
    const int lane = F.lane, fr = lane & 15, fq = lane >> 4, w8 = F.wave; LAS float* ex = (LAS float*)F.lds;
    for (int it = blockIdx.x; it < DM / 16; it += F.G) {
        const int n0 = 16 * it; const f32x4v acc = skinny_dot(F.MRG + (size_t)MR * DM, F.Wot, n0, 512 * w8, 16, lane);
#pragma unroll
        for (int e = 0; e < 4; ++e) ex[(w8 * 4 + e) * 64 + lane] = acc[e];
        __syncthreads();
        if (w8 == 0) {
#pragma unroll
            for (int e = 2; e < 4; ++e) { float v = 0.f;
#pragma unroll
                for (int w = 0; w < 8; ++w) v += ex[(w * 4 + e) * 64 + lane];
                const int mrow = 4 * fq + e;
                const float hv = F.meta[(size_t)(mrow & 15) * DM + n0 + fr] + v; float q = hv * hv;
                q += __shfl_xor(q, 1); q += __shfl_xor(q, 2); q += __shfl_xor(q, 4); q += __shfl_xor(q, 8);
                if (fq == 3) { F.H1[(size_t)(MR + mrow) * DM + n0 + fr] = hv; F.H1B[(size_t)(MR + mrow) * DM + n0 + fr] = f2b(hv); if (fr == 0) atomicAdd(F.SS2 + MR + mrow, q); } }
        }
        __syncthreads();
    }
}
__device__ __forceinline__ void meta_up(Frame& F) {
    const int lane = F.lane, fr = lane & 15, fq = lane >> 4;
    for (int g = blockIdx.x * NWAVES + F.wave; g < DFF / 16; g += F.G * NWAVES) {
        const int c0 = 16 * g; const f32x4v acc = skinny_dot(F.H1B + (size_t)MR * DM, F.Wft, 256 * (c0 >> 7) + (c0 & 127), 0, DM / 32, lane);
        if (fq == 3) {
#pragma unroll
            for (int e = 2; e < 4; ++e) { const float rs = 1.0f / sqrtf(F.SS2[MR + 12 + e] * (1.0f / 4096.0f) + EPS); F.UPM[(size_t)(e - 2) * DFF + c0 + fr] = acc[e] * rs; } }
    }
}

template <bool GLA> __device__ __forceinline__ void prep_qkp(Frame& F, int u) {
    constexpr int DK = GLA ? GLA_DK : RET_DK, NH = GLA ? GLA_H : RET_H, LDQ = DK + 8, DKW = DK / 8, NKS = DKW / 16, NDT = DKW / 32;
    const int n = u < NH ? 0 : 1 + (u - NH) % 32, h = u < NH ? u : ((u - NH) / 32) % NH, b = u < NH ? 0 : (u - NH) / (32 * NH);
    LAS bf16* Qs = (LAS bf16*)F.lds; LAS bf16* Ks = Qs + 64 * LDQ; LAS float* zs = (LAS float*)(Ks + 64 * LDQ);
    const int tid = F.tid, lane = F.lane, w8 = F.wave, r = lane & 31, hh = lane >> 5;
    if (GLA) {
        for (int e = tid; e < 64 * 16; e += NTHR) { const int row = chunk_row(b, n, e >> 4); zs[e] = row >= 0 ? F.ZB[(size_t)row * 16 + (e & 15)] : 0.f; }
        __syncthreads();
        const int d = tid, ch = h * GLA_DK + d; float wg[GLA_RANK];
#pragma unroll
        for (int q = 0; q < GLA_RANK; ++q) wg[q] = F.w_gate_up[q * 2048 + ch];
        const float bg = F.b_gate[ch]; float bc = 0.f;
#pragma unroll 1
        for (int i0 = 0; i0 < 64; i0 += 16) {
            unsigned qr[16], kr[16];
#pragma unroll
            for (int ii = 0; ii < 16; ++ii) { const int row = chunk_row(b, n, i0 + ii); qr[ii] = 0u; kr[ii] = 0u;
                if (row >= 0) { const bf16* pr = F.PROJ + (size_t)row * LDP; qr[ii] = pr[P_QG + ch]; kr[ii] = pr[P_KG + ch]; } }
#pragma unroll
            for (int ii = 0; ii < 16; ++ii) { const int i = i0 + ii, row = chunk_row(b, n, i); float qv = 0.f, kv = 0.f;
                if (row >= 0) { float lg = bg;
#pragma unroll
                    for (int q = 0; q < GLA_RANK; ++q) lg += zs[i * 16 + q] * wg[q];
                    bc += logsig(lg) * (1.0f / 16.0f);
                    qv = bf2f((bf16)qr[ii]) * 0.04419417382415922f * __expf(bc); kv = bf2f((bf16)kr[ii]) * __expf(-bc); }
                Qs[i * LDQ + d] = f2b(qv); Ks[i * LDQ + d] = f2b(kv); }
        }
        F.DECG[((size_t)(b * GLA_H + h) * 33 + n) * GLA_DK + d] = __expf(bc);
    } else {
        const int p = tid & 127, tg = tid >> 7; const float l2g = log2f(1.0f - exp2f(-5.0f - (float)h));
#pragma unroll 1
        for (int i8 = 0; i8 < 16; i8 += 8) {
            unsigned q1r[8], q2r[8], k1r[8], k2r[8]; float cr[8], sr[8];
#pragma unroll
            for (int ii = 0; ii < 8; ++ii) { const int row = chunk_row(b, n, tg * 16 + i8 + ii); q1r[ii] = q2r[ii] = k1r[ii] = k2r[ii] = 0u; cr[ii] = 0.f; sr[ii] = 0.f;
                if (row >= 0) { const bf16* pr = F.PROJ + (size_t)row * LDP; cr[ii] = F.COS[row * 128 + p]; sr[ii] = F.SIN[row * 128 + p];
                    q1r[ii] = pr[C_QR + h * 256 + p]; q2r[ii] = pr[C_QR + h * 256 + 128 + p]; k1r[ii] = pr[C_KR + h * 256 + p]; k2r[ii] = pr[C_KR + h * 256 + 128 + p]; } }
#pragma unroll
            for (int ii = 0; ii < 8; ++ii) { const int i = tg * 16 + i8 + ii; const float c = cr[ii], sn = sr[ii];
                const float q1 = bf2f((bf16)q1r[ii]), q2 = bf2f((bf16)q2r[ii]), k1 = bf2f((bf16)k1r[ii]), k2 = bf2f((bf16)k2r[ii]);
                const float dq = exp2f((float)(i + 1) * l2g), dkk = 0.0625f / dq;
                Qs[i * LDQ + p] = f2b((q1 * c - q2 * sn) * dq); Qs[i * LDQ + p + 128] = f2b((q2 * c + q1 * sn) * dq);
                Ks[i * LDQ + p] = f2b((k1 * c - k2 * sn) * dkk); Ks[i * LDQ + p + 128] = f2b((k2 * c + k1 * sn) * dkk); }
        }
    }
    __syncthreads();
    const size_t cb = (size_t)(b * NH + h) * 33 + n;
    {
        char* qdst = (char*)(GLA ? F.QFG : F.QFR) + ((cb * 8 + w8) * (NKS * 2)) * 1024 + lane * 16;
#pragma unroll
        for (int ks = 0; ks < NKS; ++ks)
#pragma unroll
            for (int qt = 0; qt < 2; ++qt) { const LAS bf16* src = Qs + (32 * qt + r) * LDQ + DKW * w8 + 16 * ks + 4 * hh;
                const unsigned long long lo = *(const LAS unsigned long long*)src, hi = *(const LAS unsigned long long*)(src + 8);
                *(v4u*)(qdst + (ks * 2 + qt) * 1024) = (v4u){(unsigned)lo, (unsigned)(lo >> 32), (unsigned)hi, (unsigned)(hi >> 32)}; }
        char* kdst = (char*)(GLA ? F.KFG : F.KFR) + ((cb * 8 + w8) * (NDT * 4)) * 1024 + lane * 16;
#pragma unroll
        for (int dkt = 0; dkt < NDT; ++dkt)
#pragma unroll
            for (int ks = 0; ks < 4; ++ks) { unsigned w[4];
#pragma unroll
                for (int jj = 0; jj < 4; ++jj) { const int j0 = 2 * jj, t0 = 16 * ks + 8 * (j0 >> 2) + 4 * hh + (j0 & 3);
                    const unsigned e0 = Ks[t0 * LDQ + DKW * w8 + 32 * dkt + r], e1 = Ks[(t0 + 1) * LDQ + DKW * w8 + 32 * dkt + r]; w[jj] = e0 | (e1 << 16); }
                *(v4u*)(kdst + (dkt * 4 + ks) * 1024) = (v4u){w[0], w[1], w[2], w[3]}; }
    }
    if (w8 < 4) {
        const int kt = w8 >> 1, qt = w8 & 1; f32x16 acc;
#pragma unroll
        for (int i = 0; i < 16; ++i) acc[i] = 0.f;
        if (!(kt == 1 && qt == 0)) {
            const LAS bf16* ap = Ks + (32 * kt + r) * LDQ + 8 * hh; const LAS bf16* bp = Qs + (32 * qt + r) * LDQ + 8 * hh;
#pragma unroll 8
            for (int s = 0; s < DK / 16; ++s) acc = MFMA32(*(const LAS bf16x8*)(ap + 16 * s), *(const LAS bf16x8*)(bp + 16 * s), acc);
        }
        char* pdst = (char*)(GLA ? F.PFG : F.PFR) + (cb * 8) * 1024 + lane * 16;
#pragma unroll
        for (int s2 = 0; s2 < 2; ++s2) { unsigned w[4];
#pragma unroll
            for (int jj = 0; jj < 4; ++jj) { const int i0 = 8 * s2 + 2 * jj, i1 = i0 + 1;
                const int k0 = 32 * kt + (i0 & 3) + 8 * (i0 >> 2) + 4 * hh, k1 = 32 * kt + (i1 & 3) + 8 * (i1 >> 2) + 4 * hh, qc = 32 * qt + r;
                w[jj] = pkbf(k0 <= qc ? acc[i0] : 0.f, k1 <= qc ? acc[i1] : 0.f); }
            *(v4u*)(pdst + ((2 * kt + s2) * 2 + qt) * 1024) = (v4u){w[0], w[1], w[2], w[3]}; }
    }
    __syncthreads();
}
__device__ __forceinline__ void prep_p_ret(Frame& F, int u) {
    const int n = u % 33, h = (u / 33) % 8, b = u / (33 * 8);
    if (n == 0 && b != 0) return;
    constexpr int LDK = 264;
    LAS bf16* Ks = (LAS bf16*)F.lds;
    const int lane = F.lane, w8 = F.wave, r = lane & 31, hh = lane >> 5;
    const size_t cb = (size_t)(b * 8 + h) * 33 + n;
    { const unsigned char* kp = (const unsigned char*)F.KFR + (cb * 8 + w8) * 4096 + lane * 16;
#pragma unroll
      for (int ks = 0; ks < 4; ++ks) { const v4u w = *(const v4u*)(kp + ks * 1024);
#pragma unroll
          for (int j = 0; j < 8; ++j) { const int tok = 16 * ks + 8 * (j >> 2) + 4 * hh + (j & 3); Ks[tok * LDK + 32 * w8 + r] = (bf16)(w[j >> 1] >> (16 * (j & 1))); } } }
    __syncthreads();
    if (w8 < 3) {
        const int kt = w8 >> 1, qt = w8 == 0 ? 0 : 1; f32x16 acc;
#pragma unroll
        for (int i = 0; i < 16; ++i) acc[i] = 0.f;
        const unsigned char* qp = (const unsigned char*)F.QFR + (cb * 8) * 4096 + qt * 1024 + lane * 16;
        const LAS bf16* ap = Ks + (32 * kt + r) * LDK + 4 * hh;
#pragma unroll 4
        for (int s = 0; s < 16; ++s) {
            const unsigned long long lo = *(const LAS unsigned long long*)(ap + 16 * s), hi = *(const LAS unsigned long long*)(ap + 16 * s + 8);
            const v4u av = (v4u){(unsigned)lo, (unsigned)(lo >> 32), (unsigned)hi, (unsigned)(hi >> 32)};
            acc = MFMA32(__builtin_bit_cast(bf16x8, av), *(const bf16x8*)(qp + (s >> 1) * 4096 + (s & 1) * 2048), acc); }
        unsigned char* pdst = (unsigned char*)F.PFR + (cb * 8) * 1024 + lane * 16;
#pragma unroll
        for (int s2 = 0; s2 < 2; ++s2) { unsigned w[4];
#pragma unroll
            for (int jj = 0; jj < 4; ++jj) { const int i0 = 8 * s2 + 2 * jj, i1 = i0 + 1;
                const int k0 = 32 * kt + (i0 & 3) + 8 * (i0 >> 2) + 4 * hh, k1 = 32 * kt + (i1 & 3) + 8 * (i1 >> 2) + 4 * hh, qc = 32 * qt + r;
                w[jj] = pkbf(k0 <= qc ? acc[i0] : 0.f, k1 <= qc ? acc[i1] : 0.f); }
            *(v4u*)(pdst + ((2 * kt + s2) * 2 + qt) * 1024) = (v4u){w[0], w[1], w[2], w[3]}; }
    } else if (w8 == 3) {
        unsigned char* pdst = (unsigned char*)F.PFR + (cb * 8) * 1024 + lane * 16;
        *(v4u*)(pdst + (2 * 2 + 0) * 1024) = (v4u){0u, 0u, 0u, 0u}; *(v4u*)(pdst + (3 * 2 + 0) * 1024) = (v4u){0u, 0u, 0u, 0u};
    }
    __syncthreads();
}
#ifndef PREP_REP
#define PREP_REP 0
#endif
__device__ __forceinline__ void p2_prep(Frame& F) {
    constexpr int U_R = 4 * 8 * 33, U_G = 4 + 4 * 4 * 32;
    const int extra = (F.G == 256) ? U_G - 512 : 0;
    for (int u = blockIdx.x; u < U_G; u += F.G) { prep_qkp<true>(F, u); if (PREP_REP & 1) prep_qkp<true>(F, u); }
    if ((int)blockIdx.x >= extra)
        for (int u = blockIdx.x - extra; u < U_R; u += F.G - extra) { prep_p_ret(F, u); if (PREP_REP & 2) prep_p_ret(F, u); }
}

__device__ __forceinline__ bf16x8 pack8(const f32x16& x, int s) { v4u w;
    if (s == 0) { w.x = pkbf(x[0], x[1]); w.y = pkbf(x[2], x[3]); w.z = pkbf(x[4], x[5]); w.w = pkbf(x[6], x[7]); }
    else { w.x = pkbf(x[8], x[9]); w.y = pkbf(x[10], x[11]); w.z = pkbf(x[12], x[13]); w.w = pkbf(x[14], x[15]); }
    return __builtin_bit_cast(bf16x8, w); }
#define LDS_BAR() do { asm volatile("s_waitcnt lgkmcnt(0)" ::: "memory"); __builtin_amdgcn_s_barrier(); asm volatile("" ::: "memory"); } while (0)
template <bool GLA, int ABL = 0> __device__ __forceinline__ void scan_unit(Frame& F, int u) {
    constexpr int DK = GLA ? GLA_DK : RET_DK, DV = GLA ? GLA_DV : RET_DV, NH = GLA ? GLA_H : RET_H, NSL = DV / 64, DKW = DK / 8, NKS = DKW / 16, NDT = DKW / 32;
    const int b = u / (NH * NSL), h = (u / NSL) % NH, sl = u % NSL, slg = h * NSL + sl;
    const int lane = F.lane, r = lane & 31, hh = lane >> 5, w8 = F.wave;
#define SMFMA(a, b, c) (ABL == 4 ? (c) : MFMA32((a), (b), (c)))
    LAS unsigned char* RED = F.lds;
    LAS unsigned char* VL = F.lds + 131072;
    f32x16 S[NDT][2];
#pragma unroll
    for (int a = 0; a < NDT; ++a)
#pragma unroll
        for (int c = 0; c < 2; ++c)
#pragma unroll
            for (int i = 0; i < 16; ++i) S[a][c][i] = 0.f;
    const int b0 = 0;
    const char* QFb = (const char*)(GLA ? F.QFG : F.QFR) + (((size_t)(b * NH + h) * 33 * 8 + w8) * (NKS * 2)) * 1024 + lane * 16;
    const char* QF0 = (const char*)(GLA ? F.QFG : F.QFR) + (((size_t)(b0 * NH + h) * 33 * 8 + w8) * (NKS * 2)) * 1024 + lane * 16;
    const char* KF0 = (const char*)(GLA ? F.KFG : F.KFR) + (((size_t)(b0 * NH + h) * 33 * 8 + w8) * (NDT * 4)) * 1024 + lane * 16;
    const char* PF0 = (const char*)(GLA ? F.PFG : F.PFR) + ((size_t)(b0 * NH + h) * 33 * 8 + w8) * 1024 + lane * 16;
    const char* KFb = (const char*)(GLA ? F.KFG : F.KFR) + (((size_t)(b * NH + h) * 33 * 8 + w8) * (NDT * 4)) * 1024 + lane * 16;
    const char* VF0 = (const char*)(GLA ? F.VFG : F.VFR) + ((size_t)slg * 8 + w8) * 1024 + lane * 16;
    const char* VFb = VF0 + (size_t)b * 33 * 64 * 8 * 1024;
    const char* PFb = (const char*)(GLA ? F.PFG : F.PFR) + ((size_t)(b * NH + h) * 33 * 8 + w8) * 1024 + lane * 16;
    bf16* Y = GLA ? F.YG : F.YR;
    const float gam64 = exp2f(64.0f * log2f(1.0f - exp2f(-5.0f - (float)h)));
    bf16x8 qf[NKS * 2];
#pragma unroll
    for (int f = 0; f < NKS * 2; ++f) qf[f] = *(const bf16x8*)(QF0 + f * 1024);
    bf16x8 bp = *(const bf16x8*)PF0;
    *(LAS bf16x8*)(VL + w8 * 1024 + lane * 16) = *(const bf16x8*)VF0;
    __syncthreads();
#pragma unroll 1
    for (int n = 0; n < 33; ++n) {
        const size_t cb = (size_t)((n ? b : 0) * NH + h) * 33 + n;
        const char* kp = n ? KFb + (size_t)n * (8 * NDT * 4 * 1024) : KF0;
        const LAS unsigned char* vl = VL + (n & 1) * 8192 + lane * 16;
        const int nn = n < 32 ? n + 1 : n;
        bf16x8 kf[NDT * 4];
#pragma unroll
        for (int f = 0; f < NDT * 4; ++f) kf[f] = *(const bf16x8*)((ABL == 2 ? KF0 : kp) + f * 1024);
        const bf16x8 vnext = *(const bf16x8*)(ABL == 2 ? VF0 : VFb + (size_t)nn * (64 * 8 * 1024));
        { const int ks2 = w8 >> 1, qt2 = w8 & 1;
#pragma unroll
          for (int wt = 0; wt < 2; ++wt) { f32x16 o0, o1;
#pragma unroll
            for (int i = 0; i < 16; ++i) { o0[i] = 0.f; o1[i] = 0.f; }
#pragma unroll
            for (int ks = 0; ks < NKS; ++ks) { const bf16x8 a = pack8(S[ks >> 1][wt], ks & 1); o0 = SMFMA(a, qf[ks * 2], o0); o1 = SMFMA(a, qf[ks * 2 + 1], o1); }
            const bf16x8 av = *(const LAS bf16x8*)(vl + (wt * 4 + ks2) * 1024);
            if (qt2 == 0) o0 = SMFMA(av, bp, o0); else o1 = SMFMA(av, bp, o1);
            if (ABL != 3 && wt == 0) LDS_BAR();
            if (ABL != 3) { LAS unsigned char* d0 = RED + ((w8 * 4 + wt * 2) * 64 + lane) * 48; LAS unsigned char* d1 = d0 + 64 * 48;
              *(LAS v4u*)d0 = (v4u){pkbf(o0[0], o0[1]), pkbf(o0[2], o0[3]), pkbf(o0[4], o0[5]), pkbf(o0[6], o0[7])}; *(LAS v4u*)(d0 + 16) = (v4u){pkbf(o0[8], o0[9]), pkbf(o0[10], o0[11]), pkbf(o0[12], o0[13]), pkbf(o0[14], o0[15])};
              *(LAS v4u*)d1 = (v4u){pkbf(o1[0], o1[1]), pkbf(o1[2], o1[3]), pkbf(o1[4], o1[5]), pkbf(o1[6], o1[7])}; *(LAS v4u*)(d1 + 16) = (v4u){pkbf(o1[8], o1[9]), pkbf(o1[10], o1[11]), pkbf(o1[12], o1[13]), pkbf(o1[14], o1[15])}; } } }
        if (ABL != 2) { const char* qn = QFb + (size_t)nn * (8 * NKS * 2 * 1024);
#pragma unroll
          for (int f = 0; f < NKS * 2; ++f) qf[f] = *(const bf16x8*)(qn + f * 1024);
          bp = *(const bf16x8*)(PFb + (size_t)nn * 8192); }
#pragma unroll
        for (int ks = 0; ks < 4; ++ks) { bf16x8 bv[2];
#pragma unroll
            for (int wt = 0; wt < 2; ++wt) bv[wt] = *(const LAS bf16x8*)(vl + (wt * 4 + ks) * 1024);
#pragma unroll
            for (int dkt = 0; dkt < NDT; ++dkt)
#pragma unroll
                for (int wt = 0; wt < 2; ++wt) S[dkt][wt] = SMFMA(kf[dkt * 4 + ks], bv[wt], S[dkt][wt]); }
        if (GLA) {
#pragma unroll
            for (int dkt = 0; dkt < NDT; ++dkt) { const float* dp = F.DECG + cb * GLA_DK + DKW * w8 + 32 * dkt + 4 * hh;
#pragma unroll
                for (int g4 = 0; g4 < 4; ++g4) { const f32x4 dv = *(const f32x4*)(dp + 8 * g4);
#pragma unroll
                    for (int e = 0; e < 4; ++e) { S[dkt][0][4 * g4 + e] *= dv[e]; S[dkt][1][4 * g4 + e] *= dv[e]; } } }
        } else {
#pragma unroll
            for (int wt = 0; wt < 2; ++wt)
#pragma unroll
                for (int i = 0; i < 16; ++i) S[0][wt][i] *= gam64;
        }
        *(LAS bf16x8*)(VL + ((n + 1) & 1) * 8192 + w8 * 1024 + lane * 16) = vnext;
        LDS_BAR();
        if (ABL != 3) {
            const int t = w8 >> 1, wt = t >> 1, qt = t & 1; float val[8];
#pragma unroll
            for (int ii = 0; ii < 8; ++ii) val[ii] = 0.f;
#pragma unroll
            for (int src = 0; src < 8; ++src) { const v4u w = *(const LAS v4u*)(RED + ((src * 4 + t) * 64 + lane) * 48 + 16 * (w8 & 1));
#pragma unroll
                for (int q = 0; q < 4; ++q) { val[2 * q] += __builtin_bit_cast(float, w[q] << 16); val[2 * q + 1] += __builtin_bit_cast(float, w[q] & 0xffff0000u); } }
            const int row = chunk_row(b, n, 32 * qt + r);
            if (ABL == 0 && row >= 0 && (n > 0 || b == 0)) {
#pragma unroll
                for (int g = 0; g < 2; ++g) { const int w0 = 32 * wt + 8 * (2 * (w8 & 1) + g) + 4 * hh;
                    *(unsigned long long*)(Y + (size_t)row * DM + h * DV + 64 * sl + w0) = (unsigned long long)pkbf(val[4 * g], val[4 * g + 1]) | ((unsigned long long)pkbf(val[4 * g + 2], val[4 * g + 3]) << 32); } }
        }
    }
    __syncthreads();
}
#undef SMFMA
#ifndef SCAN_ABL
#define SCAN_ABL 0
#endif
__device__ __forceinline__ void p3_scan(Frame& F) {
    for (int i = blockIdx.x; i < 512; i += F.G) {
        const int w = i & 255, x = w & 7, idx = w >> 3;
        if (i < 256) { scan_unit<true>(F, (2 * x + (idx >> 4)) * 16 + (idx & 15)); if (SCAN_ABL) scan_unit<true, SCAN_ABL>(F, (2 * x + (idx >> 4)) * 16 + (idx & 15)); }
        else { scan_unit<false>(F, (4 * x + (idx >> 3)) * 8 + (idx & 7)); if (SCAN_ABL) scan_unit<false, SCAN_ABL>(F, (4 * x + (idx >> 3)) * 8 + (idx & 7)); }
    }
}

__device__ __forceinline__ void ld8bf(const bf16* p, float (&o)[8]) { const v4u w = *(const v4u*)p;
#pragma unroll
    for (int q = 0; q < 4; ++q) { o[2 * q] = __builtin_bit_cast(float, w[q] << 16); o[2 * q + 1] = __builtin_bit_cast(float, w[q] & 0xffff0000u); } }
__device__ __forceinline__ void p4_merge(Frame& F) {
    const int gw = blockIdx.x * NWAVES + F.wave, NGW = F.G * NWAVES, lane = F.lane;
    for (int m = gw; m < MROWS; m += NGW) {
#pragma unroll 1
        for (int hg = 0; hg < 4; ++hg) {
            float yr[2][8], yg[2][8];
#pragma unroll
            for (int j = 0; j < 2; ++j) { const int c = hg * 1024 + j * 512 + lane * 8; ld8bf(F.YR + (size_t)m * DM + c, yr[j]); ld8bf(F.YG + (size_t)m * DM + c, yg[j]); }
            float sg = 0.f, sa = 0.f, sb = 0.f;
#pragma unroll
            for (int e = 0; e < 8; ++e) { sg += yg[0][e] * yg[0][e] + yg[1][e] * yg[1][e]; sa += yr[0][e]; sb += yr[1][e]; }
            sg = wave_sum(sg); sa = wave_sum(sa); sb = wave_sum(sb);
            const float rg = 1.0f / sqrtf(sg * (1.0f / 1024.0f) + EPS), ma = sa * (1.0f / 512.0f), mb = sb * (1.0f / 512.0f);
            float qa = 0.f, qb = 0.f;
#pragma unroll
            for (int e = 0; e < 8; ++e) { yr[0][e] -= ma; yr[1][e] -= mb; qa += yr[0][e] * yr[0][e]; qb += yr[1][e] * yr[1][e]; }
            qa = wave_sum(qa); qb = wave_sum(qb);
            const float ra = 1.0f / sqrtf(qa * (1.0f / 512.0f) + EPS), rb = 1.0f / sqrtf(qb * (1.0f / 512.0f) + EPS);
#pragma unroll
            for (int j = 0; j < 2; ++j) { const int c = hg * 1024 + j * 512 + lane * 8; const float rr = j ? rb : ra; float tr[8], tg[8], res[8];
                ld8bf(F.GR + (size_t)m * DM + c, tr); ld8bf(F.GG + (size_t)m * DM + c, tg);
                const f32x4 gr0 = *(const f32x4*)(F.ret_norm + c), gr1 = *(const f32x4*)(F.ret_norm + c + 4), gg0 = *(const f32x4*)(F.gla_norm + c), gg1 = *(const f32x4*)(F.gla_norm + c + 4);
#pragma unroll
                for (int e = 0; e < 8; ++e) res[e] = tr[e] * (yr[j][e] * rr * (e < 4 ? gr0[e & 3] : gr1[e & 3])) + tg[e] * (yg[j][e] * rg * (e < 4 ? gg0[e & 3] : gg1[e & 3]));
                *(v4u*)(F.MRG + (size_t)m * DM + c) = (v4u){pk2(res[0], res[1]), pk2(res[2], res[3]), pk2(res[4], res[5]), pk2(res[6], res[7])}; }
        }
    }
}

__device__ __forceinline__ void p8_act(Frame& F) {
    for (int i = blockIdx.x * NTHR + F.tid; i < 32 * DFF; i += F.G * NTHR) {
        const int pm = i / DFF, c = i % DFF;
        const float* prev = (pm & 7) ? F.UPH + (size_t)(pm - 1) * 2 * DFF : F.UPM;
        const float p0 = prev[c], p1 = prev[DFF + c], w0 = F.conv_w[c], w1 = F.conv_w[DFF + c];
        const float c0 = F.PARTC[(size_t)pm * 2 * DFF + c] + w1 * p1 + w0 * p0, c1 = F.PARTC[(size_t)pm * 2 * DFF + DFF + c] + w0 * p1;
        F.ACT[(size_t)(256 * pm) * DFF + c] = f2b(silu(c0) * F.PARTG[(size_t)pm * 2 * DFF + c]);
        F.ACT[(size_t)(256 * pm + 1) * DFF + c] = f2b(silu(c1) * F.PARTG[(size_t)pm * 2 * DFF + DFF + c]);
    }
}

__device__ __forceinline__ void p10_final(Frame& F) {
    const int gw = blockIdx.x * NWAVES + F.wave, NGW = F.G * NWAVES;
    for (int m = gw; m < MR; m += NGW) {
        GAS f32x4* xr = (GAS f32x4*)(F.out + (size_t)m * DM) + F.lane; f32x4 v[16]; float ss = 0.f;
#pragma unroll
        for (int j = 0; j < 16; ++j) { v[j] = xr[64 * j]; ss += (v[j].x * v[j].x + v[j].y * v[j].y) + (v[j].z * v[j].z + v[j].w * v[j].w); }
        ss = wave_sum(ss); const float r = 1.0f / sqrtf(ss * (1.0f / DM) + EPS);
#pragma unroll
        for (int j = 0; j < 16; ++j) { const f32x4 g = *((const GAS f32x4*)F.final_norm + F.lane + 64 * j); xr[64 * j] = v[j] * r * g; }
    }
}

#ifndef REP_MASK
#define REP_MASK 0u
#endif
#define REPS(k) (((REP_MASK >> (k)) & 1u) ? 2 : 1)
struct Args { const void* in[16]; float* out; unsigned char* ws; int ph_lo, ph_hi, li, pad; };
__global__ void __launch_bounds__(NTHR, 2) fwd(Args args) {
    extern __shared__ __attribute__((aligned(16))) unsigned char lds[];
    Frame F;
    F.lds = (LAS unsigned char*)lds;
    F.MISC = (volatile LAS unsigned*)(F.lds + MISC_OFF);
    F.tid = threadIdx.x; F.lane = F.tid & 63; F.wave = __builtin_amdgcn_readfirstlane(F.tid >> 6); F.G = gridDim.x;
    unsigned char* ws = args.ws;
    F.ctl = (gu32*)(ws + WS_CTL);
    F.x = (const float*)args.in[0]; F.positions = (const int*)args.in[1]; F.meta = (const float*)args.in[2]; F.attn_norm = (const float*)args.in[3]; F.w_in = (const float*)args.in[4];
    F.w_gate_up = (const float*)args.in[5]; F.b_gate = (const float*)args.in[6]; F.ret_norm = (const float*)args.in[7]; F.gla_norm = (const float*)args.in[8]; F.w_out = (const float*)args.in[9];
    F.ffn_norm = (const float*)args.in[10]; F.w_ffn_in = (const float*)args.in[11]; F.conv_w = (const float*)args.in[12]; F.conv_b = (const float*)args.in[13]; F.w_ffn_out = (const float*)args.in[14];
    F.final_norm = (const float*)args.in[15]; F.out = args.out;
    F.W1t = (bf16*)(ws + WS_W1T); F.Wot = (bf16*)(ws + WS_WOT); F.Wft = (bf16*)(ws + WS_WFT); F.W2t = (bf16*)(ws + WS_W2T); F.XB = (bf16*)(ws + WS_XB);
    F.PROJ = (bf16*)(ws + WS_PROJ); F.UG = (bf16*)(ws + WS_UG); F.ACT = (bf16*)(ws + WS_ACT); F.MRG = (bf16*)(ws + WS_MRG); F.H1B = (bf16*)(ws + WS_H1B);
    F.RS1 = (float*)(ws + WS_RS1); F.SS2 = (float*)(F.ctl + CW_SS2); F.ZB = (float*)(ws + WS_ZB); F.COS = (float*)(ws + WS_COS); F.SIN = (float*)(ws + WS_SIN); F.COST = (float*)(ws + WS_COST); F.SINT = (float*)(ws + WS_SINT);
    F.YR = (bf16*)(ws + WS_YR); F.YG = (bf16*)(ws + WS_YG); F.GR = (bf16*)(ws + WS_GR); F.GG = (bf16*)(ws + WS_GG); F.H1 = (float*)(ws + WS_H1); F.DECG = (float*)(ws + WS_DECG); F.UPH = (float*)(ws + WS_UPH); F.PARTC = (float*)(ws + WS_PARTC); F.PARTG = (float*)(ws + WS_PARTG); F.UPM = (float*)(ws + WS_UPM);
    F.QFG = (bf16*)(ws + WS_QFG); F.KFG = (bf16*)(ws + WS_KFG); F.QFR = (bf16*)(ws + WS_QFR); F.KFR = (bf16*)(ws + WS_KFR);
    F.VFG = (bf16*)(ws + WS_VFG); F.VFR = (bf16*)(ws + WS_VFR); F.PFG = (bf16*)(ws + WS_PFG); F.PFR = (bf16*)(ws + WS_PFR);
    for (int u = F.tid; u < (LDS_BYTES - LDSCTL_OFF) / 4; u += NTHR) ((LAS unsigned*)(F.lds + LDSCTL_OFF))[u] = 0u;
    __syncthreads();
    XcdBarrier bar; bar.bar = (unsigned*)(F.ctl + CW_BAR); bar.x = 0; bar.st = nullptr;
    if (N_LAUNCHES != NPH) bar = xcd_barrier_post((unsigned*)(F.ctl + CW_BAR) + args.li * XCD_BAR_WORDS, F.MISC + 8);
#define GRID_BAR(seam) do { if (N_LAUNCHES == NPH) { if (F.tid == 0) __hip_atomic_store(F.ctl + CW_TMO, 0xBADBA0u | (unsigned)(seam), RLX_AGENT); } else { xcd_barrier(bar); } } while (0)
    const int lo = args.ph_lo, hi = args.ph_hi;
#define IN(k) (lo <= (k) && (k) < hi)
#define BOTH(k) (IN(k) && IN((k) + 1))
#ifndef SKINNY_REP
#define SKINNY_REP 0
#endif
#ifndef G1_REP
#define G1_REP 0
#endif
#define PH1A() do { pg8::Gemm g{F.XB, F.W1t, MR, C_B, DM}; pg8::StaticOrder S; S.init(MR, C_B, F.G, (int)blockIdx.x); pg8::EpiA E{F.PROJ, F.RS1, F.COS, F.SIN, (unsigned char*)F.QFR, F.GR, F.GG}; \
          pg8::gemm_phase<pg8::EpiA, pg8::StaticOrder, PG8_ALIGN, PG8_SP2>(F.lds + RING_OFF, g, S, E); } while (0)
#define PH1B() do { pg8::Gemm g{F.XB, F.W1t + (size_t)C_B * DM, MR, 32768 - C_B, DM}; pg8::StaticOrder S; S.init(MR, 32768 - C_B, F.G, (int)blockIdx.x); pg8::EpiB E{(unsigned char*)F.VFR, (unsigned char*)F.VFG, (unsigned char*)F.KFR, F.RS1, F.COST, F.SINT}; \
          pg8::gemm_phase<pg8::EpiB, pg8::StaticOrder, PG8_ALIGN, PG8_SP2, false>(F.lds + RING_OFF, g, S, E); } while (0)
#define PH1() do { z_proj(F); if (SKINNY_REP & 1) z_proj(F); meta_proj(F); if (SKINNY_REP & 2) meta_proj(F); PH1A(); if (G1_REP & 1) PH1A(); PH1B(); if (G1_REP & 2) PH1B(); } while (0)
#define PH5() do { meta_wout(F); pg8::Gemm g{F.MRG, F.Wot, MR, DM, DM}; pg8::StaticOrder S; S.init(MR, DM, F.G, (int)blockIdx.x); pg8::EpiResX E{F.x, F.meta, F.H1, F.H1B, F.SS2, DM, MR, NMETA}; \
        pg8::gemm_phase<pg8::EpiResX, pg8::StaticOrder, PG8_ALIGN, PG8_SP2>(F.lds + RING_OFF, g, S, E); } while (0)
#define PH7() do { meta_up(F); pg8::Gemm g{F.H1B, F.Wft, MR, NF, DM}; pg8::StaticOrder S; S.init(MR, NF, F.G, (int)blockIdx.x); pg8::EpiFfn E{F.ACT, F.SS2, F.conv_w, F.conv_b, F.UPH, F.PARTC, F.PARTG, (LAS float*)(F.lds + 131072)}; \
        pg8::gemm_phase<pg8::EpiFfn, pg8::StaticOrder, true, PG8_SP2>(F.lds + RING_OFF, g, S, E); convert_w2(F); } while (0)
#define PH9() do { pg8::Gemm g{F.ACT, F.W2t, MR, DM, DFF}; pg8::StaticOrder S; S.init(MR, DM, F.G, (int)blockIdx.x); pg8::EpiResF32 E{F.H1, F.out, DM}; \
        pg8::gemm_phase<pg8::EpiResF32, pg8::StaticOrder, PG8_ALIGN, PG8_SP2>(F.lds + RING_OFF, g, S, E); } while (0)
#define REIDX() do { int tz = threadIdx.x; asm volatile("" : "+v"(tz)); F.tid = tz; F.lane = tz & 63; F.wave = __builtin_amdgcn_readfirstlane(tz >> 6); } while (0)
#define RUN(k, body) do { if (IN(k)) { REIDX(); body; if (REPS(k) == 2) { __syncthreads(); body; } if (BOTH(k)) GRID_BAR(k); } } while (0)
    RUN(0, p0_prologue(F));
    RUN(1, PH1());
    RUN(2, p2_prep(F));
    RUN(3, p3_scan(F));
    RUN(4, p4_merge(F));
    RUN(5, PH5());
    RUN(7, PH7());
    RUN(8, p8_act(F));
    RUN(9, PH9());
    if (IN(10)) { REIDX(); p10_final(F); }
#undef IN
#undef BOTH
}

extern "C" void kernel_launch(void* const* d_in, const int* in_sizes, int n_in, void* d_out, int out_size, void* d_ws, size_t ws_size, hipStream_t stream) {
    static int grid = 0;
    if (grid == 0) {
        if (n_in != 16 || in_sizes[0] != MR * DM || out_size != MR * DM || ws_size < WS_END) {
            fprintf(stderr, "kernel_launch: shape/workspace mismatch: n_in %d in0 %d out %d ws %zu (need %zu); nothing launched\n", n_in, n_in > 0 ? in_sizes[0] : -1, out_size, ws_size, (size_t)WS_END); grid = -1; return; }
        int dev = 0, cus = 0, per_cu = 0;
        if (hipGetDevice(&dev) != hipSuccess || hipDeviceGetAttribute(&cus, hipDeviceAttributeMultiprocessorCount, dev) != hipSuccess) { fprintf(stderr, "kernel_launch: device query failed\n"); grid = -1; return; }
        if (hipFuncSetAttribute((const void*)fwd, hipFuncAttributeMaxDynamicSharedMemorySize, LDS_BYTES) != hipSuccess) { fprintf(stderr, "kernel_launch: hipFuncSetAttribute failed\n"); grid = -1; return; }
        if (hipOccupancyMaxActiveBlocksPerMultiprocessor(&per_cu, (const void*)fwd, NTHR, LDS_BYTES) != hipSuccess || per_cu < 1)
            fprintf(stderr, "kernel_launch: note: occupancy query reports %d workgroups per CU\n", per_cu);
        (void)hipGetLastError();
        grid = cus;
    }
    if (grid < 0) return;
    if (hipMemsetAsync((char*)d_ws + WS_CTL, 0, CTL_ZERO_BYTES, stream) != hipSuccess) { fprintf(stderr, "kernel_launch: memset failed\n"); return; }
    Args a{};
    for (int i = 0; i < 16; ++i) a.in[i] = d_in[i];
    a.out = (float*)d_out; a.ws = (unsigned char*)d_ws;
    for (int li = 0; li < N_LAUNCHES; ++li) {
        a.ph_lo = (N_LAUNCHES == NPH) ? li : 0; a.ph_hi = (N_LAUNCHES == NPH) ? li + 1 : NPH; a.li = (N_LAUNCHES == NPH) ? 0 : li;
        hipLaunchKernelGGL(fwd, dim3(grid), dim3(NTHR), LDS_BYTES, stream, a);
        const hipError_t le = hipPeekAtLastError();
        if (le != hipSuccess) { fprintf(stderr, "kernel_launch: launch %d failed: %s\n", li, hipGetErrorName(le)); break; }
    }
}
```
